# Optimizing an MI355X kernel written in HIP

```python
import math
import jax, jax.numpy as jnp
from jax import lax
import numpy as np

D_MODEL = 1024
BATCH = 16
SEQ = 4096
DEPTH = 2

HEAD_DIM = 64
N_HEADS_A = 8
N_HEADS_B = 8
W_A = N_HEADS_A * HEAD_DIM
W_B = N_HEADS_B * HEAD_DIM
DILATED_PAIRS = ((128, 1), (512, 4), (2048, 16))
DSW_BLOCK = 64
GRID_W = 64
NA_ROWS = 8
NA_COLS = 16
NA_COL_BLOCK = 16
NA_COL_REGION = NA_COL_BLOCK + NA_COLS
N_HEADS_C = D_MODEL // (2 * HEAD_DIM)
DIFF_BLOCK = 128
D_FF = -(-8 * D_MODEL // (3 * 256)) * 256
RMS_EPS = 1e-6
SUBLN_EPS = 1e-5

kernel_name = "hybrid_dilated_natten_diffattn_encoder"


def rmsnorm(x, g, eps=RMS_EPS):
    xf = x.astype(jnp.float32)
    y = xf * lax.rsqrt(jnp.mean(xf * xf, axis=-1, keepdims=True) + eps)
    return (y * g.astype(jnp.float32)).astype(x.dtype)


def alibi_slopes(n):
    return jnp.exp2(-8.0 * jnp.arange(1, n + 1, dtype=jnp.float32) / n)


def lambda_init_fn(layer):
    return 0.8 - 0.6 * math.exp(-0.3 * layer)


def swiglu(h, w_gate, w_up, w_down):
    return (jax.nn.silu(h @ w_gate) * (h @ w_up)) @ w_down


def dilated_window_branch(q, k, v, slopes, window, dilation):
    B, H, T, Dh = q.shape
    half = window // (2 * dilation)
    L = T // dilation
    nb = -(-L // DSW_BLOCK)
    Lq = nb * DSW_BLOCK
    K = DSW_BLOCK + 2 * half

    def strided(a):
        return a.reshape(B, H, L, dilation, Dh).transpose(0, 1, 3, 2, 4)

    qs = jnp.pad(strided(q), ((0, 0), (0, 0), (0, 0), (0, Lq - L), (0, 0)))
    kpad = ((0, 0), (0, 0), (0, 0), (half, Lq - L + half), (0, 0))
    ks = jnp.pad(strided(k), kpad)
    vs = jnp.pad(strided(v), kpad)
    key_idx = np.arange(nb)[:, None] * DSW_BLOCK + np.arange(K)[None, :]
    kb = ks[:, :, :, key_idx, :]
    vb = vs[:, :, :, key_idx, :]
    qb = qs.reshape(B, H, dilation, nb, DSW_BLOCK, Dh)
    off = np.arange(K)[None, :] - half - np.arange(DSW_BLOCK)[:, None]
    key_j = key_idx - half
    valid = ((np.abs(off)[None] <= half)
             & (key_j[:, None, :] >= 0) & (key_j[:, None, :] < L))
    s = jnp.einsum('bhrnqd,bhrnkd->bhrnqk', qb, kb) * (HEAD_DIM ** -0.5)
    dist = (np.abs(off) * dilation).astype(np.float32)
    s = s - (slopes[:, None, None] * dist[None])[None, :, None, None]
    s = jnp.where(valid[None, None, None], s, -jnp.inf)
    m = jnp.max(s, axis=-1, keepdims=True)
    p = jnp.exp(s - m)
    l = jnp.sum(p, axis=-1, keepdims=True)
    o = jnp.einsum('bhrnqk,bhrnkd->bhrnqd', p, vb) / l
    lse = (m + jnp.log(l))[..., 0]
    o = o.reshape(B, H, dilation, Lq, Dh)[:, :, :, :L].transpose(0, 1, 3, 2, 4).reshape(B, H, T, Dh)
    lse = lse.reshape(B, H, dilation, Lq)[..., :L].transpose(0, 1, 3, 2).reshape(B, H, T)
    return o, lse


def dilated_mixture_attention(q, k, v):
    H = q.shape[1]
    slopes = alibi_slopes(H)
    outs, lses = [], []
    for window, dilation in DILATED_PAIRS:
        o, lse = dilated_window_branch(q, k, v, slopes, window, dilation)
        outs.append(o)
        lses.append(lse)
    wts = jax.nn.softmax(jnp.stack(lses, axis=0), axis=0)
    y = wts[0][..., None] * outs[0]
    for i in range(1, len(outs)):
        y = y + wts[i][..., None] * outs[i]
    return y


def neighborhood_attention(q, k, v, rpb):
    B, H, T, Dh = q.shape
    rows = T // GRID_W
    kh = min(NA_ROWS, rows)
    n_cb = GRID_W // NA_COL_BLOCK
    qg = q.reshape(B, H, rows, GRID_W, Dh)
    kg = k.reshape(B, H, rows, GRID_W, Dh)
    vg = v.reshape(B, H, rows, GRID_W, Dh)
    cb_start = np.clip(np.arange(n_cb) * NA_COL_BLOCK - NA_COLS // 2, 0, GRID_W - NA_COL_REGION)
    key_cols = cb_start[:, None] + np.arange(NA_COL_REGION)[None, :]
    q_cols = np.arange(GRID_W).reshape(n_cb, NA_COL_BLOCK)
    wc = np.clip(q_cols - NA_COLS // 2, 0, GRID_W - NA_COLS)[..., None]
    kc = key_cols[:, None, :]
    col_valid = (kc >= wc) & (kc < wc + NA_COLS)
    col_bias_idx = np.clip(kc - q_cols[..., None] + NA_COLS - 1, 0, 2 * NA_COLS - 2)
    scale = HEAD_DIM ** -0.5

    def row_step(r):
        rs = jnp.clip(r - kh // 2, 0, rows - kh)
        k_rows = lax.dynamic_slice_in_dim(kg, rs, kh, axis=2)
        v_rows = lax.dynamic_slice_in_dim(vg, rs, kh, axis=2)
        q_row = lax.dynamic_index_in_dim(qg, r, axis=2, keepdims=False)
        k_blk = k_rows[:, :, :, key_cols, :]
        v_blk = v_rows[:, :, :, key_cols, :]
        q_blk = q_row.reshape(B, H, n_cb, NA_COL_BLOCK, Dh)
        s = jnp.einsum('bhcqd,bhrckd->bhcqrk', q_blk, k_blk) * scale
        row_idx = (rs + jnp.arange(kh) - r + NA_ROWS - 1)[None, None, :, None]
        bias = rpb[:, row_idx, col_bias_idx[:, :, None, :]]
        s = s + bias[None].astype(jnp.float32)
        s = jnp.where(col_valid[:, :, None, :], s, -jnp.inf)
        p = jax.nn.softmax(s.reshape(B, H, n_cb, NA_COL_BLOCK, kh * NA_COL_REGION), axis=-1)
        p = p.reshape(s.shape)
        o = jnp.einsum('bhcqrk,bhrckd->bhcqd', p, v_blk)
        return o.reshape(B, H, GRID_W, Dh)

    out = lax.map(row_step, jnp.arange(rows))
    return out.transpose(1, 2, 0, 3, 4).reshape(B, H, T, Dh)


def differential_attention(q, k, v, lam):
    B, H, _, T, Dh = q.shape
    slopes = alibi_slopes(H)
    nq = T // DIFF_BLOCK
    q_blocks = q.reshape(B, H, 2, nq, DIFF_BLOCK, Dh).transpose(3, 0, 1, 2, 4, 5)
    kpos = jnp.arange(T)
    scale = Dh ** -0.5

    def block(args):
        qb, start = args
        s = jnp.einsum('bhiqd,bhikd->bhiqk', qb, k) * scale
        qpos = start + jnp.arange(DIFF_BLOCK)
        dist = jnp.abs(qpos[:, None] - kpos[None, :]).astype(jnp.float32)
        s = s - (slopes[:, None, None] * dist[None])[None, :, None]
        p = jax.nn.softmax(s, axis=-1)
        a = p[:, :, 0] - lam * p[:, :, 1]
        return jnp.einsum('bhqk,bhkd->bhqd', a, v)

    out = lax.map(block, (q_blocks, jnp.arange(nq) * DIFF_BLOCK))
    return out.transpose(1, 2, 0, 3, 4).reshape(B, H, T, 2 * Dh)


def even_mixer(h, w_in, w_out, rpb):
    B, T, _ = h.shape
    proj = (h @ w_in).astype(jnp.float32)
    cuts = np.cumsum([W_A, W_A, W_A, W_B, W_B])
    qa, ka, va, qb, kb, vb = jnp.split(proj, cuts, axis=-1)

    def heads(a):
        return a.reshape(B, T, -1, HEAD_DIM).transpose(0, 2, 1, 3)

    ya = dilated_mixture_attention(heads(qa), heads(ka), heads(va))
    yb = neighborhood_attention(heads(qb), heads(kb), heads(vb), rpb)
    y = jnp.concatenate([ya, yb], axis=1).transpose(0, 2, 1, 3).reshape(B, T, W_A + W_B)
    return y.astype(h.dtype) @ w_out


def odd_mixer(h, w_qkv, w_out, lam_q1, lam_k1, lam_q2, lam_k2, subln, layer):
    B, T, _ = h.shape
    proj = (h @ w_qkv).astype(jnp.float32)
    q, k, v = jnp.split(proj, 3, axis=-1)
    q = q.reshape(B, T, N_HEADS_C, 2, HEAD_DIM).transpose(0, 2, 3, 1, 4)
    k = k.reshape(B, T, N_HEADS_C, 2, HEAD_DIM).transpose(0, 2, 3, 1, 4)
    v = v.reshape(B, T, N_HEADS_C, 2 * HEAD_DIM).transpose(0, 2, 1, 3)
    lam_init = lambda_init_fn(layer)
    f32 = jnp.float32
    lam = (jnp.exp(jnp.sum(lam_q1.astype(f32) * lam_k1.astype(f32)))
           - jnp.exp(jnp.sum(lam_q2.astype(f32) * lam_k2.astype(f32))) + lam_init)
    y = differential_attention(q, k, v, lam)
    y = rmsnorm(y, subln, SUBLN_EPS) * (1.0 - lam_init)
    y = y.transpose(0, 2, 1, 3).reshape(B, T, N_HEADS_C * 2 * HEAD_DIM)
    return y.astype(h.dtype) @ w_out


def setup_inputs(seed: int = 0) -> dict:
    key = jax.random.key(seed)
    ks = jax.random.split(key, 24)
    f32 = jnp.float32

    def w(k, shape, fan_in):
        return jax.random.normal(k, shape, f32) * fan_in ** -0.5

    def gain(k, n):
        return 1.0 + 0.02 * jax.random.normal(k, (n,), f32)

    D = D_MODEL
    WC = N_HEADS_C * 2 * HEAD_DIM
    return {
        "x": jax.random.normal(ks[0], (BATCH, SEQ, D), f32),
        "a0_norm": gain(ks[1], D),
        "a0_w_in": w(ks[2], (D, 3 * W_A + 3 * W_B), D),
        "a0_w_out": w(ks[3], (W_A + W_B, D), W_A + W_B),
        "a0_rpb": 0.1 * jax.random.normal(ks[4], (N_HEADS_B, 2 * NA_ROWS - 1, 2 * NA_COLS - 1), f32),
        "f0_norm": gain(ks[5], D),
        "f0_w_gate": w(ks[6], (D, D_FF), D),
        "f0_w_up": w(ks[7], (D, D_FF), D),
        "f0_w_down": w(ks[8], (D_FF, D), D_FF),
        "a1_norm": gain(ks[9], D),
        "a1_w_qkv": w(ks[10], (D, 3 * WC), D),
        "a1_w_out": w(ks[11], (WC, D), WC),
        "a1_lam_q1": 0.1 * jax.random.normal(ks[12], (HEAD_DIM,), f32),
        "a1_lam_k1": 0.1 * jax.random.normal(ks[13], (HEAD_DIM,), f32),
        "a1_lam_q2": 0.1 * jax.random.normal(ks[14], (HEAD_DIM,), f32),
        "a1_lam_k2": 0.1 * jax.random.normal(ks[15], (HEAD_DIM,), f32),
        "a1_subln": gain(ks[16], 2 * HEAD_DIM),
        "f1_norm": gain(ks[17], D),
        "f1_w_gate": w(ks[18], (D, D_FF), D),
        "f1_w_up": w(ks[19], (D, D_FF), D),
        "f1_w_down": w(ks[20], (D_FF, D), D_FF),
        "final_norm": gain(ks[21], D),
    }


def reference(x, a0_norm, a0_w_in, a0_w_out, a0_rpb, f0_norm, f0_w_gate, f0_w_up, f0_w_down,
              a1_norm, a1_w_qkv, a1_w_out, a1_lam_q1, a1_lam_k1, a1_lam_q2, a1_lam_k2, a1_subln,
              f1_norm, f1_w_gate, f1_w_up, f1_w_down, final_norm):
    ffn_params = [(f0_norm, f0_w_gate, f0_w_up, f0_w_down),
                  (f1_norm, f1_w_gate, f1_w_up, f1_w_down)]
    for layer in range(DEPTH):
        if layer % 2 == 0:
            x = x + even_mixer(rmsnorm(x, a0_norm), a0_w_in, a0_w_out, a0_rpb)
        else:
            x = x + odd_mixer(rmsnorm(x, a1_norm), a1_w_qkv, a1_w_out,
                              a1_lam_q1, a1_lam_k1, a1_lam_q2, a1_lam_k2, a1_subln, layer)
        g, wg, wu, wd = ffn_params[layer]
        x = x + swiglu(rmsnorm(x, g), wg, wu, wd)
    return rmsnorm(x, final_norm)
```

```cpp
#include <hip/hip_runtime.h>
#include <hip/hip_cooperative_groups.h>
#include <cstdio>
#include <cstdint>
namespace cg = cooperative_groups;
#ifndef MK_DUP_MASK
#define MK_DUP_MASK 0x0
#endif
#ifndef MK_ONE_LAUNCH
#define MK_ONE_LAUNCH 1
#endif
namespace pg8 {
#define PG8_LAS __attribute__((address_space(3)))
typedef unsigned short bf16_t;
typedef short bf16x8 __attribute__((ext_vector_type(8)));
typedef float f32x4 __attribute__((ext_vector_type(4)));
typedef unsigned u32x4 __attribute__((ext_vector_type(4)));
constexpr int BM = 256, BK = 64, HALF = 128, HTB = HALF * BK * 2  , STAGE_BYTES = 8 * HTB, NXCD = 8, WGM = 8;

__host__ __device__ __forceinline__ int lds_byte(int r, int c) { const int st = (r >> 4) * 2 + (c >> 5), rr = r & 15, cc = c & 31, ob = rr * 64 + cc * 2; return st * 1024 + (ob ^ (((ob >> 9) & 1) << 5)); }
__host__ __device__ __forceinline__ void stage_rc(int b, int& R, int& C) { const int st = b / 1024, sb = b % 1024, swz = sb ^ (((sb >> 9) & 1) << 5); R = (st >> 1) * 16 + swz / 64; C = (st & 1) * 32 + (swz % 64) / 2; }
__host__ __device__ __forceinline__ int perm32(int rho) { const int n = rho >> 4, i = rho & 15; return 8 * (i >> 2) + 4 * n + (i & 3); }

struct Unit { int pm, pn; };
struct Gemm { const bf16_t* A; const bf16_t* Bt; int M, N, K; };

struct StaticOrder {
    int nM, nN, nwg, G, c;
    __host__ __device__ void init(int M, int N, int G_, int c_) { nM = M / BM; nN = N / BM; nwg = nM * nN; G = G_; c = c_; }
    __host__ __device__ bool next(int i, Unit& u) const {
        const long L = (long)i * G + c; if (L >= nwg) return false;
        int wgid = (int)L; { const int q = nwg / NXCD, r = nwg % NXCD, xcd = wgid % NXCD, off = wgid / NXCD; wgid = (xcd < r ? xcd * (q + 1) : r * (q + 1) + (xcd - r) * q) + off; }
        const int nig = WGM * nN, gid = wgid / nig, fm = gid * WGM, gsz = (nM - fm) < WGM ? (nM - fm) : WGM;
        u.pm = fm + ((wgid % nig) % gsz); u.pn = (wgid % nig) / gsz; return true;
    }
    __device__ __forceinline__ void a_ready(const Unit&) const {}
    __device__ __forceinline__ void done(const Unit&) const {}
};

__device__ __forceinline__ unsigned cvt_pk_bf16(float lo, float hi) { unsigned r; asm volatile("v_cvt_pk_bf16_f32 %0, %1, %2" : "=v"(r) : "v"(lo), "v"(hi)); return r; }
typedef float f32x2 __attribute__((ext_vector_type(2)));
template <class Epi, class Sched, bool ALIGN_EPI = false, bool SP2 = false>
__device__ __forceinline__ void gemm_phase(PG8_LAS unsigned char* lds, const Gemm g, const Sched& S, const Epi& E) {
    int tid_ = threadIdx.x; asm volatile("" : "+v"(tid_));
    const int tid = tid_, wid = __builtin_amdgcn_readfirstlane(tid >> 6), lane = tid & 63, wr = wid >> 2, wc = wid & 3, fr = lane & 15, fq = lane >> 4;
    const int K = g.K, nt = K / BK;
    unsigned voffA[2], voffB[2];
#pragma unroll
    for (int i = 0; i < 2; ++i) { int R, C; stage_rc(tid * 16 + i * 8192, R, C); const int Rb = Epi::PERM ? ((R & ~31) + perm32(R & 31)) : R;
        voffA[i] = (unsigned)(R * K + C) * 2u; voffB[i] = (unsigned)(Rb * K + C) * 2u; }
    const size_t kstep = (size_t)(BK * 2);
    const size_t hstep = (size_t)HALF * K * 2;
    const size_t tstep = 2 * hstep;
    const unsigned ldsw = (unsigned)wid * 1024u;
    const int aoff = lds_byte(wr * 64 + fr, fq * 8), boff = lds_byte(wc * 32 + fr, fq * 8);
#define PG8_SA(b, h) (((b) * 2 + (h)) * HTB)
#define PG8_SB(b, h) ((4 + (b) * 2 + (h)) * HTB)
#define PG8_STAGE(bufoff, gbase, voff) do { _Pragma("unroll") for (int _i = 0; _i < 2; ++_i) \
        __builtin_amdgcn_global_load_lds((const unsigned*)((const char*)(gbase) + (voff)[_i]), (PG8_LAS unsigned*)(lds + (bufoff) + ldsw + _i * 8192), 16, 0, 0); } while (0)
#define PG8_LDA(dst, b, h) do { _Pragma("unroll") for (int m = 0; m < 4; ++m) _Pragma("unroll") for (int k = 0; k < 2; ++k) dst[m][k] = *(const PG8_LAS bf16x8*)(lds + PG8_SA(b, h) + aoff + m * 2048 + k * 1024); } while (0)
#define PG8_LDB(dst, b, h) do { _Pragma("unroll") for (int n = 0; n < 2; ++n) _Pragma("unroll") for (int k = 0; k < 2; ++k) dst[n][k] = *(const PG8_LAS bf16x8*)(lds + PG8_SB(b, h) + boff + n * 2048 + k * 1024); } while (0)
#define PG8_MMA(ai, bj, At, Bt) do { __builtin_amdgcn_s_setprio(1); _Pragma("unroll") for (int m = 0; m < 4; ++m) _Pragma("unroll") for (int n = 0; n < 2; ++n) _Pragma("unroll") for (int k = 0; k < 2; ++k) \
        acc[ai][bj][m][n] = __builtin_amdgcn_mfma_f32_16x16x32_bf16(Bt[n][k], At[m][k], acc[ai][bj][m][n], 0, 0, 0); __builtin_amdgcn_s_setprio(0); } while (0)
#define PG8_WAIT_V(n) asm volatile("s_waitcnt vmcnt(" #n ")" ::: "memory")
#define PG8_WAIT_L(n) asm volatile("s_waitcnt lgkmcnt(" #n ")" ::: "memory")
#define PG8_BAR __builtin_amdgcn_s_barrier()
#define PG8_SCHED __builtin_amdgcn_sched_barrier(0)
    Unit cur, nxt; int ui = 0;
    if (!S.next(0, cur)) return;
    f32x4 acc[2][2][4][2];
#pragma unroll
    for (int a = 0; a < 2; ++a)
#pragma unroll
        for (int b = 0; b < 2; ++b)
#pragma unroll
            for (int m = 0; m < 4; ++m)
#pragma unroll
                for (int n = 0; n < 2; ++n) acc[a][b][m][n] = (f32x4){0.f, 0.f, 0.f, 0.f};
    bf16x8 At[4][2], B0[2][2], B1[2][2];
    const char* cA = (const char*)g.A + (size_t)cur.pm * tstep; const char* cB = (const char*)g.Bt + (size_t)cur.pn * tstep;
    S.a_ready(cur);
    if constexpr (SP2) {
        PG8_STAGE(PG8_SB(0, 0), cB, voffB); PG8_STAGE(PG8_SB(0, 1), cB + hstep, voffB); PG8_STAGE(PG8_SA(0, 0), cA, voffA); PG8_STAGE(PG8_SA(0, 1), cA + hstep, voffA);
        if (wr == 1) PG8_BAR;
        PG8_WAIT_V(2); PG8_BAR;
        PG8_STAGE(PG8_SB(1, 0), cB + kstep, voffB); PG8_STAGE(PG8_SA(1, 0), cA + kstep, voffA); PG8_STAGE(PG8_SB(1, 1), cB + hstep + kstep, voffB);
        PG8_WAIT_V(6); PG8_BAR;
    } else {
        PG8_STAGE(PG8_SB(0, 0), cB, voffB); PG8_STAGE(PG8_SA(0, 0), cA, voffA); PG8_STAGE(PG8_SB(0, 1), cB + hstep, voffB); PG8_STAGE(PG8_SA(0, 1), cA + hstep, voffA);
        if (wr == 1) PG8_BAR;
        PG8_WAIT_V(4); PG8_BAR;
        PG8_STAGE(PG8_SB(1, 0), cB + kstep, voffB); PG8_STAGE(PG8_SA(1, 0), cA + kstep, voffA); PG8_STAGE(PG8_SB(1, 1), cB + hstep + kstep, voffB);
        PG8_WAIT_V(6); PG8_BAR;
    }
    for (;;) {
        const bool has_next = S.next(ui + 1, nxt);
        const char* nA = has_next ? (const char*)g.A + (size_t)nxt.pm * tstep : cA; const char* nB = has_next ? (const char*)g.Bt + (size_t)nxt.pn * tstep : cB;
        for (int t = 0; t < nt; t += 2) {
            const bool last = (t == nt - 2);
            const char* a1 = cA + (size_t)(t + 1) * kstep;
            const char* a2 = last ? nA : cA + (size_t)(t + 2) * kstep; const char* b2 = last ? nB : cB + (size_t)(t + 2) * kstep;
            const char* a3 = a2 + kstep; const char* b3 = b2 + kstep;
            if (last && has_next) S.a_ready(nxt);
            if constexpr (SP2) {
            PG8_LDB(B0, 0, 0); PG8_LDB(B1, 0, 1); PG8_SCHED; PG8_LDA(At, 0, 0); PG8_STAGE(PG8_SA(1, 1), a1 + hstep, voffA);
            PG8_WAIT_V(8); PG8_WAIT_L(0); PG8_BAR; PG8_MMA(0, 0, At, B0); PG8_MMA(0, 1, At, B1); PG8_BAR; PG8_SCHED;
            PG8_LDA(At, 0, 1); PG8_STAGE(PG8_SB(0, 0), b2, voffB); PG8_STAGE(PG8_SB(0, 1), b2 + hstep, voffB); PG8_STAGE(PG8_SA(0, 0), a2, voffA);
            PG8_WAIT_V(8); PG8_WAIT_L(0); PG8_BAR; PG8_MMA(1, 0, At, B0); PG8_MMA(1, 1, At, B1); PG8_BAR; PG8_SCHED;
            PG8_LDB(B0, 1, 0); PG8_LDB(B1, 1, 1); PG8_SCHED; PG8_LDA(At, 1, 0); PG8_STAGE(PG8_SA(0, 1), a2 + hstep, voffA);
            PG8_WAIT_V(8); PG8_WAIT_L(0); PG8_BAR; PG8_MMA(0, 0, At, B0); PG8_MMA(0, 1, At, B1); PG8_BAR; PG8_SCHED;
            PG8_LDA(At, 1, 1); PG8_STAGE(PG8_SB(1, 0), b3, voffB); PG8_STAGE(PG8_SB(1, 1), b3 + hstep, voffB); PG8_STAGE(PG8_SA(1, 0), a3, voffA);
            PG8_WAIT_V(8); PG8_WAIT_L(0); PG8_BAR; PG8_MMA(1, 0, At, B0); PG8_MMA(1, 1, At, B1); PG8_BAR; PG8_SCHED;
            } else {
            PG8_LDB(B0, 0, 0); PG8_SCHED; PG8_LDA(At, 0, 0); PG8_STAGE(PG8_SA(1, 1), a1 + hstep, voffA);
            PG8_WAIT_L(8); PG8_BAR; PG8_WAIT_L(0); PG8_MMA(0, 0, At, B0); PG8_BAR; PG8_SCHED;
            PG8_LDB(B1, 0, 1); PG8_STAGE(PG8_SB(0, 0), b2, voffB);
            PG8_BAR; PG8_WAIT_L(0); PG8_MMA(0, 1, At, B1); PG8_BAR;
            PG8_LDA(At, 0, 1); PG8_STAGE(PG8_SA(0, 0), a2, voffA);
            PG8_BAR; PG8_WAIT_L(0); PG8_MMA(1, 0, At, B0); PG8_BAR; PG8_SCHED;
            PG8_STAGE(PG8_SB(0, 1), b2 + hstep, voffB);
            PG8_WAIT_V(6); PG8_BAR; PG8_MMA(1, 1, At, B1); PG8_BAR;
            PG8_LDB(B0, 1, 0); PG8_SCHED; PG8_LDA(At, 1, 0); PG8_STAGE(PG8_SA(0, 1), a2 + hstep, voffA);
            PG8_WAIT_L(8); PG8_BAR; PG8_WAIT_L(0); PG8_MMA(0, 0, At, B0); PG8_BAR; PG8_SCHED;
            PG8_LDB(B1, 1, 1); PG8_STAGE(PG8_SB(1, 0), b3, voffB);
            PG8_BAR; PG8_WAIT_L(0); PG8_MMA(0, 1, At, B1); PG8_BAR;
            PG8_LDA(At, 1, 1); PG8_STAGE(PG8_SA(1, 0), a3, voffA);
            PG8_BAR; PG8_WAIT_L(0); PG8_MMA(1, 0, At, B0); PG8_BAR; PG8_SCHED;
            PG8_STAGE(PG8_SB(1, 1), b3 + hstep, voffB);
            PG8_WAIT_V(6); PG8_BAR; PG8_MMA(1, 1, At, B1); PG8_BAR;
            }
        }
        if constexpr (ALIGN_EPI) { if (wr == 0) PG8_BAR; }
        if constexpr (!Epi::AFTER_DRAIN) { E(acc, cur, wr, wc, fr, fq); S.done(cur); }
        if (!has_next) break;
#pragma unroll
        for (int a = 0; a < 2; ++a)
#pragma unroll
            for (int b = 0; b < 2; ++b)
#pragma unroll
                for (int m = 0; m < 4; ++m)
#pragma unroll
                    for (int n = 0; n < 2; ++n) acc[a][b][m][n] = (f32x4){0.f, 0.f, 0.f, 0.f};
        cur = nxt; cA = nA; cB = nB; ++ui;
        if constexpr (ALIGN_EPI) { if (wr == 1) PG8_BAR; }
    }
    PG8_WAIT_V(0);
    if constexpr (!ALIGN_EPI) { if (wr == 0) PG8_BAR; }
    PG8_BAR;
    if constexpr (Epi::AFTER_DRAIN) { E.fused(acc, cur, wr, wc, fr, fq, lds, wid, lane); S.done(cur); }
#undef PG8_SA
#undef PG8_SB
#undef PG8_STAGE
#undef PG8_LDA
#undef PG8_LDB
#undef PG8_MMA
#undef PG8_WAIT_V
#undef PG8_WAIT_L
#undef PG8_BAR
#undef PG8_SCHED
}
}

constexpr int BATCH = 16, T = 4096, D = 1024, M = BATCH * T, NQKV = 3072, FF = 2816, NGU = 2 * FF;
constexpr float RMS_EPS = 1e-6f, SUBLN_EPS = 1e-5f;
constexpr float LOG2E = 1.4426950408889634f;
constexpr float QSCALE = 0.125f * LOG2E;
constexpr float LAM_INIT = 0.35550906f;

#define LAS __attribute__((address_space(3)))
typedef unsigned short bf16_t;
typedef short bf16x8 __attribute__((ext_vector_type(8)));
typedef short s16x4 __attribute__((ext_vector_type(4)));
typedef float f32x4 __attribute__((ext_vector_type(4)));
typedef float f32x16 __attribute__((ext_vector_type(16)));
typedef unsigned u32x4 __attribute__((ext_vector_type(4)));
typedef unsigned u32x2 __attribute__((ext_vector_type(2)));

__device__ __forceinline__ unsigned cvtpk(float lo, float hi) { unsigned r; asm volatile("v_cvt_pk_bf16_f32 %0, %1, %2" : "=v"(r) : "v"(lo), "v"(hi)); return r; }
__device__ __forceinline__ float sx(float v, int mask, int lane) { return __int_as_float(__builtin_amdgcn_ds_bpermute((lane ^ mask) << 2, __float_as_int(v))); }
__device__ __forceinline__ float bf2f(unsigned short u) { return __uint_as_float((unsigned)u << 16); }

namespace pg8 {
__device__ __forceinline__ float row_rs(const float* ss, int row, int fq, int fr) {
#ifdef TRIV_EPI
    return 1.0f;
#endif
    const f32x4 a = *(const f32x4*)(ss + (size_t)row * 16 + 4 * fq);
    float s = (a[0] + a[1]) + (a[2] + a[3]);
    const int ln = fq * 16 + fr; s += sx(s, 16, ln); s += sx(s, 32, ln);
    return 1.0f / sqrtf(s * (1.0f / D) + RMS_EPS);
}
struct EpiScaleBf16 {
    static constexpr bool PERM = true, AFTER_DRAIN = false;
    bf16_t* O; int ldc; const float* ss; unsigned qmask;
    __device__ __forceinline__ void operator()(const f32x4 (&acc)[2][2][4][2], const Unit& u, int wr, int wc, int fr, int fq) const {
        const int row0 = u.pm * BM + wr * 64 + fr, col0 = u.pn * BM + wc * 32 + 8 * fq;
        const float qs = ((qmask >> u.pn) & 1u) ? QSCALE : 1.0f;
#pragma unroll
        for (int ai = 0; ai < 2; ++ai)
#pragma unroll
            for (int m = 0; m < 4; ++m) { const int row = row0 + ai * HALF + m * 16; const float rs = row_rs(ss, row, fq, fr) * qs;
                bf16_t* rowp = O + (size_t)row * ldc + col0;
#pragma unroll
                for (int bj = 0; bj < 2; ++bj) { const f32x4 v0 = acc[ai][bj][m][0] * rs, v1 = acc[ai][bj][m][1] * rs;
                    u32x4 w; w.x = cvt_pk_bf16(v0[0], v0[1]); w.y = cvt_pk_bf16(v0[2], v0[3]); w.z = cvt_pk_bf16(v1[0], v1[1]); w.w = cvt_pk_bf16(v1[2], v1[3]);
                    *(u32x4*)(rowp + bj * HALF) = w; }
                if (m & 1) asm volatile("" ::: "memory"); }
    }
};
struct EpiSwiGLU {
    static constexpr bool PERM = true, AFTER_DRAIN = false;
    bf16_t* H; const float* ss;
    __device__ __forceinline__ void operator()(const f32x4 (&acc)[2][2][4][2], const Unit& u, int wr, int wc, int fr, int fq) const {
        const int row0 = u.pm * BM + wr * 64 + fr, col0 = u.pn * HALF + wc * 32 + 8 * fq;
#pragma unroll
        for (int ai = 0; ai < 2; ++ai)
#pragma unroll
            for (int m = 0; m < 4; ++m) { const int row = row0 + ai * HALF + m * 16; const float rs = row_rs(ss, row, fq, fr);
                float o[8];
#pragma unroll
                for (int n = 0; n < 2; ++n)
#pragma unroll
                    for (int e = 0; e < 4; ++e) { const float g = acc[ai][0][m][n][e] * rs, up = acc[ai][1][m][n][e] * rs;
                        o[n * 4 + e] = g * __builtin_amdgcn_rcpf(1.0f + __builtin_amdgcn_exp2f(-g * LOG2E)) * up; }
                u32x4 w; w.x = cvt_pk_bf16(o[0], o[1]); w.y = cvt_pk_bf16(o[2], o[3]); w.z = cvt_pk_bf16(o[4], o[5]); w.w = cvt_pk_bf16(o[6], o[7]);
                *(u32x4*)(H + (size_t)row * FF + col0) = w;
                if (m & 1) asm volatile("" ::: "memory"); }
    }
};
struct EpiResid {
    static constexpr bool PERM = true, AFTER_DRAIN = false;
    const float* bf; float* of; bf16_t* hi; bf16_t* lo; float* ss;
    __device__ __forceinline__ void operator()(const f32x4 (&acc)[2][2][4][2], const Unit& u, int wr, int wc, int fr, int fq) const {
        const int row0 = u.pm * BM + wr * 64 + fr, col0 = u.pn * BM + wc * 32 + 8 * fq;
#pragma unroll
        for (int ai = 0; ai < 2; ++ai)
#pragma unroll
            for (int m = 0; m < 4; ++m) { const int row = row0 + ai * HALF + m * 16; const size_t off = (size_t)row * D + col0; float sq = 0.f;
#pragma unroll
                for (int bj = 0; bj < 2; ++bj) { const size_t o2 = off + bj * HALF; f32x4 v0, v1;
                    if (bf) { v0 = *(const f32x4*)(bf + o2); v1 = *(const f32x4*)(bf + o2 + 4); }
                    else { const u32x4 h = *(const u32x4*)(hi + o2), l = *(const u32x4*)(lo + o2);
                        v0[0] = __uint_as_float(h.x << 16) + __uint_as_float(l.x << 16); v0[1] = __uint_as_float(h.x & 0xffff0000u) + __uint_as_float(l.x & 0xffff0000u);
                        v0[2] = __uint_as_float(h.y << 16) + __uint_as_float(l.y << 16); v0[3] = __uint_as_float(h.y & 0xffff0000u) + __uint_as_float(l.y & 0xffff0000u);
                        v1[0] = __uint_as_float(h.z << 16) + __uint_as_float(l.z << 16); v1[1] = __uint_as_float(h.z & 0xffff0000u) + __uint_as_float(l.z & 0xffff0000u);
                        v1[2] = __uint_as_float(h.w << 16) + __uint_as_float(l.w << 16); v1[3] = __uint_as_float(h.w & 0xffff0000u) + __uint_as_float(l.w & 0xffff0000u); }
                    v0 = v0 + acc[ai][bj][m][0]; v1 = v1 + acc[ai][bj][m][1];
                    if (of) { *(f32x4*)(of + o2) = v0; *(f32x4*)(of + o2 + 4) = v1; }
                    else { u32x4 w; w.x = cvt_pk_bf16(v0[0], v0[1]); w.y = cvt_pk_bf16(v0[2], v0[3]); w.z = cvt_pk_bf16(v1[0], v1[1]); w.w = cvt_pk_bf16(v1[2], v1[3]);
                        u32x4 r; r.x = cvt_pk_bf16(v0[0] - __uint_as_float(w.x << 16), v0[1] - __uint_as_float(w.x & 0xffff0000u)); r.y = cvt_pk_bf16(v0[2] - __uint_as_float(w.y << 16), v0[3] - __uint_as_float(w.y & 0xffff0000u));
                        r.z = cvt_pk_bf16(v1[0] - __uint_as_float(w.z << 16), v1[1] - __uint_as_float(w.z & 0xffff0000u)); r.w = cvt_pk_bf16(v1[2] - __uint_as_float(w.w << 16), v1[3] - __uint_as_float(w.w & 0xffff0000u));
                        *(u32x4*)(hi + o2) = w; *(u32x4*)(lo + o2) = r; }
                    sq += ((v0[0] * v0[0] + v0[1] * v0[1]) + (v0[2] * v0[2] + v0[3] * v0[3])) + ((v1[0] * v1[0] + v1[1] * v1[1]) + (v1[2] * v1[2] + v1[3] * v1[3])); }
                { const int ln = fq * 16 + fr; sq += sx(sq, 16, ln); sq += sx(sq, 32, ln); }
                if (fq == 0) ss[(size_t)row * 16 + u.pn * 4 + wc] = sq;
                asm volatile("" ::: "memory"); }
    }
};
}

namespace at {
constexpr float THR = 8.0f;
__device__ __forceinline__ int crow(int r, int hi) { return (r & 3) + 8 * (r >> 2) + 4 * hi; }
template <int NB> __device__ __forceinline__ int v_st(int k, int c) { const int kk = (k & ~0xC) | ((k & 4) << 1) | ((k & 8) >> 1); return ((kk >> 3) * NB + (c >> 5)) * 512 + ((kk & 7) * 32 + (c & 31)) * 2; }
__device__ __forceinline__ int v_rd_base(int lane) { return ((lane & 3) << 3) | (((lane >> 2) & 3) << 6) | (((lane >> 4) & 1) << 5) | (((lane >> 5) & 1) << 8); }
template <int NB> constexpr int v_rd_off(int d0, int ks, int half) { return d0 * 512 + ks * (NB * 1024) + half * (NB * 512); }
template <int OFF> __device__ __forceinline__ s16x4 tr_read(int vb) { s16x4 r; asm volatile("ds_read_b64_tr_b16 %0, %1 offset:%2" : "=&v"(r) : "v"(vb), "i"(OFF) : "memory"); return r; }
template <int NB, int D0> __device__ __forceinline__ void pv_one(f32x16& od, int vb, bf16x8 pa0, bf16x8 pa1, bf16x8 pa2, bf16x8 pa3) {
    const s16x4 l0 = tr_read<v_rd_off<NB>(D0, 0, 0)>(vb), h0 = tr_read<v_rd_off<NB>(D0, 0, 1)>(vb), l1 = tr_read<v_rd_off<NB>(D0, 1, 0)>(vb), h1 = tr_read<v_rd_off<NB>(D0, 1, 1)>(vb);
    const s16x4 l2 = tr_read<v_rd_off<NB>(D0, 2, 0)>(vb), h2 = tr_read<v_rd_off<NB>(D0, 2, 1)>(vb), l3 = tr_read<v_rd_off<NB>(D0, 3, 0)>(vb), h3 = tr_read<v_rd_off<NB>(D0, 3, 1)>(vb);
    asm volatile("s_waitcnt lgkmcnt(0)" ::: "memory"); __builtin_amdgcn_sched_barrier(0);
#define AT_PK(L, H) (bf16x8){L[0], L[1], L[2], L[3], H[0], H[1], H[2], H[3]}
    od = __builtin_amdgcn_mfma_f32_32x32x16_bf16(pa0, AT_PK(l0, h0), od, 0, 0, 0);
    od = __builtin_amdgcn_mfma_f32_32x32x16_bf16(pa1, AT_PK(l1, h1), od, 0, 0, 0);
    od = __builtin_amdgcn_mfma_f32_32x32x16_bf16(pa2, AT_PK(l2, h2), od, 0, 0, 0);
    od = __builtin_amdgcn_mfma_f32_32x32x16_bf16(pa3, AT_PK(l3, h3), od, 0, 0, 0);
#undef AT_PK
}
__device__ __forceinline__ float slope_of(int h) { return __builtin_amdgcn_exp2f(-(float)(h + 1)); }

constexpr int L_SCR = 65536, L_TBL = 67584, L_X = 69632;

struct Ptrs { const bf16_t* qkv; bf16_t* att; bf16_t* obr; float* lse; const float* rpb; const float* subln; float lam; const float* kn; };

struct PolDil {
    static constexpr int W = 64, KIND = 0;
    int b, h, br, dil, res, qs0, tlo, thi; float nsl;
    __device__ __forceinline__ void init(int u) {
        br = u >> 11; const int v = u & 2047, sub = v & 15, bh = v >> 4; b = bh >> 3; h = bh & 7;
        dil = br == 0 ? 1 : (br == 1 ? 4 : 16); const int L = T / dil, nqb = L / 256;
        res = sub / nqb; qs0 = (sub % nqb) * 256;
        tlo = qs0 > 0 ? 0 : 1; thi = (qs0 + 256 < L) ? 6 : 5;
        nsl = -slope_of(h) * (float)dil * LOG2E;
    }
    __device__ __forceinline__ long qtok(int wid, int i) const { return (long)b * T + res + dil * (qs0 + 32 * wid + i); }
    __device__ __forceinline__ int qcol(int) const { return h * 64; }
    __device__ __forceinline__ int kcol0() const { return 512 + h * 64; }
    __device__ __forceinline__ int vcol0() const { return 1024 + h * 64; }
    __device__ __forceinline__ int kfrag(int) const { return 0; }
    __device__ __forceinline__ long ktok(int t, int row) const { return (long)b * T + res + dil * (qs0 - 64 + 64 * t + row); }
    __device__ __forceinline__ bool need(int t, int wid) const { return (64 * t - 64 <= 32 * wid + 95) && (64 * t - 1 >= 32 * wid - 64); }
    __device__ __forceinline__ void cinit(f32x16& p0, f32x16& p1, int t, int wid, int r32, int hi, const LAS float*, float m) const {
        const float base = (float)(32 * wid + r32 + 64 - 64 * t - 4 * hi);
#pragma unroll
        for (int r = 0; r < 16; ++r) { const float c = (float)((r & 3) + 8 * (r >> 2));
            const float a0 = fabsf(base - c), a1 = fabsf(base - (c + 32.f));
            p0[r] = a0 <= 64.f ? nsl * a0 - m : -INFINITY; p1[r] = a1 <= 64.f ? nsl * a1 - m : -INFINITY; }
    }
};
struct PolNat {
    static constexpr int W = 64, KIND = 1;
    int b, h, qb, r0, kr0, tlo, thi;
    __device__ __forceinline__ static int clip(int v, int lo, int hi_) { return v < lo ? lo : (v > hi_ ? hi_ : v); }
    __device__ __forceinline__ void init(int u) {
        qb = u & 15; const int bh = u >> 4; b = bh >> 3; h = bh & 7; r0 = 4 * qb;
        kr0 = clip(r0 - 4, 0, 56); tlo = 0; thi = clip(r0 - 1, 0, 56) + 8 - kr0;
    }
    __device__ __forceinline__ long qtok(int wid, int i) const { return (long)b * T + 256 * qb + 32 * wid + i; }
    __device__ __forceinline__ int qcol(int) const { return 1536 + h * 64; }
    __device__ __forceinline__ int kcol0() const { return 2048 + h * 64; }
    __device__ __forceinline__ int vcol0() const { return 2560 + h * 64; }
    __device__ __forceinline__ int kfrag(int) const { return 0; }
    __device__ __forceinline__ long ktok(int t, int row) const { return (long)b * T + 64 * (kr0 + t) + row; }
    __device__ __forceinline__ bool need(int t, int wid) const { const int r = r0 + (wid >> 1), rs = clip(r - 4, 0, 56), kr = kr0 + t; return kr >= rs && kr < rs + 8; }
    __device__ __forceinline__ void cinit(f32x16& p0, f32x16& p1, int t, int wid, int r32, int hi, const LAS float* tbl, float m) const {
        const int r = r0 + (wid >> 1), kr = kr0 + t, c = 32 * (wid & 1) + r32, wc = clip(c - 8, 0, 48);
        const LAS float* trow = tbl + (kr - r + 7) * 32;
#pragma unroll
        for (int q = 0; q < 16; ++q) { const int k0 = (q & 3) + 8 * (q >> 2) + 4 * hi, k1 = k0 + 32;
            const float v0 = trow[clip(k0 - c + 15, 0, 30)], v1 = trow[clip(k1 - c + 15, 0, 30)];
            p0[q] = ((unsigned)(k0 - wc) < 16u) ? v0 - m : -INFINITY; p1[q] = ((unsigned)(k1 - wc) < 16u) ? v1 - m : -INFINITY; }
    }
};
struct PolDiff {
    static constexpr int W = 128, KIND = 2;
    int b, h, qb, tlo, thi; float nsl;
    __device__ __forceinline__ void init(int u) { const int k = u >> 8, c0 = u & 255, c = (c0 & 7) * 32 + (c0 >> 3)  , r = (k >> 3) * 256 + c; h = k & 7; b = r >> 5; qb = r & 31; tlo = 0; thi = T / 64; nsl = -slope_of(h) * LOG2E; }
    __device__ __forceinline__ long qtok(int wid, int i) const { return (long)b * T + 128 * qb + 32 * (wid & 3) + i; }
    __device__ __forceinline__ int qcol(int wid) const { return h * 128 + 64 * (wid >> 2); }
    __device__ __forceinline__ int kcol0() const { return 1024 + h * 128; }
    __device__ __forceinline__ int vcol0() const { return 2048 + h * 128; }
    __device__ __forceinline__ int kfrag(int wid) const { return 64 * (wid >> 2); }
    __device__ __forceinline__ long ktok(int t, int row) const { return (long)b * T + 64 * t + row; }
    __device__ __forceinline__ bool need(int, int) const { return true; }
    template <int BLK> __device__ __forceinline__ void cinit_off(f32x16& p, int t, int wid, int r32, int hi) const {
        const float base = (float)(128 * qb + 32 * (wid & 3) + r32 - 64 * t - 4 * hi - 32 * BLK);
        const float sn = t < 2 * qb ? nsl : -nsl, A = sn * base, cf = -sn;
#pragma unroll
        for (int r = 0; r < 16; ++r) p[r] = fmaf(cf, (float)((r & 3) + 8 * (r >> 2)), A);
    }
    template <int BLK> __device__ __forceinline__ void cinit_abs(f32x16& p, int t, int wid, int r32, int hi) const {
        const float base = (float)(128 * qb + 32 * (wid & 3) + r32 - 64 * t - 4 * hi - 32 * BLK);
#pragma unroll
        for (int r = 0; r < 16; ++r) p[r] = nsl * fabsf(base - (float)((r & 3) + 8 * (r >> 2)));
    }
    __device__ __forceinline__ void cinit(f32x16& p0, f32x16& p1, int t, int wid, int r32, int hi, const LAS float*, float m) const {
        const int i0 = 128 * qb + 32 * (wid & 3);
        const float base = (float)(i0 + r32 - 64 * t - 4 * hi);
        if (64 * t + 63 < i0) {
            const float A = nsl * base - m, n2 = -nsl;
#pragma unroll
            for (int r = 0; r < 16; ++r) { const float c = (float)((r & 3) + 8 * (r >> 2)); p0[r] = fmaf(n2, c, A); p1[r] = fmaf(n2, c + 32.f, A); }
        } else if (64 * t > i0 + 31) {
            const float A = -nsl * base - m;
#pragma unroll
            for (int r = 0; r < 16; ++r) { const float c = (float)((r & 3) + 8 * (r >> 2)); p0[r] = fmaf(nsl, c, A); p1[r] = fmaf(nsl, c + 32.f, A); }
        } else {
#pragma unroll
            for (int r = 0; r < 16; ++r) { const float c = (float)((r & 3) + 8 * (r >> 2));
                p0[r] = nsl * fabsf(base - c) - m; p1[r] = nsl * fabsf(base - (c + 32.f)) - m; }
        }
    }
};

template <class Pol> __device__ __forceinline__ void attn_unit(const Pol& P, LAS unsigned char* lds, const Ptrs& X, bf16x8& pq0, bf16x8& pq1, bf16x8& pq2, bf16x8& pq3, bf16x8& pk_, bf16x8& pv_, bool have, const Pol& Pn, bool hasn);
template <class Pol>
__device__ __forceinline__ void attn_unit(const Pol& P, LAS unsigned char* lds, const Ptrs& X, bf16x8& pq0, bf16x8& pq1, bf16x8& pq2, bf16x8& pq3, bf16x8& pk_, bf16x8& pv_, bool have, const Pol& Pn, bool hasn) {
    constexpr int W = Pol::W, NB = W / 32, CH = W / 64, KBYTES = 64 * W * 2, VBYTES = KBYTES, CPR = W / 8;
    int tid_ = threadIdx.x; asm volatile("" : "+v"(tid_));
    const int tid = tid_, wid = __builtin_amdgcn_readfirstlane(tid >> 6), lane = tid & 63, r32 = lane & 31, hi = lane >> 5;
    LAS unsigned char* K_lds = lds; LAS unsigned char* V_lds = lds + 2 * KBYTES;
    LAS float* li_l = (LAS float*)(lds + L_SCR) + wid * 64; LAS float* al_l = li_l + 32;
    LAS float* tbl = (LAS float*)(lds + L_TBL);
    const bf16_t* qkv = X.qkv;
    if constexpr (Pol::KIND == 1) { if (tid < 480) { const int row = tid >> 5, col = tid & 31; tbl[tid] = col < 31 ? X.rpb[(P.h * 15 + row) * 31 + col] * LOG2E : 0.f; } }
    bf16x8 qr[4];
    const bool pre_ok = Pol::KIND == 0 && have;
    if (pre_ok) {
        qr[0] = pq0; qr[1] = pq1; qr[2] = pq2; qr[3] = pq3;
    } else { const bf16_t* qp = qkv + P.qtok(wid, r32) * NQKV + P.qcol(wid) + hi * 8;
#pragma unroll
      for (int d0 = 0; d0 < 4; ++d0) qr[d0] = *(const bf16x8*)(qp + d0 * 16); }
    const int kfb = P.kfrag(wid) * 2;
    bf16x8 ks[CH], vs[CH];
#define AT_SLOAD(t) do { _Pragma("unroll") for (int i_ = 0; i_ < CH; ++i_) { const int id_ = tid + 512 * i_, row_ = id_ / CPR, col_ = (id_ % CPR) * 8; \
        const bf16_t* g_ = qkv + P.ktok((t), row_) * NQKV + col_; ks[i_] = *(const bf16x8*)(g_ + P.kcol0()); vs[i_] = *(const bf16x8*)(g_ + P.vcol0()); } } while (0)
#define AT_SWRITE(b) do { _Pragma("unroll") for (int i_ = 0; i_ < CH; ++i_) { const int id_ = tid + 512 * i_, row_ = id_ / CPR, col_ = (id_ % CPR) * 8; \
        *(LAS bf16x8*)(K_lds + (b) * KBYTES + row_ * (W * 2) + ((col_ * 2) ^ ((row_ & 7) << 4))) = ks[i_]; \
        *(LAS bf16x8*)(V_lds + (b) * VBYTES + v_st<NB>(row_, col_)) = vs[i_]; } } while (0)
    float m_reg = 0.f, l_reg = 0.f; f32x16 o[NB];
#pragma unroll
    for (int d = 0; d < NB; ++d) o[d] = f32x16{};
    const int vb0 = (int)(unsigned)(size_t)V_lds + v_rd_base(lane);
    const int tlo = P.tlo, thi = P.thi;
    if (pre_ok) { ks[0] = pk_; vs[0] = pv_; } else AT_SLOAD(tlo);
    AT_SWRITE(tlo & 1); __syncthreads();
    for (int t = tlo; t < thi; ++t) {
        const int buf = t & 1;
        if constexpr (Pol::KIND != 2) { if (t + 1 < thi) AT_SLOAD(t + 1); }
        if constexpr (Pol::KIND == 0) { if (t + 1 == thi && hasn) {
            const bf16_t* qp = qkv + Pn.qtok(wid, r32) * NQKV + Pn.qcol(wid) + hi * 8;
            pq0 = *(const bf16x8*)(qp); pq1 = *(const bf16x8*)(qp + 16); pq2 = *(const bf16x8*)(qp + 32); pq3 = *(const bf16x8*)(qp + 48);
            const int row_ = tid / CPR, col_ = (tid % CPR) * 8; const bf16_t* g_ = qkv + Pn.ktok(Pn.tlo, row_) * NQKV + col_;
            pk_ = *(const bf16x8*)(g_ + Pn.kcol0()); pv_ = *(const bf16x8*)(g_ + Pn.vcol0()); } }
        if (P.need(t, wid)) {
            f32x16 p0, p1;
            P.cinit(p0, p1, t, wid, r32, hi, tbl, m_reg);
            const LAS unsigned char* Kb = K_lds + buf * KBYTES;
#pragma unroll
            for (int d0 = 0; d0 < 4; ++d0) { const int cb = kfb + (d0 * 16 + hi * 8) * 2, sw = cb ^ ((r32 & 7) << 4);
                const bf16x8 b0 = *(const LAS bf16x8*)(Kb + r32 * (W * 2) + sw);
                const bf16x8 b1 = *(const LAS bf16x8*)(Kb + (32 + r32) * (W * 2) + sw);
                p0 = __builtin_amdgcn_mfma_f32_32x32x16_bf16(b0, qr[d0], p0, 0, 0, 0);
                p1 = __builtin_amdgcn_mfma_f32_32x32x16_bf16(b1, qr[d0], p1, 0, 0, 0); }
            float pmax = fmaxf(p0[0], p1[0]);
#pragma unroll
            for (int r = 1; r < 16; ++r) pmax = fmaxf(fmaxf(pmax, p0[r]), p1[r]);
            { auto rr = __builtin_amdgcn_permlane32_swap(__float_as_uint(pmax), __float_as_uint(pmax), false, false);
              pmax = fmaxf(__uint_as_float(rr[0]), __uint_as_float(rr[1])); }
            float alpha = 1.f;
            if (__builtin_expect(!__all(pmax <= THR), 0)) {
                const float dm = fmaxf(pmax, 0.f); alpha = __builtin_amdgcn_exp2f(-dm); m_reg += dm;
#pragma unroll
                for (int r = 0; r < 16; ++r) { p0[r] -= dm; p1[r] -= dm; }
            }
            float ps = 0.f;
#pragma unroll
            for (int r = 0; r < 16; ++r) { p0[r] = __builtin_amdgcn_exp2f(p0[r]); p1[r] = __builtin_amdgcn_exp2f(p1[r]); ps += p0[r] + p1[r]; }
            { auto rr = __builtin_amdgcn_permlane32_swap(__float_as_uint(ps), __float_as_uint(ps), false, false);
              ps = __uint_as_float(rr[0]) + __uint_as_float(rr[1]); }
            l_reg = l_reg * alpha + ps;
            if (__any(alpha < 1.f)) { if (hi == 0) al_l[r32] = alpha; asm volatile("s_waitcnt lgkmcnt(0)" ::: "memory");
#pragma unroll
                for (int r = 0; r < 16; ++r) { const float a = al_l[crow(r, hi)];
#pragma unroll
                    for (int d = 0; d < NB; ++d) o[d][r] *= a; }
                asm volatile("s_waitcnt lgkmcnt(0)" ::: "memory"); }
            bf16x8 pa0, pa1, pa2, pa3;
#define AT_PK4(PP, BASE, OUT) do { unsigned a0 = cvtpk(PP[BASE + 0], PP[BASE + 1]), a1 = cvtpk(PP[BASE + 2], PP[BASE + 3]); \
    unsigned b0_ = cvtpk(PP[BASE + 4], PP[BASE + 5]), b1_ = cvtpk(PP[BASE + 6], PP[BASE + 7]); \
    auto r0_ = __builtin_amdgcn_permlane32_swap(a0, b0_, false, false); auto r1_ = __builtin_amdgcn_permlane32_swap(a1, b1_, false, false); \
    u32x4 w_ = {r0_[0], r1_[0], r0_[1], r1_[1]}; OUT = *reinterpret_cast<bf16x8*>(&w_); } while (0)
            AT_PK4(p0, 0, pa0); AT_PK4(p0, 8, pa1); AT_PK4(p1, 0, pa2); AT_PK4(p1, 8, pa3);
#undef AT_PK4
            const int vb = vb0 + buf * VBYTES;
            pv_one<NB, 0>(o[0], vb, pa0, pa1, pa2, pa3); pv_one<NB, 1>(o[1], vb, pa0, pa1, pa2, pa3);
            if constexpr (NB == 4) { pv_one<NB, 2>(o[2], vb, pa0, pa1, pa2, pa3); pv_one<NB, 3>(o[3], vb, pa0, pa1, pa2, pa3); }
        }
        if (t + 1 < thi) { if constexpr (Pol::KIND == 2) AT_SLOAD(t + 1); AT_SWRITE(buf ^ 1); }
        __syncthreads();
    }
#undef AT_SLOAD
#undef AT_SWRITE
    if (hi == 0) li_l[r32] = l_reg;
    asm volatile("s_waitcnt lgkmcnt(0)" ::: "memory");
    float rli[16];
#pragma unroll
    for (int r = 0; r < 16; ++r) rli[r] = __builtin_amdgcn_rcpf(li_l[crow(r, hi)]);
    if constexpr (Pol::KIND == 0) {
        bf16_t* ob = X.obr + (size_t)P.br * ((size_t)M * 512);
#pragma unroll
        for (int r = 0; r < 16; ++r) { const long tok = P.qtok(wid, crow(r, hi));
#pragma unroll
            for (int d = 0; d < NB; ++d) ob[tok * 512 + P.h * 64 + d * 32 + r32] = (bf16_t)(cvtpk(o[d][r] * rli[r], 0.f) & 0xffffu); }
        if (hi == 0) X.lse[(size_t)P.br * ((size_t)M * 8) + P.qtok(wid, r32) * 8 + P.h] = m_reg + __builtin_amdgcn_logf(l_reg);
    } else if constexpr (Pol::KIND == 1) {
#pragma unroll
        for (int r = 0; r < 16; ++r) { const long tok = P.qtok(wid, crow(r, hi));
#pragma unroll
            for (int d = 0; d < NB; ++d) X.att[tok * D + 512 + P.h * 64 + d * 32 + r32] = (bf16_t)(cvtpk(o[d][r] * rli[r], 0.f) & 0xffffu); }
    } else {
        LAS float* XB = (LAS float*)(lds + L_X);
        if (wid >= 4) {
#pragma unroll
            for (int r = 0; r < 16; ++r) { const int row = 32 * (wid & 3) + crow(r, hi);
#pragma unroll
                for (int d = 0; d < NB; ++d) XB[row * 128 + d * 32 + r32] = X.lam * o[d][r] * rli[r]; }
        }
        __syncthreads();
        if (wid < 4) {
#pragma unroll
            for (int r = 0; r < 16; ++r) { const int row = 32 * wid + crow(r, hi); float s = 0.f;
#pragma unroll
                for (int d = 0; d < NB; ++d) { const float y = o[d][r] * rli[r] - XB[row * 128 + d * 32 + r32]; o[d][r] = y; s += y * y; }
                s += sx(s, 1, lane); s += sx(s, 2, lane); s += sx(s, 4, lane); s += sx(s, 8, lane); s += sx(s, 16, lane);
                const float rs = (1.0f - LAM_INIT) / sqrtf(s * (1.0f / 128.f) + SUBLN_EPS);
                const long tok = P.qtok(wid, crow(r, hi));
#pragma unroll
                for (int d = 0; d < NB; ++d) X.att[tok * D + P.h * 128 + d * 32 + r32] = (bf16_t)(cvtpk(o[d][r] * rs * X.subln[d * 32 + r32], 0.f) & 0xffffu); }
        }
        __syncthreads();
    }
}

template <class Pol> __device__ __forceinline__ void attn_unit(const Pol& P, LAS unsigned char* lds, const Ptrs& X) { bf16x8 z0_ = {}, z1_ = {}, z2_ = {}, z3_ = {}, z4_ = {}, z5_ = {}; attn_unit(P, lds, X, z0_, z1_, z2_, z3_, z4_, z5_, false, P, false); }
typedef __bf16 bf16x2_t __attribute__((ext_vector_type(2)));
typedef float f32x2_t __attribute__((ext_vector_type(2)));
__device__ __forceinline__ unsigned pk2(float lo, float hi) { const f32x2_t v = {lo, hi}; return __builtin_bit_cast(unsigned, __builtin_convertvector(v, bf16x2_t)); }
__device__ __forceinline__ s16x4 trb(const LAS unsigned char* p) { return __builtin_amdgcn_ds_read_tr16_b64_v4i16((LAS s16x4*)p); }
template <int D0> __device__ __forceinline__ void pv_blk(f32x16& od, const LAS unsigned char* vb, bf16x8 pa0, bf16x8 pa1, bf16x8 pa2, bf16x8 pa3) {
    constexpr int NB = 4;
    const s16x4 l0 = trb(vb + v_rd_off<NB>(D0, 0, 0)), h0 = trb(vb + v_rd_off<NB>(D0, 0, 1)), l1 = trb(vb + v_rd_off<NB>(D0, 1, 0)), h1 = trb(vb + v_rd_off<NB>(D0, 1, 1));
    const s16x4 l2 = trb(vb + v_rd_off<NB>(D0, 2, 0)), h2 = trb(vb + v_rd_off<NB>(D0, 2, 1)), l3 = trb(vb + v_rd_off<NB>(D0, 3, 0)), h3 = trb(vb + v_rd_off<NB>(D0, 3, 1));
#define AT_PK(L, H) (bf16x8){L[0], L[1], L[2], L[3], H[0], H[1], H[2], H[3]}
    od = __builtin_amdgcn_mfma_f32_32x32x16_bf16(pa0, AT_PK(l0, h0), od, 0, 0, 0);
    od = __builtin_amdgcn_mfma_f32_32x32x16_bf16(pa1, AT_PK(l1, h1), od, 0, 0, 0);
    od = __builtin_amdgcn_mfma_f32_32x32x16_bf16(pa2, AT_PK(l2, h2), od, 0, 0, 0);
    od = __builtin_amdgcn_mfma_f32_32x32x16_bf16(pa3, AT_PK(l3, h3), od, 0, 0, 0);
#undef AT_PK
}
constexpr int DF_SCR = 98304;
__device__ __forceinline__ void diff_unit(const PolDiff& P, LAS unsigned char* lds, const Ptrs& X) {
    constexpr int W = 128, NB = 4, CH = 2, KBYTES = 64 * W * 2, VBYTES = KBYTES, NT = T / 64;
    int tid_ = threadIdx.x; asm volatile("" : "+v"(tid_));
    const int tid = tid_, wid = __builtin_amdgcn_readfirstlane(tid >> 6), lane = tid & 63, r32 = lane & 31, hi = lane >> 5;
    LAS unsigned char* K_lds = lds; LAS unsigned char* V_lds = lds + 3 * KBYTES;
    LAS float* li_l = (LAS float*)(lds + DF_SCR) + wid * 64;
    LAS unsigned* flag = (LAS unsigned*)(lds + DF_SCR + 8 * 256);
    const bf16_t* qkv = X.qkv;
    bf16x8 qr[4];
    { const bf16_t* qp = qkv + P.qtok(wid, r32) * NQKV + P.qcol(wid) + hi * 8;
#pragma unroll
      for (int d0 = 0; d0 < 4; ++d0) qr[d0] = *(const bf16x8*)(qp + d0 * 16); }
    const int kfb = P.kfrag(wid) * 2;
    int gko, gvo;
    { const int row = 4 * wid + (lane >> 4), c = (lane & 15) ^ (row & 7); gko = row * NQKV + P.kcol0() + 8 * c; }
    { const int sidx = 2 * wid + (lane >> 5), kk = 8 * (sidx >> 2) + ((lane & 31) >> 2), k = (kk & ~0xC) | ((kk & 4) << 1) | ((kk & 8) >> 1), c = 32 * (sidx & 3) + 8 * (lane & 3);
      gvo = k * NQKV + P.vcol0() + c; }
    const bf16_t* gtile = qkv + (long)P.b * T * NQKV;
    const LAS unsigned char* krd = K_lds + r32 * (W * 2);
    const LAS unsigned char* vrd = V_lds + v_rd_base(lane);
    if (tid == 0) flag[0] = 0u;
    int t_lo, n_tiles;
    { float q2 = 0.f;
#pragma unroll
      for (int d0 = 0; d0 < 4; ++d0)
#pragma unroll
          for (int e = 0; e < 8; ++e) { const float f = bf2f((unsigned short)qr[d0][e]); q2 = fmaf(f, f, q2); }
      q2 += sx(q2, 32, lane);
#pragma unroll
      for (int o_ = 1; o_ < 32; o_ <<= 1) q2 = fmaxf(q2, sx(q2, o_, lane));
      if (lane == 0) li_l[0] = q2;
      __syncthreads();
      float qm1 = 0.f, qm2 = 0.f;
#pragma unroll
      for (int w_ = 0; w_ < 4; ++w_) { qm1 = fmaxf(qm1, ((LAS float*)(lds + DF_SCR))[w_ * 64]); qm2 = fmaxf(qm2, ((LAS float*)(lds + DF_SCR))[(w_ + 4) * 64]); }
      qm1 = sqrtf(qm1) * 1.01f; qm2 = sqrtf(qm2) * 1.01f;
      const float* kn = X.kn + ((P.b * 8 + P.h) * 2) * 64;
      const float sb = fmaxf(qm1 * kn[lane], qm2 * kn[64 + lane]);
      const int i0u = 128 * P.qb;
      const int dist = lane < 2 * P.qb ? i0u - (64 * lane + 63) : (lane > 2 * P.qb + 1 ? 64 * lane - (i0u + 127) : 0);
      const bool visit = sb + P.nsl * (float)dist > -152.f;
      const unsigned long long mask = __ballot(visit) | (3ull << (2 * P.qb));
      int lo = __builtin_ctzll(mask), hi_t = 63 - __builtin_clzll(mask);
      if (((hi_t - lo + 1) & 1) != 0) { if (lo > 0) --lo; else ++hi_t; }
      if (hi_t - lo + 1 < 4) { if (lo > 1) lo -= 2; else hi_t += 2; }
      t_lo = __builtin_amdgcn_readfirstlane(lo); n_tiles = __builtin_amdgcn_readfirstlane(hi_t - lo + 1);
      __syncthreads();
    }
#define DF_TL(k) ((k) < 2 ? 2 * P.qb + (k) : (t_lo + (k) - 2 < 2 * P.qb ? t_lo + (k) - 2 : t_lo + (k)))
#define DF_GLDS(k, rb) do { const bf16_t* g_ = gtile + (long)(64 * DF_TL(k)) * NQKV; _Pragma("unroll") for (int i_ = 0; i_ < 2; ++i_) { \
        __builtin_amdgcn_global_load_lds((const unsigned*)(g_ + gko + i_ * (32 * NQKV)), (LAS unsigned*)(K_lds + (rb) * KBYTES + (wid + 8 * i_) * 1024), 16, 0, 0); \
        __builtin_amdgcn_global_load_lds((const unsigned*)(g_ + gvo + i_ * (32 * NQKV)), (LAS unsigned*)(V_lds + (rb) * VBYTES + (wid + 8 * i_) * 1024), 16, 0, 0); } } while (0)
#define DF_QK(p0, p1, rb) do { const LAS unsigned char* Kb_ = krd + (rb) * KBYTES; \
        _Pragma("unroll") for (int d0 = 0; d0 < 4; ++d0) { const int sw_ = (kfb + (d0 * 16 + hi * 8) * 2) ^ ((r32 & 7) << 4); \
            const bf16x8 b0_ = *(const LAS bf16x8*)(Kb_ + sw_); const bf16x8 b1_ = *(const LAS bf16x8*)(Kb_ + 32 * (W * 2) + sw_); \
            p0 = __builtin_amdgcn_mfma_f32_32x32x16_bf16(b0_, qr[d0], p0, 0, 0, 0); p1 = __builtin_amdgcn_mfma_f32_32x32x16_bf16(b1_, qr[d0], p1, 0, 0, 0); } } while (0)
#define DF_KRD(b0v, b1v, rb, d0) do { const LAS unsigned char* Kb_ = krd + (rb) * KBYTES; const int sw_ = (kfb + ((d0) * 16 + hi * 8) * 2) ^ ((r32 & 7) << 4); \
        b0v = *(const LAS bf16x8*)(Kb_ + sw_); b1v = *(const LAS bf16x8*)(Kb_ + 32 * (W * 2) + sw_); } while (0)
#define DF_KMM(p0, p1, b0v, b1v, d0) do { p0 = __builtin_amdgcn_mfma_f32_32x32x16_bf16(b0v, qr[d0], p0, 0, 0, 0); p1 = __builtin_amdgcn_mfma_f32_32x32x16_bf16(b1v, qr[d0], p1, 0, 0, 0); } while (0)
#define DF_QK1(p0, p1, rb, d0) do { const LAS unsigned char* Kb_ = krd + (rb) * KBYTES; const int sw_ = (kfb + ((d0) * 16 + hi * 8) * 2) ^ ((r32 & 7) << 4); \
        const bf16x8 b0_ = *(const LAS bf16x8*)(Kb_ + sw_); const bf16x8 b1_ = *(const LAS bf16x8*)(Kb_ + 32 * (W * 2) + sw_); \
        p0 = __builtin_amdgcn_mfma_f32_32x32x16_bf16(b0_, qr[d0], p0, 0, 0, 0); p1 = __builtin_amdgcn_mfma_f32_32x32x16_bf16(b1_, qr[d0], p1, 0, 0, 0); } while (0)
#define DF_SUM16(p) ((((p[0] + p[1]) + (p[2] + p[3])) + ((p[4] + p[5]) + (p[6] + p[7]))) + (((p[8] + p[9]) + (p[10] + p[11])) + ((p[12] + p[13]) + (p[14] + p[15]))))
#define DF_EXP_H(pp, b8) do { _Pragma("unroll") for (int r = 0; r < 8; ++r) pp[(b8) + r] = __builtin_amdgcn_exp2f(pp[(b8) + r]); } while (0)
#define DF_EXP_A(p0, p1) do { _Pragma("unroll") for (int r = 0; r < 16; ++r) p0[r] = __builtin_amdgcn_exp2f(p0[r]); _Pragma("unroll") for (int r = 0; r < 8; ++r) p1[r] = __builtin_amdgcn_exp2f(p1[r]); } while (0)
#define DF_FINISH(p0, p1) do { _Pragma("unroll") for (int r = 8; r < 16; ++r) p1[r] = __builtin_amdgcn_exp2f(p1[r]); \
        float ps_ = 0.f; _Pragma("unroll") for (int r = 0; r < 16; ++r) ps_ += p0[r] + p1[r]; l_reg += ps_; \
        DF_PK4(p0, 0, pa0); DF_PK4(p0, 8, pa1); DF_PK4(p1, 0, pa2); DF_PK4(p1, 8, pa3); } while (0)
#define DF_PK4(PP, BASE, OUT) do { unsigned a0 = pk2(PP[BASE + 0], PP[BASE + 1]), a1 = pk2(PP[BASE + 2], PP[BASE + 3]); \
    unsigned b0_ = pk2(PP[BASE + 4], PP[BASE + 5]), b1_ = pk2(PP[BASE + 6], PP[BASE + 7]); \
    auto r0_ = __builtin_amdgcn_permlane32_swap(a0, b0_, false, false); auto r1_ = __builtin_amdgcn_permlane32_swap(a1, b1_, false, false); \
    u32x4 w_ = {r0_[0], r1_[0], r0_[1], r1_[1]}; OUT = *reinterpret_cast<bf16x8*>(&w_); } while (0)
#define DF_PV(rb) do { const LAS unsigned char* vb_ = vrd + (rb) * VBYTES; pv_blk<0>(o[0], vb_, pa0, pa1, pa2, pa3); pv_blk<1>(o[1], vb_, pa0, pa1, pa2, pa3); \
        pv_blk<2>(o[2], vb_, pa0, pa1, pa2, pa3); pv_blk<3>(o[3], vb_, pa0, pa1, pa2, pa3); } while (0)
#define DF_HALF(c0, c1, q0, q1, j, LOADS) do { \
        DF_KRD(ka0, ka1, rc, 0); if (LOADS) DF_GLDS((j) + 1, rn); __builtin_amdgcn_sched_barrier(0);     \
        { float ps0_ = 0.f, ps1_ = 0.f; \
          DF_KRD(kb0, kb1, rc, 1); DF_KMM(c0, c1, ka0, ka1, 0); DF_EXP_H(q1, 8); __builtin_amdgcn_sched_barrier(0); \
          DF_KRD(ka0, ka1, rc, 2); DF_KMM(c0, c1, kb0, kb1, 1); ps0_ = DF_SUM16(q0); DF_PK4(q0, 0, pa0); __builtin_amdgcn_sched_barrier(0); \
          DF_KRD(kb0, kb1, rc, 3); DF_KMM(c0, c1, ka0, ka1, 2); ps1_ = DF_SUM16(q1); DF_PK4(q0, 8, pa1); __builtin_amdgcn_sched_barrier(0); \
          DF_KMM(c0, c1, kb0, kb1, 3); l_reg += ps0_ + ps1_; DF_PK4(q1, 0, pa2); DF_PK4(q1, 8, pa3); __builtin_amdgcn_sched_barrier(0); } \
        { const LAS unsigned char* vb_ = vrd + rp * VBYTES; \
          pv_blk<0>(o[0], vb_, pa0, pa1, pa2, pa3); DF_EXP_H(c0, 0); __builtin_amdgcn_sched_barrier(0); \
          pv_blk<1>(o[1], vb_, pa0, pa1, pa2, pa3); DF_EXP_H(c0, 8); __builtin_amdgcn_sched_barrier(0); \
          pv_blk<2>(o[2], vb_, pa0, pa1, pa2, pa3); DF_EXP_H(c1, 0); if (LOADS) P.cinit_off<0>(q0, DF_TL((j) + 1), wid, r32, hi); __builtin_amdgcn_sched_barrier(0); \
          pv_blk<3>(o[3], vb_, pa0, pa1, pa2, pa3); if (LOADS) P.cinit_off<1>(q1, DF_TL((j) + 1), wid, r32, hi); __builtin_amdgcn_sched_barrier(0); } \
        __syncthreads(); { const int t_ = rp; rp = rc; rc = rn; rn = t_; } } while (0)
    float l_reg = 0.f; f32x16 o[NB];
#pragma unroll
    for (int d = 0; d < NB; ++d) o[d] = f32x16{};
    f32x16 pA0, pA1, pB0, pB1; bf16x8 pa0, pa1, pa2, pa3, ka0, ka1, kb0, kb1;
    int rp = 2, rc = 0, rn = 1;
    DF_GLDS(0, 0); DF_GLDS(1, 1); __syncthreads();
    P.cinit_abs<0>(pA0, DF_TL(0), wid, r32, hi); P.cinit_abs<1>(pA1, DF_TL(0), wid, r32, hi); DF_QK(pA0, pA1, 0); DF_EXP_A(pA0, pA1);
    P.cinit_abs<0>(pB0, DF_TL(1), wid, r32, hi); P.cinit_abs<1>(pB1, DF_TL(1), wid, r32, hi);
    rp = 0; rc = 1; rn = 2;
    { int j = 1;
      do { DF_HALF(pB0, pB1, pA0, pA1, j, true);
           DF_HALF(pA0, pA1, pB0, pB1, j + 1, true); j += 2; } while (j + 2 < n_tiles); }
    DF_HALF(pB0, pB1, pA0, pA1, n_tiles - 1, false);
    DF_FINISH(pB0, pB1); DF_PV(rp);
#undef DF_GLDS
#undef DF_TL
#undef DF_QK
#undef DF_EXP_A
#undef DF_QK1
#undef DF_KRD
#undef DF_KMM
#undef DF_SUM16
#undef DF_EXP_H
#undef DF_FINISH
#undef DF_PK4
#undef DF_PV
#undef DF_HALF
    int tid2_ = threadIdx.x; asm volatile("" : "+v"(tid2_));
    const int lane2 = tid2_ & 63, r32b = lane2 & 31, hib = lane2 >> 5;
    { auto rr = __builtin_amdgcn_permlane32_swap(__float_as_uint(l_reg), __float_as_uint(l_reg), false, false);
      l_reg = __uint_as_float(rr[0]) + __uint_as_float(rr[1]); }
    const bool bad = !(l_reg > 7.9e-31f && l_reg < 1.2e30f);
    if (__any(bad) && lane2 == 0) flag[0] = 1u;
    __syncthreads();
    const bool redo = __builtin_amdgcn_readfirstlane((int)flag[0]) != 0;
    __syncthreads();
    if (redo) { attn_unit(P, lds, X); return; }
    if (hib == 0) li_l[r32b] = l_reg;
    asm volatile("s_waitcnt lgkmcnt(0)" ::: "memory");
    float rli[16];
#pragma unroll
    for (int r = 0; r < 16; ++r) rli[r] = __builtin_amdgcn_rcpf(li_l[crow(r, hib)]);
    LAS float* XB = (LAS float*)lds;
    if (wid >= 4) {
#pragma unroll
        for (int r = 0; r < 16; ++r) { const int row = 32 * (wid & 3) + crow(r, hib);
#pragma unroll
            for (int d = 0; d < NB; ++d) XB[row * 128 + d * 32 + r32b] = X.lam * o[d][r] * rli[r]; }
    }
    __syncthreads();
    if (wid < 4) {
#pragma unroll
        for (int r = 0; r < 16; ++r) { const int row = 32 * wid + crow(r, hib); float s = 0.f;
#pragma unroll
            for (int d = 0; d < NB; ++d) { const float y = o[d][r] * rli[r] - XB[row * 128 + d * 32 + r32b]; o[d][r] = y; s += y * y; }
            s += sx(s, 1, lane2); s += sx(s, 2, lane2); s += sx(s, 4, lane2); s += sx(s, 8, lane2); s += sx(s, 16, lane2);
            const float rs = (1.0f - LAM_INIT) / sqrtf(s * (1.0f / 128.f) + SUBLN_EPS);
            const long tok = P.qtok(wid, crow(r, hib));
#pragma unroll
            for (int d = 0; d < NB; ++d) X.att[tok * D + P.h * 128 + d * 32 + r32b] = (bf16_t)(pk2(o[d][r] * rs * X.subln[d * 32 + r32b], 0.f) & 0xffffu); }
    }
    __syncthreads();
}
}

#define XB_TMO      128
#define XB_XCNT(j)  (256  + 64 * (j))
#define XB_XSUB(j)  (1280 + 64 * (j))
#define XB_XGEN(j)  (2304 + 64 * (j))
#define XB_TOP      3328
#define XB_TOPGEN   3392
#define XCD_BAR_WORDS 3456
#define XB_SPIN_CAP (1u << 18)

__device__ __forceinline__ unsigned xb_ld(unsigned* p)              { return __hip_atomic_load(p, __ATOMIC_RELAXED, __HIP_MEMORY_SCOPE_AGENT); }
__device__ __forceinline__ unsigned xb_add(unsigned* p, unsigned v) { return __hip_atomic_fetch_add(p, v, __ATOMIC_RELAXED, __HIP_MEMORY_SCOPE_AGENT); }
__device__ __forceinline__ unsigned xb_xcc_id() { return (unsigned)__builtin_amdgcn_s_getreg((3 << 11) | 20) & 0xFu; }
#define XB_SPIN(cond, bar) do { unsigned _sp = 0; while (cond) { __builtin_amdgcn_s_sleep(1); \
    if ((++_sp & 255u) == 0u) { if (xb_ld(&(bar)[XB_TMO])) break; if (_sp > XB_SPIN_CAP) { atomicAdd(&(bar)[XB_TMO], 1u); break; } } } } while (0)

struct XcdBarrier {
    unsigned* bar; unsigned x;
    volatile LAS unsigned* st;
};

__device__ __forceinline__ XcdBarrier xcd_barrier_post(unsigned* bar, volatile LAS unsigned* st) {
    XcdBarrier b; b.bar = bar; b.x = xb_xcc_id(); b.st = st;
    if (threadIdx.x == 0) (void)xb_add(&bar[XB_XCNT(b.x)], 1u);
    return b;
}
__device__ __forceinline__ void xcd_barrier_complete(unsigned* bar, unsigned x, unsigned& nloc, unsigned& nx) {
    const unsigned G = gridDim.x * gridDim.y * gridDim.z;
    unsigned sum, cnt, mine, sp = 0u;
    for (;;) {
        sum = 0u; cnt = 0u; mine = 0u;
#pragma unroll
        for (unsigned j = 0; j < 16; ++j) { const unsigned c = xb_ld(&bar[XB_XCNT(j)]); sum += c; cnt += (c > 0u) ? 1u : 0u; mine = (j == x) ? c : mine; }
        if (sum == G) break;
        __builtin_amdgcn_s_sleep(1);
        if ((++sp & 255u) == 0u) { if (xb_ld(&bar[XB_TMO])) break; if (sp > XB_SPIN_CAP) { atomicAdd(&bar[XB_TMO], 1u); break; } }
    }
    nloc = mine > 0u ? mine : 1u; nx = cnt > 0u ? cnt : 1u;
}

__device__ __forceinline__ void xcd_barrier(const XcdBarrier& b) {
    asm volatile("s_waitcnt vmcnt(0)" ::: "memory");
    __syncthreads();
    if (threadIdx.x == 0) {
        unsigned* bar = b.bar;
        __builtin_amdgcn_s_waitcnt(0);
        unsigned nloc = b.st[0], nx = b.st[1];
        if (nloc == 0u) { xcd_barrier_complete(bar, b.x, nloc, nx); b.st[0] = nloc; b.st[1] = nx; }
        const unsigned old = xb_add(&bar[XB_XSUB(b.x)], 1u);
        const unsigned gen = old / nloc;
        if (old + 1u == (gen + 1u) * nloc) {
            __builtin_amdgcn_fence(__ATOMIC_RELEASE, "agent");
            asm volatile("s_waitcnt vmcnt(0)" ::: "memory");
            const unsigned og = xb_add(&bar[XB_TOP], 1u);
            const unsigned tg = og / nx;
            if (og + 1u == (tg + 1u) * nx) xb_add(&bar[XB_TOPGEN], 1u);
            else XB_SPIN(xb_ld(&bar[XB_TOPGEN]) == tg, bar);
            __builtin_amdgcn_fence(__ATOMIC_ACQUIRE, "agent");
            xb_add(&bar[XB_XGEN(b.x)], 1u);
            asm volatile("s_waitcnt vmcnt(0)" ::: "memory");
        } else {
            XB_SPIN(xb_ld(&bar[XB_XGEN(b.x)]) == gen, bar);
            __builtin_amdgcn_fence(__ATOMIC_ACQUIRE, "agent");
            asm volatile("s_waitcnt vmcnt(0)" ::: "memory");
        }
    }
    __syncthreads();
}

constexpr size_t MiB = 1u << 20;
constexpr size_t WS_W = 2 * MiB, WS_WL = 26 * MiB;
constexpr size_t WO_IN = 0, WO_O = 6 * MiB, WO_GU = 8 * MiB, WO_D = 19 * MiB;
constexpr size_t WS_BAR = 512 * 1024, WS_BAR_BYTES = 16384;
constexpr size_t WS_KN = 0;
constexpr size_t WS_SS = 56 * MiB, WS_LSE = 60 * MiB, WS_XB = 68 * MiB, WS_ATT = 196 * MiB, WS_OBR = 324 * MiB, WS_QKV = 516 * MiB, WS_H = WS_QKV, WS_END = 900 * MiB;
constexpr int LDS_BYTES = 147456;

struct Args { const float* in[22]; float* out; unsigned char* ws; int ph_lo, ph_hi; };
enum { I_X = 0, I_A0N = 1, I_A0IN = 2, I_A0OUT = 3, I_RPB = 4, I_F0N = 5, I_F0G = 6, I_F0U = 7, I_F0D = 8, I_A1N = 9, I_A1QKV = 10, I_A1OUT = 11,
       I_LQ1 = 12, I_LK1 = 13, I_LQ2 = 14, I_LK2 = 15, I_SUBLN = 16, I_F1N = 17, I_F1G = 18, I_F1U = 19, I_F1D = 20, I_FN = 21 };
constexpr int NPH = 14;

__device__ __forceinline__ float wave_sum(float v, int lane) {
#pragma unroll
    for (int o = 1; o < 64; o <<= 1) v += sx(v, o, lane);
    return v;
}
__device__ __forceinline__ void transpose_item(const float* W, const float* gain, int K, int N, bf16_t* WT, int mode, LAS float* scr, int item, int lane) {
    const int nblk = N / 32, kb = item / nblk, nb = item % nblk, k0 = 64 * kb, n0 = 32 * nb;
#pragma unroll 8
    for (int i = 0; i < 32; ++i) { const int kk = 2 * i + (lane >> 5); const float g = gain ? gain[k0 + kk] : 1.0f; scr[kk * 33 + (lane & 31)] = W[(size_t)(k0 + kk) * N + n0 + (lane & 31)] * g; }
    asm volatile("s_waitcnt lgkmcnt(0)" ::: "memory");
    const int c = lane & 7;
    const int ob = mode == 0 ? n0 : 256 * (n0 >> 7) + 128 * (mode - 1) + (n0 & 127);
#pragma unroll
    for (int j = 0; j < 4; ++j) { const int n = (lane >> 3) + 8 * j; const LAS float* s = scr + (8 * c) * 33 + n;
        u32x4 o; o.x = cvtpk(s[0 * 33], s[1 * 33]); o.y = cvtpk(s[2 * 33], s[3 * 33]); o.z = cvtpk(s[4 * 33], s[5 * 33]); o.w = cvtpk(s[6 * 33], s[7 * 33]);
        *(u32x4*)(WT + (size_t)(ob + n) * K + k0 + 8 * c) = o; }
    asm volatile("s_waitcnt lgkmcnt(0)" ::: "memory");
}

__global__ void __launch_bounds__(512, 2) mk_fwd(Args a) {
    extern __shared__ __attribute__((aligned(16))) unsigned char lds_raw[];
    LAS unsigned char* lds = (LAS unsigned char*)lds_raw;
    cg::grid_group grid = cg::this_grid();
    { volatile LAS unsigned* st_ = (volatile LAS unsigned*)(lds + LDS_BYTES - 64); if (threadIdx.x < 2) st_[threadIdx.x] = 0u; }
    __syncthreads();
    const XcdBarrier bar = xcd_barrier_post((unsigned*)(a.ws + WS_BAR), (volatile LAS unsigned*)(lds + LDS_BYTES - 64));
    if (a.ph_lo < 0) grid.sync();
    const int wave = __builtin_amdgcn_readfirstlane((int)threadIdx.x >> 6);
    const int G = gridDim.x, gw = blockIdx.x * 8 + wave, NGW = G * 8;
    unsigned char* ws = a.ws;
    float* ss = (float*)(ws + WS_SS); float* lse = (float*)(ws + WS_LSE);
    bf16_t* xb = (bf16_t*)(ws + WS_XB); bf16_t* att = (bf16_t*)(ws + WS_ATT); bf16_t* obr = (bf16_t*)(ws + WS_OBR);
    bf16_t* qkv = (bf16_t*)(ws + WS_QKV); bf16_t* hb = (bf16_t*)(ws + WS_H);

#ifdef MK_PROBE_SYNCS
    for (int i_ = 0; i_ < MK_PROBE_SYNCS; ++i_) xcd_barrier(bar);
#endif
    for (int ph = a.ph_lo; ph < a.ph_hi; ++ph)
    for (int rep = 0; rep <= ((MK_DUP_MASK >> ph) & 1); ++rep) {
        if (ph == 0) {
            int tq_ = threadIdx.x; asm volatile("" : "+v"(tq_)); const int lane = tq_ & 63;
            LAS float* scr = (LAS float*)(lds + wave * 16384);
            constexpr int I_IN = 16 * 96, I_O = 16 * 32, I_G = 16 * 88, I_D = 44 * 32, I_L = I_IN + I_O + 2 * I_G + I_D;
            for (int it = gw; it < 2 * I_L; it += NGW) {
                const int l = it / I_L; int r = it % I_L; unsigned char* wl = ws + WS_W + (size_t)l * WS_WL;
                const float* an = a.in[l ? I_A1N : I_A0N]; const float* fn = a.in[l ? I_F1N : I_F0N];
                if (r < I_IN) { transpose_item(a.in[l ? I_A1QKV : I_A0IN], an, D, NQKV, (bf16_t*)(wl + WO_IN), 0, scr, r, lane); continue; } r -= I_IN;
                if (r < I_O) { transpose_item(a.in[l ? I_A1OUT : I_A0OUT], nullptr, D, D, (bf16_t*)(wl + WO_O), 0, scr, r, lane); continue; } r -= I_O;
                if (r < I_G) { transpose_item(a.in[l ? I_F1G : I_F0G], fn, D, FF, (bf16_t*)(wl + WO_GU), 1, scr, r, lane); continue; } r -= I_G;
                if (r < I_G) { transpose_item(a.in[l ? I_F1U : I_F0U], fn, D, FF, (bf16_t*)(wl + WO_GU), 2, scr, r, lane); continue; } r -= I_G;
                transpose_item(a.in[l ? I_F1D : I_F0D], nullptr, FF, D, (bf16_t*)(wl + WO_D), 0, scr, r, lane);
            }
            const float* x = a.in[I_X];
            for (int m = gw; m < M; m += 2 * NGW) {
                const f32x4* xr0 = (const f32x4*)(x + (size_t)m * D) + lane; const f32x4* xr1 = (const f32x4*)(x + (size_t)(m + NGW) * D) + lane; f32x4 v0[4], v1[4];
#pragma unroll
                for (int j = 0; j < 4; ++j) { v0[j] = xr0[64 * j]; v1[j] = xr1[64 * j]; }
                float s0 = 0.f, s1 = 0.f;
#pragma unroll
                for (int j = 0; j < 4; ++j) { s0 += (v0[j][0] * v0[j][0] + v0[j][1] * v0[j][1]) + (v0[j][2] * v0[j][2] + v0[j][3] * v0[j][3]);
                                              s1 += (v1[j][0] * v1[j][0] + v1[j][1] * v1[j][1]) + (v1[j][2] * v1[j][2] + v1[j][3] * v1[j][3]); }
                s0 = wave_sum(s0, lane); s1 = wave_sum(s1, lane);
                u32x2* o0 = (u32x2*)(xb + (size_t)m * D) + lane; u32x2* o1 = (u32x2*)(xb + (size_t)(m + NGW) * D) + lane;
#pragma unroll
                for (int j = 0; j < 4; ++j) { u32x2 w; w.x = cvtpk(v0[j][0], v0[j][1]); w.y = cvtpk(v0[j][2], v0[j][3]); o0[64 * j] = w;
                                              u32x2 z; z.x = cvtpk(v1[j][0], v1[j][1]); z.y = cvtpk(v1[j][2], v1[j][3]); o1[64 * j] = z; }
                if (lane < 16) { ss[(size_t)m * 16 + lane] = lane == 0 ? s0 : 0.f; ss[(size_t)(m + NGW) * 16 + lane] = lane == 0 ? s1 : 0.f; }
            }
        } else if (ph == 13) {
            int tq_ = threadIdx.x; asm volatile("" : "+v"(tq_)); const int lane = tq_ & 63;
            const float* g = a.in[I_FN];
            f32x4 gg[4];
#pragma unroll
            for (int j = 0; j < 4; ++j) gg[j] = ((const f32x4*)g)[lane + 64 * j];
            for (int m = gw; m < M; m += 2 * NGW) {
                f32x4* xr0 = (f32x4*)(a.out + (size_t)m * D) + lane; f32x4* xr1 = (f32x4*)(a.out + (size_t)(m + NGW) * D) + lane; f32x4 v0[4], v1[4];
#pragma unroll
                for (int j = 0; j < 4; ++j) { v0[j] = xr0[64 * j]; v1[j] = xr1[64 * j]; }
                float s0 = 0.f, s1 = 0.f;
#pragma unroll
                for (int j = 0; j < 4; ++j) { s0 += (v0[j][0] * v0[j][0] + v0[j][1] * v0[j][1]) + (v0[j][2] * v0[j][2] + v0[j][3] * v0[j][3]);
                                              s1 += (v1[j][0] * v1[j][0] + v1[j][1] * v1[j][1]) + (v1[j][2] * v1[j][2] + v1[j][3] * v1[j][3]); }
                s0 = wave_sum(s0, lane); s1 = wave_sum(s1, lane);
                const float rs0 = 1.0f / sqrtf(s0 * (1.0f / D) + RMS_EPS), rs1 = 1.0f / sqrtf(s1 * (1.0f / D) + RMS_EPS);
#pragma unroll
                for (int j = 0; j < 4; ++j) { xr0[64 * j] = v0[j] * rs0 * gg[j]; xr1[64 * j] = v1[j] * rs1 * gg[j]; }
            }
        } else {
            const int l = (ph - 1) / 6, s = (ph - 1) % 6;
            unsigned char* wl = ws + WS_W + (size_t)l * WS_WL;
            if (s == 0) {
                pg8::Gemm g{xb, (const bf16_t*)(wl + WO_IN), M, NQKV, D}; pg8::StaticOrder S; S.init(M, NQKV, G, (int)blockIdx.x);
                pg8::EpiScaleBf16 E{qkv, NQKV, ss, l == 0 ? 0xC3u : 0xFu};
#ifndef SKIP_G1
                pg8::gemm_phase<pg8::EpiScaleBf16, pg8::StaticOrder, true, true>(lds, g, S, E);
#endif
            } else if (s == 1) {
                at::Ptrs X{qkv, att, obr, lse, a.in[I_RPB], a.in[I_SUBLN], 0.f, (const float*)(ws + WS_KN)};
                if (l == 0) {
                    const int vc0 = ((int)blockIdx.x & 7) * (G >> 3) + ((int)blockIdx.x >> 3);
#ifndef SKIP_NAT
                    for (int u = vc0; u < 2048; u += G) { at::PolNat P; P.init(u); at::attn_unit(P, lds, X); }
#endif
#ifndef SKIP_DIL
                    { bf16x8 pq0 = {}, pq1 = {}, pq2 = {}, pq3 = {}, pk_ = {}, pv_ = {}; bool have = false;
                      for (int u = 2048 + vc0; u < 8192; u += G) { at::PolDil P, Pn; P.init(u - 2048); const bool hasn = u + G < 8192; if (hasn) Pn.init(u + G - 2048); else Pn = P;
                          at::attn_unit(P, lds, X, pq0, pq1, pq2, pq3, pk_, pv_, have, Pn, hasn); have = hasn; } }
#endif
                } else {
                    int tq_ = threadIdx.x; asm volatile("" : "+v"(tq_)); const int lane = tq_ & 63;
                    float* kn = (float*)(ws + WS_KN);
                    for (int it = gw; it < 16 * 8 * 64; it += NGW) {
                        const int t = it & 63, hh = (it >> 6) & 7, bb = it >> 9;
                        const bf16_t* kp = qkv + ((size_t)bb * T + 64 * t + (lane >> 4)) * NQKV + 1024 + hh * 128 + (lane & 15) * 8;
                        bf16x8 v[16];
#pragma unroll
                        for (int i = 0; i < 16; ++i) v[i] = *(const bf16x8*)(kp + (size_t)(4 * i) * NQKV);
                        float mx = 0.f;
#pragma unroll
                        for (int i = 0; i < 16; ++i) { float k2 = 0.f;
#pragma unroll
                            for (int e = 0; e < 8; ++e) { const float f = bf2f((unsigned short)v[i][e]); k2 = fmaf(f, f, k2); }
                            k2 += sx(k2, 1, lane); k2 += sx(k2, 2, lane); k2 += sx(k2, 4, lane);
                            mx = fmaxf(mx, k2); }
                        mx = fmaxf(mx, sx(mx, 16, lane)); mx = fmaxf(mx, sx(mx, 32, lane));
                        if ((lane & 55) == 0) kn[((bb * 8 + hh) * 2 + (lane >> 3)) * 64 + t] = sqrtf(mx) * 1.001f;
                    }
                }
            } else if (s == 2) {
                if (l == 0) {
                    int tq_ = threadIdx.x; asm volatile("" : "+v"(tq_)); const int lane = tq_ & 63;
                    const int hd = lane >> 3;
                    for (int m0 = gw; m0 < M; m0 += 2 * NGW) {
                        float L[2][3]; bf16x8 ov[2][3];
#pragma unroll
                        for (int r = 0; r < 2; ++r) { const size_t m = (size_t)m0 + (size_t)r * NGW;
#pragma unroll
                            for (int i = 0; i < 3; ++i) { L[r][i] = lse[(size_t)i * M * 8 + m * 8 + hd]; ov[r][i] = *(const bf16x8*)(obr + (size_t)i * M * 512 + m * 512 + lane * 8); } }
#pragma unroll
                        for (int r = 0; r < 2; ++r) { const size_t m = (size_t)m0 + (size_t)r * NGW;
                            const float mx = fmaxf(L[r][0], fmaxf(L[r][1], L[r][2]));
                            float w0 = __builtin_amdgcn_exp2f(L[r][0] - mx), w1 = __builtin_amdgcn_exp2f(L[r][1] - mx), w2 = __builtin_amdgcn_exp2f(L[r][2] - mx);
                            const float inv = 1.0f / (w0 + w1 + w2); w0 *= inv; w1 *= inv; w2 *= inv;
                            float y[8];
#pragma unroll
                            for (int e = 0; e < 8; ++e) y[e] = w0 * bf2f((unsigned short)ov[r][0][e]) + w1 * bf2f((unsigned short)ov[r][1][e]) + w2 * bf2f((unsigned short)ov[r][2][e]);
                            u32x4 w; w.x = cvtpk(y[0], y[1]); w.y = cvtpk(y[2], y[3]); w.z = cvtpk(y[4], y[5]); w.w = cvtpk(y[6], y[7]);
                            *(u32x4*)(att + m * D + lane * 8) = w; }
                    }
                } else {
                    float d1 = 0.f, d2 = 0.f;
                    for (int i = 0; i < 64; ++i) { d1 += a.in[I_LQ1][i] * a.in[I_LK1][i]; d2 += a.in[I_LQ2][i] * a.in[I_LK2][i]; }
                    at::Ptrs X{qkv, att, obr, lse, a.in[I_RPB], a.in[I_SUBLN], 0.f, (const float*)(ws + WS_KN)};
                    X.lam = __int_as_float(__builtin_amdgcn_readfirstlane(__float_as_int(__expf(d1) - __expf(d2) + LAM_INIT)));
#ifndef SKIP_DIFF
                    for (int u = blockIdx.x; u < 4096; u += G) { at::PolDiff P; P.init(u); at::diff_unit(P, lds, X); }
#endif
                }
            } else if (s == 3 || s == 5) {
                const bool dn = s == 5;
                pg8::Gemm g{dn ? hb : att, (const bf16_t*)(wl + (dn ? WO_D : WO_O)), M, D, dn ? FF : D}; pg8::StaticOrder S; S.init(M, D, G, (int)blockIdx.x);
                pg8::EpiResid E{(l == 0 && !dn) ? a.in[I_X] : nullptr, (l == 1 && dn) ? a.out : nullptr, xb, (bf16_t*)(ws + WS_OBR)  , ss};
#ifndef SKIP_G2
                pg8::gemm_phase<pg8::EpiResid, pg8::StaticOrder, true, true>(lds, g, S, E);
#endif
            } else {
                pg8::Gemm g{xb, (const bf16_t*)(wl + WO_GU), M, NGU, D}; pg8::StaticOrder S; S.init(M, NGU, G, (int)blockIdx.x);
                pg8::EpiSwiGLU E{hb, ss};
#ifndef SKIP_G3
                pg8::gemm_phase<pg8::EpiSwiGLU, pg8::StaticOrder, true, true>(lds, g, S, E);
#endif
            }
        }
        if ((ph + 1 < a.ph_hi || rep < ((MK_DUP_MASK >> ph) & 1))) xcd_barrier(bar);
    }
}

extern "C" void kernel_launch(void* const* d_in, const int* in_sizes, int n_in, void* d_out, int out_size, void* d_ws, size_t ws_size, hipStream_t stream) {
    static int grid = 0;
    if (grid == 0) {
        if (n_in != 22 || in_sizes[0] != M * D || out_size != M * D || ws_size < WS_END) { fprintf(stderr, "kernel_launch: unexpected shapes (n_in %d, in0 %d, out %d, ws %zu)\n", n_in, n_in > 0 ? in_sizes[0] : -1, out_size, ws_size); grid = -1; return; }
        int dev = 0, cus = 0, per_cu = 0;
        hipGetDevice(&dev); hipDeviceGetAttribute(&cus, hipDeviceAttributeMultiprocessorCount, dev);
        if (hipFuncSetAttribute((const void*)mk_fwd, hipFuncAttributeMaxDynamicSharedMemorySize, LDS_BYTES) != hipSuccess) { fprintf(stderr, "kernel_launch: hipFuncSetAttribute failed\n"); grid = -1; return; }
        hipOccupancyMaxActiveBlocksPerMultiprocessor(&per_cu, (const void*)mk_fwd, 512, LDS_BYTES);
        (void)hipGetLastError();
        if (per_cu < 1) { fprintf(stderr, "kernel_launch: occupancy query says %d blocks/CU\n", per_cu); per_cu = 1; }
        grid = cus * 1;
    }
    if (grid < 0) return;
    Args a{};
    for (int i = 0; i < 22; ++i) a.in[i] = (const float*)d_in[i];
    a.out = (float*)d_out; a.ws = (unsigned char*)d_ws;
#if MK_ONE_LAUNCH
    if (hipMemsetAsync((char*)d_ws + WS_BAR, 0, WS_BAR_BYTES, stream) != hipSuccess) { fprintf(stderr, "kernel_launch: memset of the barrier words failed\n"); return; }
    a.ph_lo = 0; a.ph_hi = NPH;
    void* args[] = {&a};
    hipError_t e = hipLaunchCooperativeKernel((const void*)mk_fwd, dim3(grid), dim3(512), args, LDS_BYTES, stream);
    if (e != hipSuccess) fprintf(stderr, "cooperative launch failed: %s (grid %d)\n", hipGetErrorString(e), grid);
#else
    for (int ph = 0; ph < NPH; ++ph) {
        a.ph_lo = ph; a.ph_hi = ph + 1;
        hipLaunchKernelGGL(mk_fwd, dim3(grid), dim3(512), LDS_BYTES, stream, a);
    }
#endif
}
```

```cpp
#include <hip/hip_runtime.h>
#include <hip/hip_cooperative_groups.h>
#include <cstdio>
#include <cstdint>
namespace cg = cooperative_groups;
#ifndef MK_DUP_MASK
#define MK_DUP_MASK 0x0
#endif
#ifndef MK_ONE_LAUNCH
#define MK_ONE_LAUNCH 1
#endif
namespace pg8 {
#define PG8_LAS __attribute__((address_space(3)))
typedef unsigned short bf16_t;
typedef short bf16x8 __attribute__((ext_vector_type(8)));
typedef float f32x4 __attribute__((ext_vector_type(4)));
typedef unsigned u32x4 __attribute__((ext_vector_type(4)));
constexpr int BM = 256, BK = 64, HALF = 128, HTB = HALF * BK * 2  , STAGE_BYTES = 8 * HTB, NXCD = 8, WGM = 8;

__host__ __device__ __forceinline__ int lds_byte(int r, int c) { const int st = (r >> 4) * 2 + (c >> 5), rr = r & 15, cc = c & 31, ob = rr * 64 + cc * 2; return st * 1024 + (ob ^ (((ob >> 9) & 1) << 5)); }
__host__ __device__ __forceinline__ void stage_rc(int b, int& R, int& C) { const int st = b / 1024, sb = b % 1024, swz = sb ^ (((sb >> 9) & 1) << 5); R = (st >> 1) * 16 + swz / 64; C = (st & 1) * 32 + (swz % 64) / 2; }
__host__ __device__ __forceinline__ int perm32(int rho) { const int n = rho >> 4, i = rho & 15; return 8 * (i >> 2) + 4 * n + (i & 3); }

struct Unit { int pm, pn; };
struct Gemm { const bf16_t* A; const bf16_t* Bt; int M, N, K; };

struct StaticOrder {
    int nM, nN, nwg, G, c;
    __host__ __device__ void init(int M, int N, int G_, int c_) { nM = M / BM; nN = N / BM; nwg = nM * nN; G = G_; c = c_; }
    __host__ __device__ bool next(int i, Unit& u) const {
        const long L = (long)i * G + c; if (L >= nwg) return false;
        int wgid = (int)L; { const int q = nwg / NXCD, r = nwg % NXCD, xcd = wgid % NXCD, off = wgid / NXCD; wgid = (xcd < r ? xcd * (q + 1) : r * (q + 1) + (xcd - r) * q) + off; }
        const int nig = WGM * nN, gid = wgid / nig, fm = gid * WGM, gsz = (nM - fm) < WGM ? (nM - fm) : WGM;
        u.pm = fm + ((wgid % nig) % gsz); u.pn = (wgid % nig) / gsz; return true;
    }
    __device__ __forceinline__ void a_ready(const Unit&) const {}
    __device__ __forceinline__ void done(const Unit&) const {}
};

__device__ __forceinline__ unsigned cvt_pk_bf16(float lo, float hi) { unsigned r; asm volatile("v_cvt_pk_bf16_f32 %0, %1, %2" : "=v"(r) : "v"(lo), "v"(hi)); return r; }
typedef float f32x2 __attribute__((ext_vector_type(2)));
template <class Epi, class Sched, bool ALIGN_EPI = false, bool SP2 = false>
__device__ __forceinline__ void gemm_phase(PG8_LAS unsigned char* lds, const Gemm g, const Sched& S, const Epi& E) {
    int tid_ = threadIdx.x; asm volatile("" : "+v"(tid_));
    const int tid = tid_, wid = __builtin_amdgcn_readfirstlane(tid >> 6), lane = tid & 63, wr = wid >> 2, wc = wid & 3, fr = lane & 15, fq = lane >> 4;
    const int K = g.K, nt = K / BK;
    unsigned voffA[2], voffB[2];
#pragma unroll
    for (int i = 0; i < 2; ++i) { int R, C; stage_rc(tid * 16 + i * 8192, R, C); const int Rb = Epi::PERM ? ((R & ~31) + perm32(R & 31)) : R;
        voffA[i] = (unsigned)(R * K + C) * 2u; voffB[i] = (unsigned)(Rb * K + C) * 2u; }
    const size_t kstep = (size_t)(BK * 2);
    const size_t hstep = (size_t)HALF * K * 2;
    const size_t tstep = 2 * hstep;
    const unsigned ldsw = (unsigned)wid * 1024u;
    const int aoff = lds_byte(wr * 64 + fr, fq * 8), boff = lds_byte(wc * 32 + fr, fq * 8);
#define PG8_SA(b, h) (((b) * 2 + (h)) * HTB)
#define PG8_SB(b, h) ((4 + (b) * 2 + (h)) * HTB)
#define PG8_STAGE(bufoff, gbase, voff) do { _Pragma("unroll") for (int _i = 0; _i < 2; ++_i) \
        __builtin_amdgcn_global_load_lds((const unsigned*)((const char*)(gbase) + (voff)[_i]), (PG8_LAS unsigned*)(lds + (bufoff) + ldsw + _i * 8192), 16, 0, 0); } while (0)
#define PG8_LDA(dst, b, h) do { _Pragma("unroll") for (int m = 0; m < 4; ++m) _Pragma("unroll") for (int k = 0; k < 2; ++k) dst[m][k] = *(const PG8_LAS bf16x8*)(lds + PG8_SA(b, h) + aoff + m * 2048 + k * 1024); } while (0)
#define PG8_LDB(dst, b, h) do { _Pragma("unroll") for (int n = 0; n < 2; ++n) _Pragma("unroll") for (int k = 0; k < 2; ++k) dst[n][k] = *(const PG8_LAS bf16x8*)(lds + PG8_SB(b, h) + boff + n * 2048 + k * 1024); } while (0)
#define PG8_MMA(ai, bj, At, Bt) do { __builtin_amdgcn_s_setprio(1); _Pragma("unroll") for (int m = 0; m < 4; ++m) _Pragma("unroll") for (int n = 0; n < 2; ++n) _Pragma("unroll") for (int k = 0; k < 2; ++k) \
        acc[ai][bj][m][n] = __builtin_amdgcn_mfma_f32_16x16x32_bf16(Bt[n][k], At[m][k], acc[ai][bj][m][n], 0, 0, 0); __builtin_amdgcn_s_setprio(0); } while (0)
#define PG8_WAIT_V(n) asm volatile("s_waitcnt vmcnt(" #n ")" ::: "memory")
#define PG8_WAIT_L(n) asm volatile("s_waitcnt lgkmcnt(" #n ")" ::: "memory")
#define PG8_BAR __builtin_amdgcn_s_barrier()
#define PG8_SCHED __builtin_amdgcn_sched_barrier(0)
    Unit cur, nxt; int ui = 0;
    if (!S.next(0, cur)) return;
    f32x4 acc[2][2][4][2];
#pragma unroll
    for (int a = 0; a < 2; ++a)
#pragma unroll
        for (int b = 0; b < 2; ++b)
#pragma unroll
            for (int m = 0; m < 4; ++m)
#pragma unroll
                for (int n = 0; n < 2; ++n) acc[a][b][m][n] = (f32x4){0.f, 0.f, 0.f, 0.f};
    bf16x8 At[4][2], B0[2][2], B1[2][2];
    const char* cA = (const char*)g.A + (size_t)cur.pm * tstep; const char* cB = (const char*)g.Bt + (size_t)cur.pn * tstep;
    S.a_ready(cur);
    if constexpr (SP2) {
        PG8_STAGE(PG8_SB(0, 0), cB, voffB); PG8_STAGE(PG8_SB(0, 1), cB + hstep, voffB); PG8_STAGE(PG8_SA(0, 0), cA, voffA); PG8_STAGE(PG8_SA(0, 1), cA + hstep, voffA);
        if (wr == 1) PG8_BAR;
        PG8_WAIT_V(2); PG8_BAR;
        PG8_STAGE(PG8_SB(1, 0), cB + kstep, voffB); PG8_STAGE(PG8_SA(1, 0), cA + kstep, voffA); PG8_STAGE(PG8_SB(1, 1), cB + hstep + kstep, voffB);
        PG8_WAIT_V(6); PG8_BAR;
    } else {
        PG8_STAGE(PG8_SB(0, 0), cB, voffB); PG8_STAGE(PG8_SA(0, 0), cA, voffA); PG8_STAGE(PG8_SB(0, 1), cB + hstep, voffB); PG8_STAGE(PG8_SA(0, 1), cA + hstep, voffA);
        if (wr == 1) PG8_BAR;
        PG8_WAIT_V(4); PG8_BAR;
        PG8_STAGE(PG8_SB(1, 0), cB + kstep, voffB); PG8_STAGE(PG8_SA(1, 0), cA + kstep, voffA); PG8_STAGE(PG8_SB(1, 1), cB + hstep + kstep, voffB);
        PG8_WAIT_V(6); PG8_BAR;
    }
    for (;;) {
        const bool has_next = S.next(ui + 1, nxt);
        const char* nA = has_next ? (const char*)g.A + (size_t)nxt.pm * tstep : cA; const char* nB = has_next ? (const char*)g.Bt + (size_t)nxt.pn * tstep : cB;
        for (int t = 0; t < nt; t += 2) {
            const bool last = (t == nt - 2);
            const char* a1 = cA + (size_t)(t + 1) * kstep;
            const char* a2 = last ? nA : cA + (size_t)(t + 2) * kstep; const char* b2 = last ? nB : cB + (size_t)(t + 2) * kstep;
            const char* a3 = a2 + kstep; const char* b3 = b2 + kstep;
            if (last && has_next) S.a_ready(nxt);
            if constexpr (SP2) {
            PG8_LDB(B0, 0, 0); PG8_LDB(B1, 0, 1); PG8_SCHED; PG8_LDA(At, 0, 0); PG8_STAGE(PG8_SA(1, 1), a1 + hstep, voffA);
            PG8_WAIT_V(8); PG8_WAIT_L(0); PG8_BAR; PG8_MMA(0, 0, At, B0); PG8_MMA(0, 1, At, B1); PG8_BAR; PG8_SCHED;
            PG8_LDA(At, 0, 1); PG8_STAGE(PG8_SB(0, 0), b2, voffB); PG8_STAGE(PG8_SB(0, 1), b2 + hstep, voffB); PG8_STAGE(PG8_SA(0, 0), a2, voffA);
            PG8_WAIT_V(8); PG8_WAIT_L(0); PG8_BAR; PG8_MMA(1, 0, At, B0); PG8_MMA(1, 1, At, B1); PG8_BAR; PG8_SCHED;
            PG8_LDB(B0, 1, 0); PG8_LDB(B1, 1, 1); PG8_SCHED; PG8_LDA(At, 1, 0); PG8_STAGE(PG8_SA(0, 1), a2 + hstep, voffA);
            PG8_WAIT_V(8); PG8_WAIT_L(0); PG8_BAR; PG8_MMA(0, 0, At, B0); PG8_MMA(0, 1, At, B1); PG8_BAR; PG8_SCHED;
            PG8_LDA(At, 1, 1); PG8_STAGE(PG8_SB(1, 0), b3, voffB); PG8_STAGE(PG8_SB(1, 1), b3 + hstep, voffB); PG8_STAGE(PG8_SA(1, 0), a3, voffA);
            PG8_WAIT_V(8); PG8_WAIT_L(0); PG8_BAR; PG8_MMA(1, 0, At, B0); PG8_MMA(1, 1, At, B1); PG8_BAR; PG8_SCHED;
            } else {
            PG8_LDB(B0, 0, 0); PG8_SCHED; PG8_LDA(At, 0, 0); PG8_STAGE(PG8_SA(1, 1), a1 + hstep, voffA);
            PG8_WAIT_L(8); PG8_BAR; PG8_WAIT_L(0); PG8_MMA(0, 0, At, B0); PG8_BAR; PG8_SCHED;
            PG8_LDB(B1, 0, 1); PG8_STAGE(PG8_SB(0, 0), b2, voffB);
            PG8_BAR; PG8_WAIT_L(0); PG8_MMA(0, 1, At, B1); PG8_BAR;
            PG8_LDA(At, 0, 1); PG8_STAGE(PG8_SA(0, 0), a2, voffA);
            PG8_BAR; PG8_WAIT_L(0); PG8_MMA(1, 0, At, B0); PG8_BAR; PG8_SCHED;
            PG8_STAGE(PG8_SB(0, 1), b2 + hstep, voffB);
            PG8_WAIT_V(6); PG8_BAR; PG8_MMA(1, 1, At, B1); PG8_BAR;
            PG8_LDB(B0, 1, 0); PG8_SCHED; PG8_LDA(At, 1, 0); PG8_STAGE(PG8_SA(0, 1), a2 + hstep, voffA);
            PG8_WAIT_L(8); PG8_BAR; PG8_WAIT_L(0); PG8_MMA(0, 0, At, B0); PG8_BAR; PG8_SCHED;
            PG8_LDB(B1, 1, 1); PG8_STAGE(PG8_SB(1, 0), b3, voffB);
            PG8_BAR; PG8_WAIT_L(0); PG8_MMA(0, 1, At, B1); PG8_BAR;
            PG8_LDA(At, 1, 1); PG8_STAGE(PG8_SA(1, 0), a3, voffA);
            PG8_BAR; PG8_WAIT_L(0); PG8_MMA(1, 0, At, B0); PG8_BAR; PG8_SCHED;
            PG8_STAGE(PG8_SB(1, 1), b3 + hstep, voffB);
            PG8_WAIT_V(6); PG8_BAR; PG8_MMA(1, 1, At, B1); PG8_BAR;
            }
        }
        if constexpr (ALIGN_EPI) { if (wr == 0) PG8_BAR; }
        if constexpr (!Epi::AFTER_DRAIN) { E(acc, cur, wr, wc, fr, fq); S.done(cur); }
        if (!has_next) break;
#pragma unroll
        for (int a = 0; a < 2; ++a)
#pragma unroll
            for (int b = 0; b < 2; ++b)
#pragma unroll
                for (int m = 0; m < 4; ++m)
#pragma unroll
                    for (int n = 0; n < 2; ++n) acc[a][b][m][n] = (f32x4){0.f, 0.f, 0.f, 0.f};
        cur = nxt; cA = nA; cB = nB; ++ui;
        if constexpr (ALIGN_EPI) { if (wr == 1) PG8_BAR; }
    }
    PG8_WAIT_V(0);
    if constexpr (!ALIGN_EPI) { if (wr == 0) PG8_BAR; }
    PG8_BAR;
    if constexpr (Epi::AFTER_DRAIN) { E.fused(acc, cur, wr, wc, fr, fq, lds, wid, lane); S.done(cur); }
#undef PG8_SA
#undef PG8_SB
#undef PG8_STAGE
#undef PG8_LDA
#undef PG8_LDB
#undef PG8_MMA
#undef PG8_WAIT_V
#undef PG8_WAIT_L
#undef PG8_BAR
#undef PG8_SCHED
}
}

constexpr int BATCH = 16, T = 4096, D = 1024, M = BATCH * T, NQKV = 3072, FF = 2816, NGU = 2 * FF;
constexpr float RMS_EPS = 1e-6f, SUBLN_EPS = 1e-5f;
constexpr float LOG2E = 1.4426950408889634f;
constexpr float QSCALE = 0.125f * LOG2E;
constexpr float LAM_INIT = 0.35550906f;

#define LAS __attribute__((address_space(3)))
typedef unsigned short bf16_t;
typedef short bf16x8 __attribute__((ext_vector_type(8)));
typedef short s16x4 __attribute__((ext_vector_type(4)));
typedef float f32x4 __attribute__((ext_vector_type(4)));
typedef float f32x16 __attribute__((ext_vector_type(16)));
typedef unsigned u32x4 __attribute__((ext_vector_type(4)));
typedef unsigned u32x2 __attribute__((ext_vector_type(2)));

__device__ __forceinline__ unsigned cvtpk(float lo, float hi) { unsigned r; asm volatile("v_cvt_pk_bf16_f32 %0, %1, %2" : "=v"(r) : "v"(lo), "v"(hi)); return r; }
__device__ __forceinline__ float sx(float v, int mask, int lane) { return __int_as_float(__builtin_amdgcn_ds_bpermute((lane ^ mask) << 2, __float_as_int(v))); }
__device__ __forceinline__ float bf2f(unsigned short u) { return __uint_as_float((unsigned)u << 16); }

namespace pg8 {
__device__ __forceinline__ float row_rs(const float* ss, int row, int fq, int fr) {
#ifdef TRIV_EPI
    return 1.0f;
#endif
    const f32x4 a = *(const f32x4*)(ss + (size_t)row * 16 + 4 * fq);
    float s = (a[0] + a[1]) + (a[2] + a[3]);
    const int ln = fq * 16 + fr; s += sx(s, 16, ln); s += sx(s, 32, ln);
    return 1.0f / sqrtf(s * (1.0f / D) + RMS_EPS);
}
struct EpiScaleBf16 {
    static constexpr bool PERM = true, AFTER_DRAIN = false;
    bf16_t* O; int ldc; const float* ss; unsigned qmask;
    float* kn2;
    __device__ __forceinline__ void operator()(const f32x4 (&acc)[2][2][4][2], const Unit& u, int wr, int wc, int fr, int fq) const {
        const int row0 = u.pm * BM + wr * 64 + fr, col0 = u.pn * BM + wc * 32 + 8 * fq;
        const float qs = ((qmask >> u.pn) & 1u) ? QSCALE : 1.0f;
        const bool kt = kn2 != nullptr && u.pn >= 4 && u.pn < 8;
        const int ln = fq * 16 + fr;
        float km[2][2] = {{0.f, 0.f}, {0.f, 0.f}};
#pragma unroll
        for (int ai = 0; ai < 2; ++ai)
#pragma unroll
            for (int m = 0; m < 4; ++m) { const int row = row0 + ai * HALF + m * 16; const float rs = row_rs(ss, row, fq, fr) * qs;
                bf16_t* rowp = O + (size_t)row * ldc + col0;
#pragma unroll
                for (int bj = 0; bj < 2; ++bj) { const f32x4 v0 = acc[ai][bj][m][0] * rs, v1 = acc[ai][bj][m][1] * rs;
                    u32x4 w; w.x = cvt_pk_bf16(v0[0], v0[1]); w.y = cvt_pk_bf16(v0[2], v0[3]); w.z = cvt_pk_bf16(v1[0], v1[1]); w.w = cvt_pk_bf16(v1[2], v1[3]);
                    *(u32x4*)(rowp + bj * HALF) = w;
                    if (kt) { float s8 = 0.f;
#pragma unroll
                        for (int e = 0; e < 4; ++e) { const unsigned ww = e == 0 ? w.x : (e == 1 ? w.y : (e == 2 ? w.z : w.w)); const float lo_ = __uint_as_float(ww << 16), hi_ = __uint_as_float(ww & 0xffff0000u);
                            s8 = fmaf(lo_, lo_, s8); s8 = fmaf(hi_, hi_, s8); }
                        s8 += sx(s8, 16, ln); s8 += sx(s8, 32, ln);
                        km[ai][bj] = fmaxf(km[ai][bj], s8); } }
                if (m & 1) asm volatile("" ::: "memory"); }
        if (kt) {
#pragma unroll
            for (int ai = 0; ai < 2; ++ai)
#pragma unroll
                for (int bj = 0; bj < 2; ++bj) { float v = km[ai][bj];
                    v = fmaxf(v, sx(v, 1, ln)); v = fmaxf(v, sx(v, 2, ln)); v = fmaxf(v, sx(v, 4, ln)); v = fmaxf(v, sx(v, 8, ln));
                    const int rt = u.pm * BM + ai * HALF + wr * 64, bb = rt >> 12, tile = (rt & 4095) >> 6, head = (u.pn - 4) * 2 + bj;
                    if (ln == 0) kn2[((((bb * 8 + head) * 2 + (wc >> 1)) * 64 + tile) << 1) + (wc & 1)] = v; }
        }
    }
};
struct EpiSwiGLU {
    static constexpr bool PERM = true, AFTER_DRAIN = false;
    bf16_t* H; const float* ss;
    __device__ __forceinline__ void operator()(const f32x4 (&acc)[2][2][4][2], const Unit& u, int wr, int wc, int fr, int fq) const {
        const int row0 = u.pm * BM + wr * 64 + fr, col0 = u.pn * HALF + wc * 32 + 8 * fq;
#pragma unroll
        for (int ai = 0; ai < 2; ++ai)
#pragma unroll
            for (int m = 0; m < 4; ++m) { const int row = row0 + ai * HALF + m * 16; const float rs = row_rs(ss, row, fq, fr);
                float o[8];
#pragma unroll
                for (int n = 0; n < 2; ++n)
#pragma unroll
                    for (int e = 0; e < 4; ++e) { const float g = acc[ai][0][m][n][e] * rs, up = acc[ai][1][m][n][e] * rs;
                        o[n * 4 + e] = g * __builtin_amdgcn_rcpf(1.0f + __builtin_amdgcn_exp2f(-g * LOG2E)) * up; }
                u32x4 w; w.x = cvt_pk_bf16(o[0], o[1]); w.y = cvt_pk_bf16(o[2], o[3]); w.z = cvt_pk_bf16(o[4], o[5]); w.w = cvt_pk_bf16(o[6], o[7]);
                *(u32x4*)(H + (size_t)row * FF + col0) = w;
                if (m & 1) asm volatile("" ::: "memory"); }
    }
};
struct EpiResid {
    static constexpr bool PERM = true, AFTER_DRAIN = false;
    const float* bf; float* of; bf16_t* hi; bf16_t* lo; float* ss;
    __device__ __forceinline__ void operator()(const f32x4 (&acc)[2][2][4][2], const Unit& u, int wr, int wc, int fr, int fq) const {
        const int row0 = u.pm * BM + wr * 64 + fr, col0 = u.pn * BM + wc * 32 + 8 * fq;
#pragma unroll
        for (int ai = 0; ai < 2; ++ai)
#pragma unroll
            for (int m = 0; m < 4; ++m) { const int row = row0 + ai * HALF + m * 16; const size_t off = (size_t)row * D + col0; float sq = 0.f;
#pragma unroll
                for (int bj = 0; bj < 2; ++bj) { const size_t o2 = off + bj * HALF; f32x4 v0, v1;
                    if (bf) { v0 = *(const f32x4*)(bf + o2); v1 = *(const f32x4*)(bf + o2 + 4); }
                    else { const u32x4 h = *(const u32x4*)(hi + o2), l = *(const u32x4*)(lo + o2);
                        v0[0] = __uint_as_float(h.x << 16) + __uint_as_float(l.x << 16); v0[1] = __uint_as_float(h.x & 0xffff0000u) + __uint_as_float(l.x & 0xffff0000u);
                        v0[2] = __uint_as_float(h.y << 16) + __uint_as_float(l.y << 16); v0[3] = __uint_as_float(h.y & 0xffff0000u) + __uint_as_float(l.y & 0xffff0000u);
                        v1[0] = __uint_as_float(h.z << 16) + __uint_as_float(l.z << 16); v1[1] = __uint_as_float(h.z & 0xffff0000u) + __uint_as_float(l.z & 0xffff0000u);
                        v1[2] = __uint_as_float(h.w << 16) + __uint_as_float(l.w << 16); v1[3] = __uint_as_float(h.w & 0xffff0000u) + __uint_as_float(l.w & 0xffff0000u); }
                    v0 = v0 + acc[ai][bj][m][0]; v1 = v1 + acc[ai][bj][m][1];
                    if (of) { *(f32x4*)(of + o2) = v0; *(f32x4*)(of + o2 + 4) = v1; }
                    else { u32x4 w; w.x = cvt_pk_bf16(v0[0], v0[1]); w.y = cvt_pk_bf16(v0[2], v0[3]); w.z = cvt_pk_bf16(v1[0], v1[1]); w.w = cvt_pk_bf16(v1[2], v1[3]);
                        u32x4 r; r.x = cvt_pk_bf16(v0[0] - __uint_as_float(w.x << 16), v0[1] - __uint_as_float(w.x & 0xffff0000u)); r.y = cvt_pk_bf16(v0[2] - __uint_as_float(w.y << 16), v0[3] - __uint_as_float(w.y & 0xffff0000u));
                        r.z = cvt_pk_bf16(v1[0] - __uint_as_float(w.z << 16), v1[1] - __uint_as_float(w.z & 0xffff0000u)); r.w = cvt_pk_bf16(v1[2] - __uint_as_float(w.w << 16), v1[3] - __uint_as_float(w.w & 0xffff0000u));
                        *(u32x4*)(hi + o2) = w; *(u32x4*)(lo + o2) = r; }
                    sq += ((v0[0] * v0[0] + v0[1] * v0[1]) + (v0[2] * v0[2] + v0[3] * v0[3])) + ((v1[0] * v1[0] + v1[1] * v1[1]) + (v1[2] * v1[2] + v1[3] * v1[3])); }
                { const int ln = fq * 16 + fr; sq += sx(sq, 16, ln); sq += sx(sq, 32, ln); }
                if (fq == 0) ss[(size_t)row * 16 + u.pn * 4 + wc] = sq;
                asm volatile("" ::: "memory"); }
    }
};
}

namespace at {
constexpr float THR = 8.0f;
__device__ __forceinline__ int crow(int r, int hi) { return (r & 3) + 8 * (r >> 2) + 4 * hi; }
template <int NB> __device__ __forceinline__ int v_st(int k, int c) { const int kk = (k & ~0xC) | ((k & 4) << 1) | ((k & 8) >> 1); return ((kk >> 3) * NB + (c >> 5)) * 512 + ((kk & 7) * 32 + (c & 31)) * 2; }
__device__ __forceinline__ int v_rd_base(int lane) { return ((lane & 3) << 3) | (((lane >> 2) & 3) << 6) | (((lane >> 4) & 1) << 5) | (((lane >> 5) & 1) << 8); }
template <int NB> constexpr int v_rd_off(int d0, int ks, int half) { return d0 * 512 + ks * (NB * 1024) + half * (NB * 512); }
template <int OFF> __device__ __forceinline__ s16x4 tr_read(int vb) { s16x4 r; asm volatile("ds_read_b64_tr_b16 %0, %1 offset:%2" : "=&v"(r) : "v"(vb), "i"(OFF) : "memory"); return r; }
template <int NB, int D0> __device__ __forceinline__ void pv_one(f32x16& od, int vb, bf16x8 pa0, bf16x8 pa1, bf16x8 pa2, bf16x8 pa3) {
    const s16x4 l0 = tr_read<v_rd_off<NB>(D0, 0, 0)>(vb), h0 = tr_read<v_rd_off<NB>(D0, 0, 1)>(vb), l1 = tr_read<v_rd_off<NB>(D0, 1, 0)>(vb), h1 = tr_read<v_rd_off<NB>(D0, 1, 1)>(vb);
    const s16x4 l2 = tr_read<v_rd_off<NB>(D0, 2, 0)>(vb), h2 = tr_read<v_rd_off<NB>(D0, 2, 1)>(vb), l3 = tr_read<v_rd_off<NB>(D0, 3, 0)>(vb), h3 = tr_read<v_rd_off<NB>(D0, 3, 1)>(vb);
    asm volatile("s_waitcnt lgkmcnt(0)" ::: "memory"); __builtin_amdgcn_sched_barrier(0);
#define AT_PK(L, H) (bf16x8){L[0], L[1], L[2], L[3], H[0], H[1], H[2], H[3]}
    od = __builtin_amdgcn_mfma_f32_32x32x16_bf16(pa0, AT_PK(l0, h0), od, 0, 0, 0);
    od = __builtin_amdgcn_mfma_f32_32x32x16_bf16(pa1, AT_PK(l1, h1), od, 0, 0, 0);
    od = __builtin_amdgcn_mfma_f32_32x32x16_bf16(pa2, AT_PK(l2, h2), od, 0, 0, 0);
    od = __builtin_amdgcn_mfma_f32_32x32x16_bf16(pa3, AT_PK(l3, h3), od, 0, 0, 0);
#undef AT_PK
}
__device__ __forceinline__ float slope_of(int h) { return __builtin_amdgcn_exp2f(-(float)(h + 1)); }

constexpr int L_SCR = 65536, L_TBL = 67584, L_X = 69632;

struct Ptrs { const bf16_t* qkv; bf16_t* att; bf16_t* obr; float* lse; const float* rpb; const float* subln; float lam; const float* kn; };

struct PolDil {
    static constexpr int W = 64, KIND = 0;
    int b, h, br, dil, res, qs0, tlo, thi; float nsl;
    __device__ __forceinline__ void init(int u) {
        br = u >> 11; const int v = u & 2047, sub = v & 15, bh = v >> 4; b = bh >> 3; h = bh & 7;
        dil = br == 0 ? 1 : (br == 1 ? 4 : 16); const int L = T / dil, nqb = L / 256;
        res = sub / nqb; qs0 = (sub % nqb) * 256;
        tlo = qs0 > 0 ? 0 : 1; thi = (qs0 + 256 < L) ? 6 : 5;
        nsl = -slope_of(h) * (float)dil * LOG2E;
    }
    __device__ __forceinline__ long qtok(int wid, int i) const { return (long)b * T + res + dil * (qs0 + 32 * wid + i); }
    __device__ __forceinline__ int qcol(int) const { return h * 64; }
    __device__ __forceinline__ int kcol0() const { return 512 + h * 64; }
    __device__ __forceinline__ int vcol0() const { return 1024 + h * 64; }
    __device__ __forceinline__ int kfrag(int) const { return 0; }
    __device__ __forceinline__ long ktok(int t, int row) const { return (long)b * T + res + dil * (qs0 - 64 + 64 * t + row); }
    __device__ __forceinline__ bool need(int t, int wid) const { return (64 * t - 64 <= 32 * wid + 95) && (64 * t - 1 >= 32 * wid - 64); }
    __device__ __forceinline__ void cinit(f32x16& p0, f32x16& p1, int t, int wid, int r32, int hi, const LAS float*, float m) const {
        const float base = (float)(32 * wid + r32 + 64 - 64 * t - 4 * hi);
#pragma unroll
        for (int r = 0; r < 16; ++r) { const float c = (float)((r & 3) + 8 * (r >> 2));
            const float a0 = fabsf(base - c), a1 = fabsf(base - (c + 32.f));
            p0[r] = a0 <= 64.f ? nsl * a0 - m : -INFINITY; p1[r] = a1 <= 64.f ? nsl * a1 - m : -INFINITY; }
    }
};
struct PolNat {
    static constexpr int W = 64, KIND = 1;
    int b, h, qb, r0, kr0, tlo, thi;
    __device__ __forceinline__ static int clip(int v, int lo, int hi_) { return v < lo ? lo : (v > hi_ ? hi_ : v); }
    __device__ __forceinline__ void init(int u) {
        qb = u & 15; const int bh = u >> 4; b = bh >> 3; h = bh & 7; r0 = 4 * qb;
        kr0 = clip(r0 - 4, 0, 56); tlo = 0; thi = clip(r0 - 1, 0, 56) + 8 - kr0;
    }
    __device__ __forceinline__ long qtok(int wid, int i) const { return (long)b * T + 256 * qb + 32 * wid + i; }
    __device__ __forceinline__ int qcol(int) const { return 1536 + h * 64; }
    __device__ __forceinline__ int kcol0() const { return 2048 + h * 64; }
    __device__ __forceinline__ int vcol0() const { return 2560 + h * 64; }
    __device__ __forceinline__ int kfrag(int) const { return 0; }
    __device__ __forceinline__ long ktok(int t, int row) const { return (long)b * T + 64 * (kr0 + t) + row; }
    __device__ __forceinline__ bool need(int t, int wid) const { const int r = r0 + (wid >> 1), rs = clip(r - 4, 0, 56), kr = kr0 + t; return kr >= rs && kr < rs + 8; }
    __device__ __forceinline__ void cinit(f32x16& p0, f32x16& p1, int t, int wid, int r32, int hi, const LAS float* tbl, float m) const {
        const int r = r0 + (wid >> 1), kr = kr0 + t, c = 32 * (wid & 1) + r32, wc = clip(c - 8, 0, 48);
        const LAS float* trow = tbl + (kr - r + 7) * 32;
#pragma unroll
        for (int q = 0; q < 16; ++q) { const int k0 = (q & 3) + 8 * (q >> 2) + 4 * hi, k1 = k0 + 32;
            const float v0 = trow[clip(k0 - c + 15, 0, 30)], v1 = trow[clip(k1 - c + 15, 0, 30)];
            p0[q] = ((unsigned)(k0 - wc) < 16u) ? v0 - m : -INFINITY; p1[q] = ((unsigned)(k1 - wc) < 16u) ? v1 - m : -INFINITY; }
    }
};
struct PolDiff {
    static constexpr int W = 128, KIND = 2;
    int b, h, qb, tlo, thi; float nsl;
    __device__ __forceinline__ void init(int u) { const int k = u >> 8, c0 = u & 255, c = (c0 & 7) * 32 + (c0 >> 3)  , r = (k >> 3) * 256 + c; h = k & 7; b = r >> 5; qb = r & 31; tlo = 0; thi = T / 64; nsl = -slope_of(h) * LOG2E; }
    __device__ __forceinline__ long qtok(int wid, int i) const { return (long)b * T + 128 * qb + 32 * (wid & 3) + i; }
    __device__ __forceinline__ int qcol(int wid) const { return h * 128 + 64 * (wid >> 2); }
    __device__ __forceinline__ int kcol0() const { return 1024 + h * 128; }
    __device__ __forceinline__ int vcol0() const { return 2048 + h * 128; }
    __device__ __forceinline__ int kfrag(int wid) const { return 64 * (wid >> 2); }
    __device__ __forceinline__ long ktok(int t, int row) const { return (long)b * T + 64 * t + row; }
    __device__ __forceinline__ bool need(int, int) const { return true; }
    template <int BLK> __device__ __forceinline__ void cinit_off(f32x16& p, int t, int wid, int r32, int hi) const {
        const float base = (float)(128 * qb + 32 * (wid & 3) + r32 - 64 * t - 4 * hi - 32 * BLK);
        const float sn = t < 2 * qb ? nsl : -nsl, A = sn * base, cf = -sn;
#pragma unroll
        for (int r = 0; r < 16; ++r) p[r] = fmaf(cf, (float)((r & 3) + 8 * (r >> 2)), A);
    }
    template <int BLK> __device__ __forceinline__ void cinit_abs(f32x16& p, int t, int wid, int r32, int hi) const {
        const float base = (float)(128 * qb + 32 * (wid & 3) + r32 - 64 * t - 4 * hi - 32 * BLK);
#pragma unroll
        for (int r = 0; r < 16; ++r) p[r] = nsl * fabsf(base - (float)((r & 3) + 8 * (r >> 2)));
    }
    __device__ __forceinline__ void cinit(f32x16& p0, f32x16& p1, int t, int wid, int r32, int hi, const LAS float*, float m) const {
        const int i0 = 128 * qb + 32 * (wid & 3);
        const float base = (float)(i0 + r32 - 64 * t - 4 * hi);
        if (64 * t + 63 < i0) {
            const float A = nsl * base - m, n2 = -nsl;
#pragma unroll
            for (int r = 0; r < 16; ++r) { const float c = (float)((r & 3) + 8 * (r >> 2)); p0[r] = fmaf(n2, c, A); p1[r] = fmaf(n2, c + 32.f, A); }
        } else if (64 * t > i0 + 31) {
            const float A = -nsl * base - m;
#pragma unroll
            for (int r = 0; r < 16; ++r) { const float c = (float)((r & 3) + 8 * (r >> 2)); p0[r] = fmaf(nsl, c, A); p1[r] = fmaf(nsl, c + 32.f, A); }
        } else {
#pragma unroll
            for (int r = 0; r < 16; ++r) { const float c = (float)((r & 3) + 8 * (r >> 2));
                p0[r] = nsl * fabsf(base - c) - m; p1[r] = nsl * fabsf(base - (c + 32.f)) - m; }
        }
    }
};

template <class Pol> __device__ __forceinline__ void attn_unit(const Pol& P, LAS unsigned char* lds, const Ptrs& X, bf16x8& pq0, bf16x8& pq1, bf16x8& pq2, bf16x8& pq3, bf16x8& pk_, bf16x8& pv_, bool have, const Pol& Pn, bool hasn);
template <class Pol>
__device__ __forceinline__ void attn_unit(const Pol& P, LAS unsigned char* lds, const Ptrs& X, bf16x8& pq0, bf16x8& pq1, bf16x8& pq2, bf16x8& pq3, bf16x8& pk_, bf16x8& pv_, bool have, const Pol& Pn, bool hasn) {
    constexpr int W = Pol::W, NB = W / 32, CH = W / 64, KBYTES = 64 * W * 2, VBYTES = KBYTES, CPR = W / 8;
    int tid_ = threadIdx.x; asm volatile("" : "+v"(tid_));
    const int tid = tid_, wid = __builtin_amdgcn_readfirstlane(tid >> 6), lane = tid & 63, r32 = lane & 31, hi = lane >> 5;
    LAS unsigned char* K_lds = lds; LAS unsigned char* V_lds = lds + 2 * KBYTES;
    LAS float* li_l = (LAS float*)(lds + L_SCR) + wid * 64; LAS float* al_l = li_l + 32;
    LAS float* tbl = (LAS float*)(lds + L_TBL);
    const bf16_t* qkv = X.qkv;
    if constexpr (Pol::KIND == 1) { if (tid < 480) { const int row = tid >> 5, col = tid & 31; tbl[tid] = col < 31 ? X.rpb[(P.h * 15 + row) * 31 + col] * LOG2E : 0.f; } }
    bf16x8 qr[4];
    const bool pre_ok = Pol::KIND == 0 && have;
    if (pre_ok) {
        qr[0] = pq0; qr[1] = pq1; qr[2] = pq2; qr[3] = pq3;
    } else { const bf16_t* qp = qkv + P.qtok(wid, r32) * NQKV + P.qcol(wid) + hi * 8;
#pragma unroll
      for (int d0 = 0; d0 < 4; ++d0) qr[d0] = *(const bf16x8*)(qp + d0 * 16); }
    const int kfb = P.kfrag(wid) * 2;
    bf16x8 ks[CH], vs[CH];
#define AT_SLOAD(t) do { _Pragma("unroll") for (int i_ = 0; i_ < CH; ++i_) { const int id_ = tid + 512 * i_, row_ = id_ / CPR, col_ = (id_ % CPR) * 8; \
        const bf16_t* g_ = qkv + P.ktok((t), row_) * NQKV + col_; ks[i_] = *(const bf16x8*)(g_ + P.kcol0()); vs[i_] = *(const bf16x8*)(g_ + P.vcol0()); } } while (0)
#define AT_SWRITE(b) do { _Pragma("unroll") for (int i_ = 0; i_ < CH; ++i_) { const int id_ = tid + 512 * i_, row_ = id_ / CPR, col_ = (id_ % CPR) * 8; \
        *(LAS bf16x8*)(K_lds + (b) * KBYTES + row_ * (W * 2) + ((col_ * 2) ^ ((row_ & 7) << 4))) = ks[i_]; \
        *(LAS bf16x8*)(V_lds + (b) * VBYTES + v_st<NB>(row_, col_)) = vs[i_]; } } while (0)
    float m_reg = 0.f, l_reg = 0.f; f32x16 o[NB];
#pragma unroll
    for (int d = 0; d < NB; ++d) o[d] = f32x16{};
    const int vb0 = (int)(unsigned)(size_t)V_lds + v_rd_base(lane);
    const int tlo = P.tlo, thi = P.thi;
    if (pre_ok) { ks[0] = pk_; vs[0] = pv_; } else AT_SLOAD(tlo);
    AT_SWRITE(tlo & 1); __syncthreads();
    for (int t = tlo; t < thi; ++t) {
        const int buf = t & 1;
        if constexpr (Pol::KIND != 2) { if (t + 1 < thi) AT_SLOAD(t + 1); }
        if constexpr (Pol::KIND == 0) { if (t + 1 == thi && hasn) {
            const bf16_t* qp = qkv + Pn.qtok(wid, r32) * NQKV + Pn.qcol(wid) + hi * 8;
            pq0 = *(const bf16x8*)(qp); pq1 = *(const bf16x8*)(qp + 16); pq2 = *(const bf16x8*)(qp + 32); pq3 = *(const bf16x8*)(qp + 48);
            const int row_ = tid / CPR, col_ = (tid % CPR) * 8; const bf16_t* g_ = qkv + Pn.ktok(Pn.tlo, row_) * NQKV + col_;
            pk_ = *(const bf16x8*)(g_ + Pn.kcol0()); pv_ = *(const bf16x8*)(g_ + Pn.vcol0()); } }
        if (P.need(t, wid)) {
            f32x16 p0, p1;
            P.cinit(p0, p1, t, wid, r32, hi, tbl, m_reg);
            const LAS unsigned char* Kb = K_lds + buf * KBYTES;
#pragma unroll
            for (int d0 = 0; d0 < 4; ++d0) { const int cb = kfb + (d0 * 16 + hi * 8) * 2, sw = cb ^ ((r32 & 7) << 4);
                const bf16x8 b0 = *(const LAS bf16x8*)(Kb + r32 * (W * 2) + sw);
                const bf16x8 b1 = *(const LAS bf16x8*)(Kb + (32 + r32) * (W * 2) + sw);
                p0 = __builtin_amdgcn_mfma_f32_32x32x16_bf16(b0, qr[d0], p0, 0, 0, 0);
                p1 = __builtin_amdgcn_mfma_f32_32x32x16_bf16(b1, qr[d0], p1, 0, 0, 0); }
            float pmax = fmaxf(p0[0], p1[0]);
#pragma unroll
            for (int r = 1; r < 16; ++r) pmax = fmaxf(fmaxf(pmax, p0[r]), p1[r]);
            { auto rr = __builtin_amdgcn_permlane32_swap(__float_as_uint(pmax), __float_as_uint(pmax), false, false);
              pmax = fmaxf(__uint_as_float(rr[0]), __uint_as_float(rr[1])); }
            float alpha = 1.f;
            if (__builtin_expect(!__all(pmax <= THR), 0)) {
                const float dm = fmaxf(pmax, 0.f); alpha = __builtin_amdgcn_exp2f(-dm); m_reg += dm;
#pragma unroll
                for (int r = 0; r < 16; ++r) { p0[r] -= dm; p1[r] -= dm; }
            }
            float ps = 0.f;
#pragma unroll
            for (int r = 0; r < 16; ++r) { p0[r] = __builtin_amdgcn_exp2f(p0[r]); p1[r] = __builtin_amdgcn_exp2f(p1[r]); ps += p0[r] + p1[r]; }
            { auto rr = __builtin_amdgcn_permlane32_swap(__float_as_uint(ps), __float_as_uint(ps), false, false);
              ps = __uint_as_float(rr[0]) + __uint_as_float(rr[1]); }
            l_reg = l_reg * alpha + ps;
            if (__any(alpha < 1.f)) { if (hi == 0) al_l[r32] = alpha; asm volatile("s_waitcnt lgkmcnt(0)" ::: "memory");
#pragma unroll
                for (int r = 0; r < 16; ++r) { const float a = al_l[crow(r, hi)];
#pragma unroll
                    for (int d = 0; d < NB; ++d) o[d][r] *= a; }
                asm volatile("s_waitcnt lgkmcnt(0)" ::: "memory"); }
            bf16x8 pa0, pa1, pa2, pa3;
#define AT_PK4(PP, BASE, OUT) do { unsigned a0 = cvtpk(PP[BASE + 0], PP[BASE + 1]), a1 = cvtpk(PP[BASE + 2], PP[BASE + 3]); \
    unsigned b0_ = cvtpk(PP[BASE + 4], PP[BASE + 5]), b1_ = cvtpk(PP[BASE + 6], PP[BASE + 7]); \
    auto r0_ = __builtin_amdgcn_permlane32_swap(a0, b0_, false, false); auto r1_ = __builtin_amdgcn_permlane32_swap(a1, b1_, false, false); \
    u32x4 w_ = {r0_[0], r1_[0], r0_[1], r1_[1]}; OUT = *reinterpret_cast<bf16x8*>(&w_); } while (0)
            AT_PK4(p0, 0, pa0); AT_PK4(p0, 8, pa1); AT_PK4(p1, 0, pa2); AT_PK4(p1, 8, pa3);
#undef AT_PK4
            const int vb = vb0 + buf * VBYTES;
            pv_one<NB, 0>(o[0], vb, pa0, pa1, pa2, pa3); pv_one<NB, 1>(o[1], vb, pa0, pa1, pa2, pa3);
            if constexpr (NB == 4) { pv_one<NB, 2>(o[2], vb, pa0, pa1, pa2, pa3); pv_one<NB, 3>(o[3], vb, pa0, pa1, pa2, pa3); }
        }
        if (t + 1 < thi) { if constexpr (Pol::KIND == 2) AT_SLOAD(t + 1); AT_SWRITE(buf ^ 1); }
        __syncthreads();
    }
#undef AT_SLOAD
#undef AT_SWRITE
    if (hi == 0) li_l[r32] = l_reg;
    asm volatile("s_waitcnt lgkmcnt(0)" ::: "memory");
    float rli[16];
#pragma unroll
    for (int r = 0; r < 16; ++r) rli[r] = __builtin_amdgcn_rcpf(li_l[crow(r, hi)]);
    if constexpr (Pol::KIND == 0) {
        bf16_t* ob = X.obr + (size_t)P.br * ((size_t)M * 512);
#pragma unroll
        for (int r = 0; r < 16; ++r) { const long tok = P.qtok(wid, crow(r, hi));
#pragma unroll
            for (int d = 0; d < NB; ++d) ob[tok * 512 + P.h * 64 + d * 32 + r32] = (bf16_t)(cvtpk(o[d][r] * rli[r], 0.f) & 0xffffu); }
        if (hi == 0) X.lse[(size_t)P.br * ((size_t)M * 8) + P.qtok(wid, r32) * 8 + P.h] = m_reg + __builtin_amdgcn_logf(l_reg);
    } else if constexpr (Pol::KIND == 1) {
#pragma unroll
        for (int r = 0; r < 16; ++r) { const long tok = P.qtok(wid, crow(r, hi));
#pragma unroll
            for (int d = 0; d < NB; ++d) X.att[tok * D + 512 + P.h * 64 + d * 32 + r32] = (bf16_t)(cvtpk(o[d][r] * rli[r], 0.f) & 0xffffu); }
    } else {
        LAS float* XB = (LAS float*)(lds + L_X);
        if (wid >= 4) {
#pragma unroll
            for (int r = 0; r < 16; ++r) { const int row = 32 * (wid & 3) + crow(r, hi);
#pragma unroll
                for (int d = 0; d < NB; ++d) XB[row * 128 + d * 32 + r32] = X.lam * o[d][r] * rli[r]; }
        }
        __syncthreads();
        if (wid < 4) {
#pragma unroll
            for (int r = 0; r < 16; ++r) { const int row = 32 * wid + crow(r, hi); float s = 0.f;
#pragma unroll
                for (int d = 0; d < NB; ++d) { const float y = o[d][r] * rli[r] - XB[row * 128 + d * 32 + r32]; o[d][r] = y; s += y * y; }
                s += sx(s, 1, lane); s += sx(s, 2, lane); s += sx(s, 4, lane); s += sx(s, 8, lane); s += sx(s, 16, lane);
                const float rs = (1.0f - LAM_INIT) / sqrtf(s * (1.0f / 128.f) + SUBLN_EPS);
                const long tok = P.qtok(wid, crow(r, hi));
#pragma unroll
                for (int d = 0; d < NB; ++d) X.att[tok * D + P.h * 128 + d * 32 + r32] = (bf16_t)(cvtpk(o[d][r] * rs * X.subln[d * 32 + r32], 0.f) & 0xffffu); }
        }
        __syncthreads();
    }
}

template <class Pol> __device__ __forceinline__ void attn_unit(const Pol& P, LAS unsigned char* lds, const Ptrs& X) { bf16x8 z0_ = {}, z1_ = {}, z2_ = {}, z3_ = {}, z4_ = {}, z5_ = {}; attn_unit(P, lds, X, z0_, z1_, z2_, z3_, z4_, z5_, false, P, false); }
typedef __bf16 bf16x2_t __attribute__((ext_vector_type(2)));
typedef float f32x2_t __attribute__((ext_vector_type(2)));
__device__ __forceinline__ unsigned pk2(float lo, float hi) { const f32x2_t v = {lo, hi}; return __builtin_bit_cast(unsigned, __builtin_convertvector(v, bf16x2_t)); }
__device__ __forceinline__ s16x4 trb(const LAS unsigned char* p) { return __builtin_amdgcn_ds_read_tr16_b64_v4i16((LAS s16x4*)p); }
template <int D0> __device__ __forceinline__ void pv_blk(f32x16& od, const LAS unsigned char* vb, bf16x8 pa0, bf16x8 pa1, bf16x8 pa2, bf16x8 pa3) {
    constexpr int NB = 4;
    const s16x4 l0 = trb(vb + v_rd_off<NB>(D0, 0, 0)), h0 = trb(vb + v_rd_off<NB>(D0, 0, 1)), l1 = trb(vb + v_rd_off<NB>(D0, 1, 0)), h1 = trb(vb + v_rd_off<NB>(D0, 1, 1));
    const s16x4 l2 = trb(vb + v_rd_off<NB>(D0, 2, 0)), h2 = trb(vb + v_rd_off<NB>(D0, 2, 1)), l3 = trb(vb + v_rd_off<NB>(D0, 3, 0)), h3 = trb(vb + v_rd_off<NB>(D0, 3, 1));
#define AT_PK(L, H) (bf16x8){L[0], L[1], L[2], L[3], H[0], H[1], H[2], H[3]}
    od = __builtin_amdgcn_mfma_f32_32x32x16_bf16(pa0, AT_PK(l0, h0), od, 0, 0, 0);
    od = __builtin_amdgcn_mfma_f32_32x32x16_bf16(pa1, AT_PK(l1, h1), od, 0, 0, 0);
    od = __builtin_amdgcn_mfma_f32_32x32x16_bf16(pa2, AT_PK(l2, h2), od, 0, 0, 0);
    od = __builtin_amdgcn_mfma_f32_32x32x16_bf16(pa3, AT_PK(l3, h3), od, 0, 0, 0);
#undef AT_PK
}
constexpr int DF_SCR = 98304;
__device__ __forceinline__ void diff_unit(const PolDiff& P, LAS unsigned char* lds, const Ptrs& X) {
    constexpr int W = 128, NB = 4, CH = 2, KBYTES = 64 * W * 2, VBYTES = KBYTES, NT = T / 64;
    int tid_ = threadIdx.x; asm volatile("" : "+v"(tid_));
    const int tid = tid_, wid = __builtin_amdgcn_readfirstlane(tid >> 6), lane = tid & 63, r32 = lane & 31, hi = lane >> 5;
    LAS unsigned char* K_lds = lds; LAS unsigned char* V_lds = lds + 3 * KBYTES;
    LAS float* li_l = (LAS float*)(lds + DF_SCR) + wid * 64;
    LAS unsigned* flag = (LAS unsigned*)(lds + DF_SCR + 8 * 256);
    const bf16_t* qkv = X.qkv;
    bf16x8 qr[4];
    { const bf16_t* qp = qkv + P.qtok(wid, r32) * NQKV + P.qcol(wid) + hi * 8;
#pragma unroll
      for (int d0 = 0; d0 < 4; ++d0) qr[d0] = *(const bf16x8*)(qp + d0 * 16); }
    const int kfb = P.kfrag(wid) * 2;
    int gko, gvo;
    { const int row = 4 * wid + (lane >> 4), c = (lane & 15) ^ (row & 7); gko = row * NQKV + P.kcol0() + 8 * c; }
    { const int sidx = 2 * wid + (lane >> 5), kk = 8 * (sidx >> 2) + ((lane & 31) >> 2), k = (kk & ~0xC) | ((kk & 4) << 1) | ((kk & 8) >> 1), c = 32 * (sidx & 3) + 8 * (lane & 3);
      gvo = k * NQKV + P.vcol0() + c; }
    const bf16_t* gtile = qkv + (long)P.b * T * NQKV;
    const LAS unsigned char* krd = K_lds + r32 * (W * 2);
    const LAS unsigned char* vrd = V_lds + v_rd_base(lane);
    if (tid == 0) flag[0] = 0u;
    int t_lo, n_tiles;
    { float q2 = 0.f;
#pragma unroll
      for (int d0 = 0; d0 < 4; ++d0)
#pragma unroll
          for (int e = 0; e < 8; ++e) { const float f = bf2f((unsigned short)qr[d0][e]); q2 = fmaf(f, f, q2); }
      q2 += sx(q2, 32, lane);
#pragma unroll
      for (int o_ = 1; o_ < 32; o_ <<= 1) q2 = fmaxf(q2, sx(q2, o_, lane));
      if (lane == 0) li_l[0] = q2;
      __syncthreads();
      float qm1 = 0.f, qm2 = 0.f;
#pragma unroll
      for (int w_ = 0; w_ < 4; ++w_) { qm1 = fmaxf(qm1, ((LAS float*)(lds + DF_SCR))[w_ * 64]); qm2 = fmaxf(qm2, ((LAS float*)(lds + DF_SCR))[(w_ + 4) * 64]); }
      qm1 = sqrtf(qm1) * 1.01f; qm2 = sqrtf(qm2) * 1.01f;
      const float* kn = X.kn + ((P.b * 8 + P.h) * 2) * 128;
      const float k1_ = sqrtf(kn[2 * lane] + kn[2 * lane + 1]) * 1.001f, k2_ = sqrtf(kn[128 + 2 * lane] + kn[128 + 2 * lane + 1]) * 1.001f;
      const float sb = fmaxf(qm1 * k1_, qm2 * k2_);
      const int i0u = 128 * P.qb;
      const int dist = lane < 2 * P.qb ? i0u - (64 * lane + 63) : (lane > 2 * P.qb + 1 ? 64 * lane - (i0u + 127) : 0);
      const bool visit = sb + P.nsl * (float)dist > -152.f;
      const unsigned long long mask = __ballot(visit) | (3ull << (2 * P.qb));
      int lo = __builtin_ctzll(mask), hi_t = 63 - __builtin_clzll(mask);
      if (((hi_t - lo + 1) & 1) != 0) { if (lo > 0) --lo; else ++hi_t; }
      if (hi_t - lo + 1 < 4) { if (lo > 1) lo -= 2; else hi_t += 2; }
      t_lo = __builtin_amdgcn_readfirstlane(lo); n_tiles = __builtin_amdgcn_readfirstlane(hi_t - lo + 1);
      __syncthreads();
    }
#define DF_TL(k) ((k) < 2 ? 2 * P.qb + (k) : (t_lo + (k) - 2 < 2 * P.qb ? t_lo + (k) - 2 : t_lo + (k)))
#define DF_GLDS(k, rb) do { const bf16_t* g_ = gtile + (long)(64 * DF_TL(k)) * NQKV; _Pragma("unroll") for (int i_ = 0; i_ < 2; ++i_) { \
        __builtin_amdgcn_global_load_lds((const unsigned*)(g_ + gko + i_ * (32 * NQKV)), (LAS unsigned*)(K_lds + (rb) * KBYTES + (wid + 8 * i_) * 1024), 16, 0, 0); \
        __builtin_amdgcn_global_load_lds((const unsigned*)(g_ + gvo + i_ * (32 * NQKV)), (LAS unsigned*)(V_lds + (rb) * VBYTES + (wid + 8 * i_) * 1024), 16, 0, 0); } } while (0)
#define DF_QK(p0, p1, rb) do { const LAS unsigned char* Kb_ = krd + (rb) * KBYTES; \
        _Pragma("unroll") for (int d0 = 0; d0 < 4; ++d0) { const int sw_ = (kfb + (d0 * 16 + hi * 8) * 2) ^ ((r32 & 7) << 4); \
            const bf16x8 b0_ = *(const LAS bf16x8*)(Kb_ + sw_); const bf16x8 b1_ = *(const LAS bf16x8*)(Kb_ + 32 * (W * 2) + sw_); \
            p0 = __builtin_amdgcn_mfma_f32_32x32x16_bf16(b0_, qr[d0], p0, 0, 0, 0); p1 = __builtin_amdgcn_mfma_f32_32x32x16_bf16(b1_, qr[d0], p1, 0, 0, 0); } } while (0)
#define DF_KRD(b0v, b1v, rb, d0) do { const LAS unsigned char* Kb_ = krd + (rb) * KBYTES; const int sw_ = (kfb + ((d0) * 16 + hi * 8) * 2) ^ ((r32 & 7) << 4); \
        b0v = *(const LAS bf16x8*)(Kb_ + sw_); b1v = *(const LAS bf16x8*)(Kb_ + 32 * (W * 2) + sw_); } while (0)
#define DF_KMM(p0, p1, b0v, b1v, d0) do { p0 = __builtin_amdgcn_mfma_f32_32x32x16_bf16(b0v, qr[d0], p0, 0, 0, 0); p1 = __builtin_amdgcn_mfma_f32_32x32x16_bf16(b1v, qr[d0], p1, 0, 0, 0); } while (0)
#define DF_QK1(p0, p1, rb, d0) do { const LAS unsigned char* Kb_ = krd + (rb) * KBYTES; const int sw_ = (kfb + ((d0) * 16 + hi * 8) * 2) ^ ((r32 & 7) << 4); \
        const bf16x8 b0_ = *(const LAS bf16x8*)(Kb_ + sw_); const bf16x8 b1_ = *(const LAS bf16x8*)(Kb_ + 32 * (W * 2) + sw_); \
        p0 = __builtin_amdgcn_mfma_f32_32x32x16_bf16(b0_, qr[d0], p0, 0, 0, 0); p1 = __builtin_amdgcn_mfma_f32_32x32x16_bf16(b1_, qr[d0], p1, 0, 0, 0); } while (0)
#define DF_SUM16(p) ((((p[0] + p[1]) + (p[2] + p[3])) + ((p[4] + p[5]) + (p[6] + p[7]))) + (((p[8] + p[9]) + (p[10] + p[11])) + ((p[12] + p[13]) + (p[14] + p[15]))))
#define DF_EXP_H(pp, b8) do { _Pragma("unroll") for (int r = 0; r < 8; ++r) pp[(b8) + r] = __builtin_amdgcn_exp2f(pp[(b8) + r]); } while (0)
#define DF_EXP_A(p0, p1) do { _Pragma("unroll") for (int r = 0; r < 16; ++r) p0[r] = __builtin_amdgcn_exp2f(p0[r]); _Pragma("unroll") for (int r = 0; r < 8; ++r) p1[r] = __builtin_amdgcn_exp2f(p1[r]); } while (0)
#define DF_FINISH(p0, p1) do { _Pragma("unroll") for (int r = 8; r < 16; ++r) p1[r] = __builtin_amdgcn_exp2f(p1[r]); \
        float ps_ = 0.f; _Pragma("unroll") for (int r = 0; r < 16; ++r) ps_ += p0[r] + p1[r]; l_reg += ps_; \
        DF_PK4(p0, 0, pa0); DF_PK4(p0, 8, pa1); DF_PK4(p1, 0, pa2); DF_PK4(p1, 8, pa3); } while (0)
#define DF_PK4(PP, BASE, OUT) do { unsigned a0 = pk2(PP[BASE + 0], PP[BASE + 1]), a1 = pk2(PP[BASE + 2], PP[BASE + 3]); \
    unsigned b0_ = pk2(PP[BASE + 4], PP[BASE + 5]), b1_ = pk2(PP[BASE + 6], PP[BASE + 7]); \
    auto r0_ = __builtin_amdgcn_permlane32_swap(a0, b0_, false, false); auto r1_ = __builtin_amdgcn_permlane32_swap(a1, b1_, false, false); \
    u32x4 w_ = {r0_[0], r1_[0], r0_[1], r1_[1]}; OUT = *reinterpret_cast<bf16x8*>(&w_); } while (0)
#define DF_PV(rb) do { const LAS unsigned char* vb_ = vrd + (rb) * VBYTES; pv_blk<0>(o[0], vb_, pa0, pa1, pa2, pa3); pv_blk<1>(o[1], vb_, pa0, pa1, pa2, pa3); \
        pv_blk<2>(o[2], vb_, pa0, pa1, pa2, pa3); pv_blk<3>(o[3], vb_, pa0, pa1, pa2, pa3); } while (0)
#define DF_HALF(c0, c1, q0, q1, j, LOADS) do { \
        DF_KRD(ka0, ka1, rc, 0); if (LOADS) DF_GLDS((j) + 1, rn); __builtin_amdgcn_sched_barrier(0);     \
        { float ps0_ = 0.f, ps1_ = 0.f; \
          DF_KRD(kb0, kb1, rc, 1); DF_KMM(c0, c1, ka0, ka1, 0); DF_EXP_H(q1, 8); __builtin_amdgcn_sched_barrier(0); \
          DF_KRD(ka0, ka1, rc, 2); DF_KMM(c0, c1, kb0, kb1, 1); ps0_ = DF_SUM16(q0); DF_PK4(q0, 0, pa0); __builtin_amdgcn_sched_barrier(0); \
          DF_KRD(kb0, kb1, rc, 3); DF_KMM(c0, c1, ka0, ka1, 2); ps1_ = DF_SUM16(q1); DF_PK4(q0, 8, pa1); __builtin_amdgcn_sched_barrier(0); \
          DF_KMM(c0, c1, kb0, kb1, 3); l_reg += ps0_ + ps1_; DF_PK4(q1, 0, pa2); DF_PK4(q1, 8, pa3); __builtin_amdgcn_sched_barrier(0); } \
        { const LAS unsigned char* vb_ = vrd + rp * VBYTES; \
          pv_blk<0>(o[0], vb_, pa0, pa1, pa2, pa3); DF_EXP_H(c0, 0); __builtin_amdgcn_sched_barrier(0); \
          pv_blk<1>(o[1], vb_, pa0, pa1, pa2, pa3); DF_EXP_H(c0, 8); __builtin_amdgcn_sched_barrier(0); \
          pv_blk<2>(o[2], vb_, pa0, pa1, pa2, pa3); DF_EXP_H(c1, 0); if (LOADS) P.cinit_off<0>(q0, DF_TL((j) + 1), wid, r32, hi); __builtin_amdgcn_sched_barrier(0); \
          pv_blk<3>(o[3], vb_, pa0, pa1, pa2, pa3); if (LOADS) P.cinit_off<1>(q1, DF_TL((j) + 1), wid, r32, hi); __builtin_amdgcn_sched_barrier(0); } \
        __syncthreads(); { const int t_ = rp; rp = rc; rc = rn; rn = t_; } } while (0)
    float l_reg = 0.f; f32x16 o[NB];
#pragma unroll
    for (int d = 0; d < NB; ++d) o[d] = f32x16{};
    f32x16 pA0, pA1, pB0, pB1; bf16x8 pa0, pa1, pa2, pa3, ka0, ka1, kb0, kb1;
    int rp = 2, rc = 0, rn = 1;
    DF_GLDS(0, 0); DF_GLDS(1, 1); __syncthreads();
    P.cinit_abs<0>(pA0, DF_TL(0), wid, r32, hi); P.cinit_abs<1>(pA1, DF_TL(0), wid, r32, hi); DF_QK(pA0, pA1, 0); DF_EXP_A(pA0, pA1);
    P.cinit_abs<0>(pB0, DF_TL(1), wid, r32, hi); P.cinit_abs<1>(pB1, DF_TL(1), wid, r32, hi);
    rp = 0; rc = 1; rn = 2;
    { int j = 1;
      do { DF_HALF(pB0, pB1, pA0, pA1, j, true);
           DF_HALF(pA0, pA1, pB0, pB1, j + 1, true); j += 2; } while (j + 2 < n_tiles); }
    DF_HALF(pB0, pB1, pA0, pA1, n_tiles - 1, false);
    DF_FINISH(pB0, pB1); DF_PV(rp);
#undef DF_GLDS
#undef DF_TL
#undef DF_QK
#undef DF_EXP_A
#undef DF_QK1
#undef DF_KRD
#undef DF_KMM
#undef DF_SUM16
#undef DF_EXP_H
#undef DF_FINISH
#undef DF_PK4
#undef DF_PV
#undef DF_HALF
    int tid2_ = threadIdx.x; asm volatile("" : "+v"(tid2_));
    const int lane2 = tid2_ & 63, r32b = lane2 & 31, hib = lane2 >> 5;
    { auto rr = __builtin_amdgcn_permlane32_swap(__float_as_uint(l_reg), __float_as_uint(l_reg), false, false);
      l_reg = __uint_as_float(rr[0]) + __uint_as_float(rr[1]); }
    const bool bad = !(l_reg > 7.9e-31f && l_reg < 1.2e30f);
    if (__any(bad) && lane2 == 0) flag[0] = 1u;
    __syncthreads();
    const bool redo = __builtin_amdgcn_readfirstlane((int)flag[0]) != 0;
    __syncthreads();
    if (redo) { attn_unit(P, lds, X); return; }
    if (hib == 0) li_l[r32b] = l_reg;
    asm volatile("s_waitcnt lgkmcnt(0)" ::: "memory");
    float rli[16];
#pragma unroll
    for (int r = 0; r < 16; ++r) rli[r] = __builtin_amdgcn_rcpf(li_l[crow(r, hib)]);
    LAS float* XB = (LAS float*)lds;
    if (wid >= 4) {
#pragma unroll
        for (int r = 0; r < 16; ++r) { const int row = 32 * (wid & 3) + crow(r, hib);
#pragma unroll
            for (int d = 0; d < NB; ++d) XB[row * 128 + d * 32 + r32b] = X.lam * o[d][r] * rli[r]; }
    }
    __syncthreads();
    if (wid < 4) {
#pragma unroll
        for (int r = 0; r < 16; ++r) { const int row = 32 * wid + crow(r, hib); float s = 0.f;
#pragma unroll
            for (int d = 0; d < NB; ++d) { const float y = o[d][r] * rli[r] - XB[row * 128 + d * 32 + r32b]; o[d][r] = y; s += y * y; }
            s += sx(s, 1, lane2); s += sx(s, 2, lane2); s += sx(s, 4, lane2); s += sx(s, 8, lane2); s += sx(s, 16, lane2);
            const float rs = (1.0f - LAM_INIT) / sqrtf(s * (1.0f / 128.f) + SUBLN_EPS);
            const long tok = P.qtok(wid, crow(r, hib));
#pragma unroll
            for (int d = 0; d < NB; ++d) X.att[tok * D + P.h * 128 + d * 32 + r32b] = (bf16_t)(pk2(o[d][r] * rs * X.subln[d * 32 + r32b], 0.f) & 0xffffu); }
    }
    __syncthreads();
}
}

#define XB_TMO      128
#define XB_XCNT(j)  (256  + 64 * (j))
#define XB_XSUB(j)  (1280 + 64 * (j))
#define XB_XGEN(j)  (2304 + 64 * (j))
#define XB_TOP      3328
#define XB_TOPGEN   3392
#define XCD_BAR_WORDS 3456
#define XB_SPIN_CAP (1u << 18)

__device__ __forceinline__ unsigned xb_ld(unsigned* p)              { return __hip_atomic_load(p, __ATOMIC_RELAXED, __HIP_MEMORY_SCOPE_AGENT); }
__device__ __forceinline__ unsigned xb_add(unsigned* p, unsigned v) { return __hip_atomic_fetch_add(p, v, __ATOMIC_RELAXED, __HIP_MEMORY_SCOPE_AGENT); }
__device__ __forceinline__ unsigned xb_xcc_id() { return (unsigned)__builtin_amdgcn_s_getreg((3 << 11) | 20) & 0xFu; }
#define XB_SPIN(cond, bar) do { unsigned _sp = 0; while (cond) { __builtin_amdgcn_s_sleep(1); \
    if ((++_sp & 255u) == 0u) { if (xb_ld(&(bar)[XB_TMO])) break; if (_sp > XB_SPIN_CAP) { atomicAdd(&(bar)[XB_TMO], 1u); break; } } } } while (0)

struct XcdBarrier {
    unsigned* bar; unsigned x;
    volatile LAS unsigned* st;
};

__device__ __forceinline__ XcdBarrier xcd_barrier_post(unsigned* bar, volatile LAS unsigned* st) {
    XcdBarrier b; b.bar = bar; b.x = xb_xcc_id(); b.st = st;
    if (threadIdx.x == 0) (void)xb_add(&bar[XB_XCNT(b.x)], 1u);
    return b;
}
__device__ __forceinline__ void xcd_barrier_complete(unsigned* bar, unsigned x, unsigned& nloc, unsigned& nx) {
    const unsigned G = gridDim.x * gridDim.y * gridDim.z;
    unsigned sum, cnt, mine, sp = 0u;
    for (;;) {
        sum = 0u; cnt = 0u; mine = 0u;
#pragma unroll
        for (unsigned j = 0; j < 16; ++j) { const unsigned c = xb_ld(&bar[XB_XCNT(j)]); sum += c; cnt += (c > 0u) ? 1u : 0u; mine = (j == x) ? c : mine; }
        if (sum == G) break;
        __builtin_amdgcn_s_sleep(1);
        if ((++sp & 255u) == 0u) { if (xb_ld(&bar[XB_TMO])) break; if (sp > XB_SPIN_CAP) { atomicAdd(&bar[XB_TMO], 1u); break; } }
    }
    nloc = mine > 0u ? mine : 1u; nx = cnt > 0u ? cnt : 1u;
}

__device__ __forceinline__ void xcd_barrier(const XcdBarrier& b) {
    asm volatile("s_waitcnt vmcnt(0)" ::: "memory");
    __syncthreads();
    if (threadIdx.x == 0) {
        unsigned* bar = b.bar;
        __builtin_amdgcn_s_waitcnt(0);
        unsigned nloc = b.st[0], nx = b.st[1];
        if (nloc == 0u) { xcd_barrier_complete(bar, b.x, nloc, nx); b.st[0] = nloc; b.st[1] = nx; }
        const unsigned old = xb_add(&bar[XB_XSUB(b.x)], 1u);
        const unsigned gen = old / nloc;
        if (old + 1u == (gen + 1u) * nloc) {
            __builtin_amdgcn_fence(__ATOMIC_RELEASE, "agent");
            asm volatile("s_waitcnt vmcnt(0)" ::: "memory");
            const unsigned og = xb_add(&bar[XB_TOP], 1u);
            const unsigned tg = og / nx;
            if (og + 1u == (tg + 1u) * nx) xb_add(&bar[XB_TOPGEN], 1u);
            else XB_SPIN(xb_ld(&bar[XB_TOPGEN]) == tg, bar);
            __builtin_amdgcn_fence(__ATOMIC_ACQUIRE, "agent");
            xb_add(&bar[XB_XGEN(b.x)], 1u);
            asm volatile("s_waitcnt vmcnt(0)" ::: "memory");
        } else {
            XB_SPIN(xb_ld(&bar[XB_XGEN(b.x)]) == gen, bar);
            __builtin_amdgcn_fence(__ATOMIC_ACQUIRE, "agent");
            asm volatile("s_waitcnt vmcnt(0)" ::: "memory");
        }
    }
    __syncthreads();
}

constexpr size_t MiB = 1u << 20;
constexpr size_t WS_W = 2 * MiB, WS_WL = 26 * MiB;
constexpr size_t WO_IN = 0, WO_O = 6 * MiB, WO_GU = 8 * MiB, WO_D = 19 * MiB;
constexpr size_t WS_BAR = 512 * 1024, WS_BAR_BYTES = 16384;
constexpr size_t WS_KN = 0;
constexpr size_t WS_SS = 56 * MiB, WS_LSE = 60 * MiB, WS_XB = 68 * MiB, WS_ATT = 196 * MiB, WS_OBR = 324 * MiB, WS_QKV = 516 * MiB, WS_H = WS_QKV, WS_END = 900 * MiB;
constexpr int LDS_BYTES = 147456;

struct Args { const float* in[22]; float* out; unsigned char* ws; int ph_lo, ph_hi; };
enum { I_X = 0, I_A0N = 1, I_A0IN = 2, I_A0OUT = 3, I_RPB = 4, I_F0N = 5, I_F0G = 6, I_F0U = 7, I_F0D = 8, I_A1N = 9, I_A1QKV = 10, I_A1OUT = 11,
       I_LQ1 = 12, I_LK1 = 13, I_LQ2 = 14, I_LK2 = 15, I_SUBLN = 16, I_F1N = 17, I_F1G = 18, I_F1U = 19, I_F1D = 20, I_FN = 21 };
constexpr int NPH = 14;

__device__ __forceinline__ float wave_sum(float v, int lane) {
#pragma unroll
    for (int o = 1; o < 64; o <<= 1) v += sx(v, o, lane);
    return v;
}
__device__ __forceinline__ void transpose_item(const float* W, const float* gain, int K, int N, bf16_t* WT, int mode, LAS float* scr, int item, int lane) {
    const int nblk = N / 32, kb = item / nblk, nb = item % nblk, k0 = 64 * kb, n0 = 32 * nb;
#pragma unroll 8
    for (int i = 0; i < 32; ++i) { const int kk = 2 * i + (lane >> 5); const float g = gain ? gain[k0 + kk] : 1.0f; scr[kk * 33 + (lane & 31)] = W[(size_t)(k0 + kk) * N + n0 + (lane & 31)] * g; }
    asm volatile("s_waitcnt lgkmcnt(0)" ::: "memory");
    const int c = lane & 7;
    const int ob = mode == 0 ? n0 : 256 * (n0 >> 7) + 128 * (mode - 1) + (n0 & 127);
#pragma unroll
    for (int j = 0; j < 4; ++j) { const int n = (lane >> 3) + 8 * j; const LAS float* s = scr + (8 * c) * 33 + n;
        u32x4 o; o.x = cvtpk(s[0 * 33], s[1 * 33]); o.y = cvtpk(s[2 * 33], s[3 * 33]); o.z = cvtpk(s[4 * 33], s[5 * 33]); o.w = cvtpk(s[6 * 33], s[7 * 33]);
        *(u32x4*)(WT + (size_t)(ob + n) * K + k0 + 8 * c) = o; }
    asm volatile("s_waitcnt lgkmcnt(0)" ::: "memory");
}

__global__ void __launch_bounds__(512, 2) mk_fwd(Args a) {
    extern __shared__ __attribute__((aligned(16))) unsigned char lds_raw[];
    LAS unsigned char* lds = (LAS unsigned char*)lds_raw;
    cg::grid_group grid = cg::this_grid();
    { volatile LAS unsigned* st_ = (volatile LAS unsigned*)(lds + LDS_BYTES - 64); if (threadIdx.x < 2) st_[threadIdx.x] = 0u; }
    __syncthreads();
    const XcdBarrier bar = xcd_barrier_post((unsigned*)(a.ws + WS_BAR), (volatile LAS unsigned*)(lds + LDS_BYTES - 64));
    if (a.ph_lo < 0) grid.sync();
    const int wave = __builtin_amdgcn_readfirstlane((int)threadIdx.x >> 6);
    const int G = gridDim.x, gw = blockIdx.x * 8 + wave, NGW = G * 8;
    unsigned char* ws = a.ws;
    float* ss = (float*)(ws + WS_SS); float* lse = (float*)(ws + WS_LSE);
    bf16_t* xb = (bf16_t*)(ws + WS_XB); bf16_t* att = (bf16_t*)(ws + WS_ATT); bf16_t* obr = (bf16_t*)(ws + WS_OBR);
    bf16_t* qkv = (bf16_t*)(ws + WS_QKV); bf16_t* hb = (bf16_t*)(ws + WS_H);

#ifdef MK_PROBE_SYNCS
    for (int i_ = 0; i_ < MK_PROBE_SYNCS; ++i_) xcd_barrier(bar);
#endif
    for (int ph = a.ph_lo; ph < a.ph_hi; ++ph)
    for (int rep = 0; rep <= ((MK_DUP_MASK >> ph) & 1); ++rep) {
        if (ph == 0) {
            int tq_ = threadIdx.x; asm volatile("" : "+v"(tq_)); const int lane = tq_ & 63;
            LAS float* scr = (LAS float*)(lds + wave * 16384);
            constexpr int I_IN = 16 * 96, I_O = 16 * 32, I_G = 16 * 88, I_D = 44 * 32, I_L = I_IN + I_O + 2 * I_G + I_D;
            for (int it = gw; it < 2 * I_L; it += NGW) {
                const int l = it / I_L; int r = it % I_L; unsigned char* wl = ws + WS_W + (size_t)l * WS_WL;
                const float* an = a.in[l ? I_A1N : I_A0N]; const float* fn = a.in[l ? I_F1N : I_F0N];
                if (r < I_IN) { transpose_item(a.in[l ? I_A1QKV : I_A0IN], an, D, NQKV, (bf16_t*)(wl + WO_IN), 0, scr, r, lane); continue; } r -= I_IN;
                if (r < I_O) { transpose_item(a.in[l ? I_A1OUT : I_A0OUT], nullptr, D, D, (bf16_t*)(wl + WO_O), 0, scr, r, lane); continue; } r -= I_O;
                if (r < I_G) { transpose_item(a.in[l ? I_F1G : I_F0G], fn, D, FF, (bf16_t*)(wl + WO_GU), 1, scr, r, lane); continue; } r -= I_G;
                if (r < I_G) { transpose_item(a.in[l ? I_F1U : I_F0U], fn, D, FF, (bf16_t*)(wl + WO_GU), 2, scr, r, lane); continue; } r -= I_G;
                transpose_item(a.in[l ? I_F1D : I_F0D], nullptr, FF, D, (bf16_t*)(wl + WO_D), 0, scr, r, lane);
            }
            const float* x = a.in[I_X];
            for (int m = gw; m < M; m += 2 * NGW) {
                const f32x4* xr0 = (const f32x4*)(x + (size_t)m * D) + lane; const f32x4* xr1 = (const f32x4*)(x + (size_t)(m + NGW) * D) + lane; f32x4 v0[4], v1[4];
#pragma unroll
                for (int j = 0; j < 4; ++j) { v0[j] = xr0[64 * j]; v1[j] = xr1[64 * j]; }
                float s0 = 0.f, s1 = 0.f;
#pragma unroll
                for (int j = 0; j < 4; ++j) { s0 += (v0[j][0] * v0[j][0] + v0[j][1] * v0[j][1]) + (v0[j][2] * v0[j][2] + v0[j][3] * v0[j][3]);
                                              s1 += (v1[j][0] * v1[j][0] + v1[j][1] * v1[j][1]) + (v1[j][2] * v1[j][2] + v1[j][3] * v1[j][3]); }
                s0 = wave_sum(s0, lane); s1 = wave_sum(s1, lane);
                u32x2* o0 = (u32x2*)(xb + (size_t)m * D) + lane; u32x2* o1 = (u32x2*)(xb + (size_t)(m + NGW) * D) + lane;
#pragma unroll
                for (int j = 0; j < 4; ++j) { u32x2 w; w.x = cvtpk(v0[j][0], v0[j][1]); w.y = cvtpk(v0[j][2], v0[j][3]); o0[64 * j] = w;
                                              u32x2 z; z.x = cvtpk(v1[j][0], v1[j][1]); z.y = cvtpk(v1[j][2], v1[j][3]); o1[64 * j] = z; }
                if (lane < 16) { ss[(size_t)m * 16 + lane] = lane == 0 ? s0 : 0.f; ss[(size_t)(m + NGW) * 16 + lane] = lane == 0 ? s1 : 0.f; }
            }
        } else if (ph == 13) {
            int tq_ = threadIdx.x; asm volatile("" : "+v"(tq_)); const int lane = tq_ & 63;
            const float* g = a.in[I_FN];
            f32x4 gg[4];
#pragma unroll
            for (int j = 0; j < 4; ++j) gg[j] = ((const f32x4*)g)[lane + 64 * j];
            for (int m = gw; m < M; m += 2 * NGW) {
                f32x4* xr0 = (f32x4*)(a.out + (size_t)m * D) + lane; f32x4* xr1 = (f32x4*)(a.out + (size_t)(m + NGW) * D) + lane; f32x4 v0[4], v1[4];
#pragma unroll
                for (int j = 0; j < 4; ++j) { v0[j] = xr0[64 * j]; v1[j] = xr1[64 * j]; }
                float s0 = 0.f, s1 = 0.f;
#pragma unroll
                for (int j = 0; j < 4; ++j) { s0 += (v0[j][0] * v0[j][0] + v0[j][1] * v0[j][1]) + (v0[j][2] * v0[j][2] + v0[j][3] * v0[j][3]);
                                              s1 += (v1[j][0] * v1[j][0] + v1[j][1] * v1[j][1]) + (v1[j][2] * v1[j][2] + v1[j][3] * v1[j][3]); }
                s0 = wave_sum(s0, lane); s1 = wave_sum(s1, lane);
                const float rs0 = 1.0f / sqrtf(s0 * (1.0f / D) + RMS_EPS), rs1 = 1.0f / sqrtf(s1 * (1.0f / D) + RMS_EPS);
#pragma unroll
                for (int j = 0; j < 4; ++j) { xr0[64 * j] = v0[j] * rs0 * gg[j]; xr1[64 * j] = v1[j] * rs1 * gg[j]; }
            }
        } else {
            const int l = (ph - 1) / 6, s = (ph - 1) % 6;
            unsigned char* wl = ws + WS_W + (size_t)l * WS_WL;
            if (s == 0) {
                pg8::Gemm g{xb, (const bf16_t*)(wl + WO_IN), M, NQKV, D}; pg8::StaticOrder S; S.init(M, NQKV, G, (int)blockIdx.x);
                pg8::EpiScaleBf16 E{qkv, NQKV, ss, l == 0 ? 0xC3u : 0xFu, l == 1 ? (float*)(ws + WS_KN) : nullptr};
#ifndef SKIP_G1
                pg8::gemm_phase<pg8::EpiScaleBf16, pg8::StaticOrder, true, true>(lds, g, S, E);
#endif
            } else if (s == 1) {
                at::Ptrs X{qkv, att, obr, lse, a.in[I_RPB], a.in[I_SUBLN], 0.f, (const float*)(ws + WS_KN)};
                if (l == 0) {
                    const int vc0 = ((int)blockIdx.x & 7) * (G >> 3) + ((int)blockIdx.x >> 3);
#ifndef SKIP_NAT
                    for (int u = vc0; u < 2048; u += G) { at::PolNat P; P.init(u); at::attn_unit(P, lds, X); }
#endif
#ifndef SKIP_DIL
                    { bf16x8 pq0 = {}, pq1 = {}, pq2 = {}, pq3 = {}, pk_ = {}, pv_ = {}; bool have = false;
                      for (int u = 2048 + vc0; u < 8192; u += G) { at::PolDil P, Pn; P.init(u - 2048); const bool hasn = u + G < 8192; if (hasn) Pn.init(u + G - 2048); else Pn = P;
                          at::attn_unit(P, lds, X, pq0, pq1, pq2, pq3, pk_, pv_, have, Pn, hasn); have = hasn; } }
#endif
                }
            } else if (s == 2) {
                if (l == 0) {
                    int tq_ = threadIdx.x; asm volatile("" : "+v"(tq_)); const int lane = tq_ & 63;
                    const int hd = lane >> 3;
                    for (int m0 = gw; m0 < M; m0 += 2 * NGW) {
                        float L[2][3]; bf16x8 ov[2][3];
#pragma unroll
                        for (int r = 0; r < 2; ++r) { const size_t m = (size_t)m0 + (size_t)r * NGW;
#pragma unroll
                            for (int i = 0; i < 3; ++i) { L[r][i] = lse[(size_t)i * M * 8 + m * 8 + hd]; ov[r][i] = *(const bf16x8*)(obr + (size_t)i * M * 512 + m * 512 + lane * 8); } }
#pragma unroll
                        for (int r = 0; r < 2; ++r) { const size_t m = (size_t)m0 + (size_t)r * NGW;
                            const float mx = fmaxf(L[r][0], fmaxf(L[r][1], L[r][2]));
                            float w0 = __builtin_amdgcn_exp2f(L[r][0] - mx), w1 = __builtin_amdgcn_exp2f(L[r][1] - mx), w2 = __builtin_amdgcn_exp2f(L[r][2] - mx);
                            const float inv = 1.0f / (w0 + w1 + w2); w0 *= inv; w1 *= inv; w2 *= inv;
                            float y[8];
#pragma unroll
                            for (int e = 0; e < 8; ++e) y[e] = w0 * bf2f((unsigned short)ov[r][0][e]) + w1 * bf2f((unsigned short)ov[r][1][e]) + w2 * bf2f((unsigned short)ov[r][2][e]);
                            u32x4 w; w.x = cvtpk(y[0], y[1]); w.y = cvtpk(y[2], y[3]); w.z = cvtpk(y[4], y[5]); w.w = cvtpk(y[6], y[7]);
                            *(u32x4*)(att + m * D + lane * 8) = w; }
                    }
                } else {
                    float d1 = 0.f, d2 = 0.f;
                    for (int i = 0; i < 64; ++i) { d1 += a.in[I_LQ1][i] * a.in[I_LK1][i]; d2 += a.in[I_LQ2][i] * a.in[I_LK2][i]; }
                    at::Ptrs X{qkv, att, obr, lse, a.in[I_RPB], a.in[I_SUBLN], 0.f, (const float*)(ws + WS_KN)};
                    X.lam = __int_as_float(__builtin_amdgcn_readfirstlane(__float_as_int(__expf(d1) - __expf(d2) + LAM_INIT)));
#ifndef SKIP_DIFF
                    for (int u = blockIdx.x; u < 4096; u += G) { at::PolDiff P; P.init(u); at::diff_unit(P, lds, X); }
#endif
                }
            } else if (s == 3 || s == 5) {
                const bool dn = s == 5;
                pg8::Gemm g{dn ? hb : att, (const bf16_t*)(wl + (dn ? WO_D : WO_O)), M, D, dn ? FF : D}; pg8::StaticOrder S; S.init(M, D, G, (int)blockIdx.x);
                pg8::EpiResid E{(l == 0 && !dn) ? a.in[I_X] : nullptr, (l == 1 && dn) ? a.out : nullptr, xb, (bf16_t*)(ws + WS_OBR)  , ss};
#ifndef SKIP_G2
                pg8::gemm_phase<pg8::EpiResid, pg8::StaticOrder, true, true>(lds, g, S, E);
#endif
            } else {
                pg8::Gemm g{xb, (const bf16_t*)(wl + WO_GU), M, NGU, D}; pg8::StaticOrder S; S.init(M, NGU, G, (int)blockIdx.x);
                pg8::EpiSwiGLU E{hb, ss};
#ifndef SKIP_G3
                pg8::gemm_phase<pg8::EpiSwiGLU, pg8::StaticOrder, true, true>(lds, g, S, E);
#endif
            }
        }
        if ((ph + 1 < a.ph_hi || rep < ((MK_DUP_MASK >> ph) & 1)) && ph != 8) xcd_barrier(bar);
    }
}

extern "C" void kernel_launch(void* const* d_in, const int* in_sizes, int n_in, void* d_out, int out_size, void* d_ws, size_t ws_size, hipStream_t stream) {
    static int grid = 0;
    if (grid == 0) {
        if (n_in != 22 || in_sizes[0] != M * D || out_size != M * D || ws_size < WS_END) { fprintf(stderr, "kernel_launch: unexpected shapes (n_in %d, in0 %d, out %d, ws %zu)\n", n_in, n_in > 0 ? in_sizes[0] : -1, out_size, ws_size); grid = -1; return; }
        int dev = 0, cus = 0, per_cu = 0;
        hipGetDevice(&dev); hipDeviceGetAttribute(&cus, hipDeviceAttributeMultiprocessorCount, dev);
        if (hipFuncSetAttribute((const void*)mk_fwd, hipFuncAttributeMaxDynamicSharedMemorySize, LDS_BYTES) != hipSuccess) { fprintf(stderr, "kernel_launch: hipFuncSetAttribute failed\n"); grid = -1; return; }
        hipOccupancyMaxActiveBlocksPerMultiprocessor(&per_cu, (const void*)mk_fwd, 512, LDS_BYTES);
        (void)hipGetLastError();
        if (per_cu < 1) { fprintf(stderr, "kernel_launch: occupancy query says %d blocks/CU\n", per_cu); per_cu = 1; }
        grid = cus * 1;
    }
    if (grid < 0) return;
    Args a{};
    for (int i = 0; i < 22; ++i) a.in[i] = (const float*)d_in[i];
    a.out = (float*)d_out; a.ws = (unsigned char*)d_ws;
#if MK_ONE_LAUNCH
    if (hipMemsetAsync((char*)d_ws + WS_BAR, 0, WS_BAR_BYTES, stream) != hipSuccess) { fprintf(stderr, "kernel_launch: memset of the barrier words failed\n"); return; }
    a.ph_lo = 0; a.ph_hi = NPH;
    void* args[] = {&a};
    hipError_t e = hipLaunchCooperativeKernel((const void*)mk_fwd, dim3(grid), dim3(512), args, LDS_BYTES, stream);
    if (e != hipSuccess) fprintf(stderr, "cooperative launch failed: %s (grid %d)\n", hipGetErrorString(e), grid);
#else
    for (int ph = 0; ph < NPH; ++ph) {
        a.ph_lo = ph; a.ph_hi = ph + 1;
        hipLaunchKernelGGL(mk_fwd, dim3(grid), dim3(512), LDS_BYTES, stream, a);
    }
#endif
}
```

```cpp
#include <hip/hip_runtime.h>
#include <hip/hip_cooperative_groups.h>
#include <cstdio>
#include <cstdint>
namespace cg = cooperative_groups;
#ifndef MK_DUP_MASK
#define MK_DUP_MASK 0x0
#endif
#ifndef MK_ONE_LAUNCH
#define MK_ONE_LAUNCH 1
#endif
namespace pg8 {
#define PG8_LAS __attribute__((address_space(3)))
typedef unsigned short bf16_t;
typedef short bf16x8 __attribute__((ext_vector_type(8)));
typedef float f32x4 __attribute__((ext_vector_type(4)));
typedef unsigned u32x4 __attribute__((ext_vector_type(4)));
constexpr int BM = 256, BK = 64, HALF = 128, HTB = HALF * BK * 2  , STAGE_BYTES = 8 * HTB, NXCD = 8, WGM = 8;

__host__ __device__ __forceinline__ int lds_byte(int r, int c) { const int st = (r >> 4) * 2 + (c >> 5), rr = r & 15, cc = c & 31, ob = rr * 64 + cc * 2; return st * 1024 + (ob ^ (((ob >> 9) & 1) << 5)); }
__host__ __device__ __forceinline__ void stage_rc(int b, int& R, int& C) { const int st = b / 1024, sb = b % 1024, swz = sb ^ (((sb >> 9) & 1) << 5); R = (st >> 1) * 16 + swz / 64; C = (st & 1) * 32 + (swz % 64) / 2; }
__host__ __device__ __forceinline__ int perm32(int rho) { const int n = rho >> 4, i = rho & 15; return 8 * (i >> 2) + 4 * n + (i & 3); }

struct Unit { int pm, pn; };
struct Gemm { const bf16_t* A; const bf16_t* Bt; int M, N, K; };

struct StaticOrder {
    int nM, nN, nwg, G, c;
    __host__ __device__ void init(int M, int N, int G_, int c_) { nM = M / BM; nN = N / BM; nwg = nM * nN; G = G_; c = c_; }
    __host__ __device__ bool next(int i, Unit& u) const {
        const long L = (long)i * G + c; if (L >= nwg) return false;
        int wgid = (int)L; { const int q = nwg / NXCD, r = nwg % NXCD, xcd = wgid % NXCD, off = wgid / NXCD; wgid = (xcd < r ? xcd * (q + 1) : r * (q + 1) + (xcd - r) * q) + off; }
        const int nig = WGM * nN, gid = wgid / nig, fm = gid * WGM, gsz = (nM - fm) < WGM ? (nM - fm) : WGM;
        u.pm = fm + ((wgid % nig) % gsz); u.pn = (wgid % nig) / gsz; return true;
    }
    __device__ __forceinline__ void a_ready(const Unit&) const {}
    __device__ __forceinline__ void done(const Unit&) const {}
};

__device__ __forceinline__ unsigned cvt_pk_bf16(float lo, float hi) { unsigned r; asm volatile("v_cvt_pk_bf16_f32 %0, %1, %2" : "=v"(r) : "v"(lo), "v"(hi)); return r; }
typedef float f32x2 __attribute__((ext_vector_type(2)));
template <class Epi, class Sched, bool ALIGN_EPI = false, bool SP2 = false>
__device__ __forceinline__ void gemm_phase(PG8_LAS unsigned char* lds, const Gemm g, const Sched& S, const Epi& E) {
    int tid_ = threadIdx.x; asm volatile("" : "+v"(tid_));
    const int tid = tid_, wid = __builtin_amdgcn_readfirstlane(tid >> 6), lane = tid & 63, wr = wid >> 2, wc = wid & 3, fr = lane & 15, fq = lane >> 4;
    const int K = g.K, nt = K / BK;
    unsigned voffA[2], voffB[2];
#pragma unroll
    for (int i = 0; i < 2; ++i) { int R, C; stage_rc(tid * 16 + i * 8192, R, C); const int Rb = Epi::PERM ? ((R & ~31) + perm32(R & 31)) : R;
        voffA[i] = (unsigned)(R * K + C) * 2u; voffB[i] = (unsigned)(Rb * K + C) * 2u; }
    const size_t kstep = (size_t)(BK * 2);
    const size_t hstep = (size_t)HALF * K * 2;
    const size_t tstep = 2 * hstep;
    const unsigned ldsw = (unsigned)wid * 1024u;
    const int aoff = lds_byte(wr * 64 + fr, fq * 8), boff = lds_byte(wc * 32 + fr, fq * 8);
#define PG8_SA(b, h) (((b) * 2 + (h)) * HTB)
#define PG8_SB(b, h) ((4 + (b) * 2 + (h)) * HTB)
#define PG8_STAGE(bufoff, gbase, voff) do { _Pragma("unroll") for (int _i = 0; _i < 2; ++_i) \
        __builtin_amdgcn_global_load_lds((const unsigned*)((const char*)(gbase) + (voff)[_i]), (PG8_LAS unsigned*)(lds + (bufoff) + ldsw + _i * 8192), 16, 0, 0); } while (0)
#define PG8_LDA(dst, b, h) do { _Pragma("unroll") for (int m = 0; m < 4; ++m) _Pragma("unroll") for (int k = 0; k < 2; ++k) dst[m][k] = *(const PG8_LAS bf16x8*)(lds + PG8_SA(b, h) + aoff + m * 2048 + k * 1024); } while (0)
#define PG8_LDB(dst, b, h) do { _Pragma("unroll") for (int n = 0; n < 2; ++n) _Pragma("unroll") for (int k = 0; k < 2; ++k) dst[n][k] = *(const PG8_LAS bf16x8*)(lds + PG8_SB(b, h) + boff + n * 2048 + k * 1024); } while (0)
#define PG8_MMA(ai, bj, At, Bt) do { __builtin_amdgcn_s_setprio(1); _Pragma("unroll") for (int m = 0; m < 4; ++m) _Pragma("unroll") for (int n = 0; n < 2; ++n) _Pragma("unroll") for (int k = 0; k < 2; ++k) \
        acc[ai][bj][m][n] = __builtin_amdgcn_mfma_f32_16x16x32_bf16(Bt[n][k], At[m][k], acc[ai][bj][m][n], 0, 0, 0); __builtin_amdgcn_s_setprio(0); } while (0)
#define PG8_WAIT_V(n) asm volatile("s_waitcnt vmcnt(" #n ")" ::: "memory")
#define PG8_WAIT_L(n) asm volatile("s_waitcnt lgkmcnt(" #n ")" ::: "memory")
#define PG8_BAR __builtin_amdgcn_s_barrier()
#define PG8_SCHED __builtin_amdgcn_sched_barrier(0)
    Unit cur, nxt; int ui = 0;
    if (!S.next(0, cur)) return;
    f32x4 acc[2][2][4][2];
#pragma unroll
    for (int a = 0; a < 2; ++a)
#pragma unroll
        for (int b = 0; b < 2; ++b)
#pragma unroll
            for (int m = 0; m < 4; ++m)
#pragma unroll
                for (int n = 0; n < 2; ++n) acc[a][b][m][n] = (f32x4){0.f, 0.f, 0.f, 0.f};
    bf16x8 At[4][2], B0[2][2], B1[2][2];
    const char* cA = (const char*)g.A + (size_t)cur.pm * tstep; const char* cB = (const char*)g.Bt + (size_t)cur.pn * tstep;
    S.a_ready(cur);
    if constexpr (SP2) {
        PG8_STAGE(PG8_SB(0, 0), cB, voffB); PG8_STAGE(PG8_SB(0, 1), cB + hstep, voffB); PG8_STAGE(PG8_SA(0, 0), cA, voffA); PG8_STAGE(PG8_SA(0, 1), cA + hstep, voffA);
        if (wr == 1) PG8_BAR;
        PG8_WAIT_V(2); PG8_BAR;
        PG8_STAGE(PG8_SB(1, 0), cB + kstep, voffB); PG8_STAGE(PG8_SA(1, 0), cA + kstep, voffA); PG8_STAGE(PG8_SB(1, 1), cB + hstep + kstep, voffB);
        PG8_WAIT_V(6); PG8_BAR;
    } else {
        PG8_STAGE(PG8_SB(0, 0), cB, voffB); PG8_STAGE(PG8_SA(0, 0), cA, voffA); PG8_STAGE(PG8_SB(0, 1), cB + hstep, voffB); PG8_STAGE(PG8_SA(0, 1), cA + hstep, voffA);
        if (wr == 1) PG8_BAR;
        PG8_WAIT_V(4); PG8_BAR;
        PG8_STAGE(PG8_SB(1, 0), cB + kstep, voffB); PG8_STAGE(PG8_SA(1, 0), cA + kstep, voffA); PG8_STAGE(PG8_SB(1, 1), cB + hstep + kstep, voffB);
        PG8_WAIT_V(6); PG8_BAR;
    }
    for (;;) {
        const bool has_next = S.next(ui + 1, nxt);
        const char* nA = has_next ? (const char*)g.A + (size_t)nxt.pm * tstep : cA; const char* nB = has_next ? (const char*)g.Bt + (size_t)nxt.pn * tstep : cB;
        for (int t = 0; t < nt; t += 2) {
            const bool last = (t == nt - 2);
            const char* a1 = cA + (size_t)(t + 1) * kstep;
            const char* a2 = last ? nA : cA + (size_t)(t + 2) * kstep; const char* b2 = last ? nB : cB + (size_t)(t + 2) * kstep;
            const char* a3 = a2 + kstep; const char* b3 = b2 + kstep;
            if (last && has_next) S.a_ready(nxt);
            if constexpr (SP2) {
            PG8_LDB(B0, 0, 0); PG8_LDB(B1, 0, 1); PG8_SCHED; PG8_LDA(At, 0, 0); PG8_STAGE(PG8_SA(1, 1), a1 + hstep, voffA);
            PG8_WAIT_V(8); PG8_WAIT_L(0); PG8_BAR; PG8_MMA(0, 0, At, B0); PG8_MMA(0, 1, At, B1); PG8_BAR; PG8_SCHED;
            PG8_LDA(At, 0, 1); PG8_STAGE(PG8_SB(0, 0), b2, voffB); PG8_STAGE(PG8_SB(0, 1), b2 + hstep, voffB); PG8_STAGE(PG8_SA(0, 0), a2, voffA);
            PG8_WAIT_V(8); PG8_WAIT_L(0); PG8_BAR; PG8_MMA(1, 0, At, B0); PG8_MMA(1, 1, At, B1); PG8_BAR; PG8_SCHED;
            PG8_LDB(B0, 1, 0); PG8_LDB(B1, 1, 1); PG8_SCHED; PG8_LDA(At, 1, 0); PG8_STAGE(PG8_SA(0, 1), a2 + hstep, voffA);
            PG8_WAIT_V(8); PG8_WAIT_L(0); PG8_BAR; PG8_MMA(0, 0, At, B0); PG8_MMA(0, 1, At, B1); PG8_BAR; PG8_SCHED;
            PG8_LDA(At, 1, 1); PG8_STAGE(PG8_SB(1, 0), b3, voffB); PG8_STAGE(PG8_SB(1, 1), b3 + hstep, voffB); PG8_STAGE(PG8_SA(1, 0), a3, voffA);
            PG8_WAIT_V(8); PG8_WAIT_L(0); PG8_BAR; PG8_MMA(1, 0, At, B0); PG8_MMA(1, 1, At, B1); PG8_BAR; PG8_SCHED;
            } else {
            PG8_LDB(B0, 0, 0); PG8_SCHED; PG8_LDA(At, 0, 0); PG8_STAGE(PG8_SA(1, 1), a1 + hstep, voffA);
            PG8_WAIT_L(8); PG8_BAR; PG8_WAIT_L(0); PG8_MMA(0, 0, At, B0); PG8_BAR; PG8_SCHED;
            PG8_LDB(B1, 0, 1); PG8_STAGE(PG8_SB(0, 0), b2, voffB);
            PG8_BAR; PG8_WAIT_L(0); PG8_MMA(0, 1, At, B1); PG8_BAR;
            PG8_LDA(At, 0, 1); PG8_STAGE(PG8_SA(0, 0), a2, voffA);
            PG8_BAR; PG8_WAIT_L(0); PG8_MMA(1, 0, At, B0); PG8_BAR; PG8_SCHED;
            PG8_STAGE(PG8_SB(0, 1), b2 + hstep, voffB);
            PG8_WAIT_V(6); PG8_BAR; PG8_MMA(1, 1, At, B1); PG8_BAR;
            PG8_LDB(B0, 1, 0); PG8_SCHED; PG8_LDA(At, 1, 0); PG8_STAGE(PG8_SA(0, 1), a2 + hstep, voffA);
            PG8_WAIT_L(8); PG8_BAR; PG8_WAIT_L(0); PG8_MMA(0, 0, At, B0); PG8_BAR; PG8_SCHED;
            PG8_LDB(B1, 1, 1); PG8_STAGE(PG8_SB(1, 0), b3, voffB);
            PG8_BAR; PG8_WAIT_L(0); PG8_MMA(0, 1, At, B1); PG8_BAR;
            PG8_LDA(At, 1, 1); PG8_STAGE(PG8_SA(1, 0), a3, voffA);
            PG8_BAR; PG8_WAIT_L(0); PG8_MMA(1, 0, At, B0); PG8_BAR; PG8_SCHED;
            PG8_STAGE(PG8_SB(1, 1), b3 + hstep, voffB);
            PG8_WAIT_V(6); PG8_BAR; PG8_MMA(1, 1, At, B1); PG8_BAR;
            }
        }
        if constexpr (ALIGN_EPI) { if (wr == 0) PG8_BAR; }
        if constexpr (!Epi::AFTER_DRAIN) { E(acc, cur, wr, wc, fr, fq); S.done(cur); }
        if (!has_next) break;
#pragma unroll
        for (int a = 0; a < 2; ++a)
#pragma unroll
            for (int b = 0; b < 2; ++b)
#pragma unroll
                for (int m = 0; m < 4; ++m)
#pragma unroll
                    for (int n = 0; n < 2; ++n) acc[a][b][m][n] = (f32x4){0.f, 0.f, 0.f, 0.f};
        cur = nxt; cA = nA; cB = nB; ++ui;
        if constexpr (ALIGN_EPI) { if (wr == 1) PG8_BAR; }
    }
    PG8_WAIT_V(0);
    if constexpr (!ALIGN_EPI) { if (wr == 0) PG8_BAR; }
    PG8_BAR;
    if constexpr (Epi::AFTER_DRAIN) { E.fused(acc, cur, wr, wc, fr, fq, lds, wid, lane); S.done(cur); }
#undef PG8_SA
#undef PG8_SB
#undef PG8_STAGE
#undef PG8_LDA
#undef PG8_LDB
#undef PG8_MMA
#undef PG8_WAIT_V
#undef PG8_WAIT_L
#undef PG8_BAR
#undef PG8_SCHED
}
}

constexpr int BATCH = 16, T = 4096, D = 1024, M = BATCH * T, NQKV = 3072, FF = 2816, NGU = 2 * FF;
constexpr float RMS_EPS = 1e-6f, SUBLN_EPS = 1e-5f;
constexpr float LOG2E = 1.4426950408889634f;
constexpr float QSCALE = 0.125f * LOG2E;
constexpr float LAM_INIT = 0.35550906f;

#define LAS __attribute__((address_space(3)))
typedef unsigned short bf16_t;
typedef short bf16x8 __attribute__((ext_vector_type(8)));
typedef short s16x4 __attribute__((ext_vector_type(4)));
typedef float f32x4 __attribute__((ext_vector_type(4)));
typedef float f32x16 __attribute__((ext_vector_type(16)));
typedef unsigned u32x4 __attribute__((ext_vector_type(4)));
typedef unsigned u32x2 __attribute__((ext_vector_type(2)));

__device__ __forceinline__ unsigned cvtpk(float lo, float hi) { unsigned r; asm volatile("v_cvt_pk_bf16_f32 %0, %1, %2" : "=v"(r) : "v"(lo), "v"(hi)); return r; }
__device__ __forceinline__ float sx(float v, int mask, int lane) { return __int_as_float(__builtin_amdgcn_ds_bpermute((lane ^ mask) << 2, __float_as_int(v))); }
__device__ __forceinline__ float bf2f(unsigned short u) { return __uint_as_float((unsigned)u << 16); }

namespace pg8 {
__device__ __forceinline__ float row_rs(const float* ss, int row, int fq, int fr) {
#ifdef TRIV_EPI
    return 1.0f;
#endif
    const f32x4 a = *(const f32x4*)(ss + (size_t)row * 16 + 4 * fq);
    float s = (a[0] + a[1]) + (a[2] + a[3]);
    const int ln = fq * 16 + fr; s += sx(s, 16, ln); s += sx(s, 32, ln);
    return 1.0f / sqrtf(s * (1.0f / D) + RMS_EPS);
}
struct EpiScaleBf16 {
    static constexpr bool PERM = true, AFTER_DRAIN = false;
    bf16_t* O; int ldc; const float* ss; unsigned qmask;
    float* kn2;
    __device__ __forceinline__ void operator()(const f32x4 (&acc)[2][2][4][2], const Unit& u, int wr, int wc, int fr, int fq) const {
        const int row0 = u.pm * BM + wr * 64 + fr, col0 = u.pn * BM + wc * 32 + 8 * fq;
        const float qs = ((qmask >> u.pn) & 1u) ? QSCALE : 1.0f;
        const bool kt = kn2 != nullptr && u.pn >= 4 && u.pn < 8;
        const int ln = fq * 16 + fr;
        float km[2][2] = {{0.f, 0.f}, {0.f, 0.f}};
#pragma unroll
        for (int ai = 0; ai < 2; ++ai)
#pragma unroll
            for (int m = 0; m < 4; ++m) { const int row = row0 + ai * HALF + m * 16; const float rs = row_rs(ss, row, fq, fr) * qs;
                bf16_t* rowp = O + (size_t)row * ldc + col0;
#pragma unroll
                for (int bj = 0; bj < 2; ++bj) { const f32x4 v0 = acc[ai][bj][m][0] * rs, v1 = acc[ai][bj][m][1] * rs;
                    u32x4 w; w.x = cvt_pk_bf16(v0[0], v0[1]); w.y = cvt_pk_bf16(v0[2], v0[3]); w.z = cvt_pk_bf16(v1[0], v1[1]); w.w = cvt_pk_bf16(v1[2], v1[3]);
                    *(u32x4*)(rowp + bj * HALF) = w;
                    if (kt) { float s8 = 0.f;
#pragma unroll
                        for (int e = 0; e < 4; ++e) { const unsigned ww = e == 0 ? w.x : (e == 1 ? w.y : (e == 2 ? w.z : w.w)); const float lo_ = __uint_as_float(ww << 16), hi_ = __uint_as_float(ww & 0xffff0000u);
                            s8 = fmaf(lo_, lo_, s8); s8 = fmaf(hi_, hi_, s8); }
                        s8 += sx(s8, 16, ln); s8 += sx(s8, 32, ln);
                        km[ai][bj] = fmaxf(km[ai][bj], s8); } }
                if (m & 1) asm volatile("" ::: "memory"); }
        if (kt) {
#pragma unroll
            for (int ai = 0; ai < 2; ++ai)
#pragma unroll
                for (int bj = 0; bj < 2; ++bj) { float v = km[ai][bj];
                    v = fmaxf(v, sx(v, 1, ln)); v = fmaxf(v, sx(v, 2, ln)); v = fmaxf(v, sx(v, 4, ln)); v = fmaxf(v, sx(v, 8, ln));
                    const int rt = u.pm * BM + ai * HALF + wr * 64, bb = rt >> 12, tile = (rt & 4095) >> 6, head = (u.pn - 4) * 2 + bj;
                    if (ln == 0) kn2[((((bb * 8 + head) * 2 + (wc >> 1)) * 64 + tile) << 1) + (wc & 1)] = v; }
        }
    }
};
struct EpiSwiGLU {
    static constexpr bool PERM = true, AFTER_DRAIN = false;
    bf16_t* H; const float* ss;
    __device__ __forceinline__ void operator()(const f32x4 (&acc)[2][2][4][2], const Unit& u, int wr, int wc, int fr, int fq) const {
        const int row0 = u.pm * BM + wr * 64 + fr, col0 = u.pn * HALF + wc * 32 + 8 * fq;
#pragma unroll
        for (int ai = 0; ai < 2; ++ai)
#pragma unroll
            for (int m = 0; m < 4; ++m) { const int row = row0 + ai * HALF + m * 16; const float rs = row_rs(ss, row, fq, fr);
                float o[8];
#pragma unroll
                for (int n = 0; n < 2; ++n)
#pragma unroll
                    for (int e = 0; e < 4; ++e) { const float g = acc[ai][0][m][n][e] * rs, up = acc[ai][1][m][n][e] * rs;
                        o[n * 4 + e] = g * __builtin_amdgcn_rcpf(1.0f + __builtin_amdgcn_exp2f(-g * LOG2E)) * up; }
                u32x4 w; w.x = cvt_pk_bf16(o[0], o[1]); w.y = cvt_pk_bf16(o[2], o[3]); w.z = cvt_pk_bf16(o[4], o[5]); w.w = cvt_pk_bf16(o[6], o[7]);
                *(u32x4*)(H + (size_t)row * FF + col0) = w;
                if (m & 1) asm volatile("" ::: "memory"); }
    }
};
struct EpiResid {
    static constexpr bool PERM = true, AFTER_DRAIN = false;
    const float* bf; float* of; bf16_t* hi; bf16_t* lo; float* ss;
    __device__ __forceinline__ void operator()(const f32x4 (&acc)[2][2][4][2], const Unit& u, int wr, int wc, int fr, int fq) const {
        const int row0 = u.pm * BM + wr * 64 + fr, col0 = u.pn * BM + wc * 32 + 8 * fq;
#pragma unroll
        for (int ai = 0; ai < 2; ++ai)
#pragma unroll
            for (int m = 0; m < 4; ++m) { const int row = row0 + ai * HALF + m * 16; const size_t off = (size_t)row * D + col0; float sq = 0.f;
#pragma unroll
                for (int bj = 0; bj < 2; ++bj) { const size_t o2 = off + bj * HALF; f32x4 v0, v1;
                    if (bf) { v0 = *(const f32x4*)(bf + o2); v1 = *(const f32x4*)(bf + o2 + 4); }
                    else { const u32x4 h = *(const u32x4*)(hi + o2), l = *(const u32x4*)(lo + o2);
                        v0[0] = __uint_as_float(h.x << 16) + __uint_as_float(l.x << 16); v0[1] = __uint_as_float(h.x & 0xffff0000u) + __uint_as_float(l.x & 0xffff0000u);
                        v0[2] = __uint_as_float(h.y << 16) + __uint_as_float(l.y << 16); v0[3] = __uint_as_float(h.y & 0xffff0000u) + __uint_as_float(l.y & 0xffff0000u);
                        v1[0] = __uint_as_float(h.z << 16) + __uint_as_float(l.z << 16); v1[1] = __uint_as_float(h.z & 0xffff0000u) + __uint_as_float(l.z & 0xffff0000u);
                        v1[2] = __uint_as_float(h.w << 16) + __uint_as_float(l.w << 16); v1[3] = __uint_as_float(h.w & 0xffff0000u) + __uint_as_float(l.w & 0xffff0000u); }
                    v0 = v0 + acc[ai][bj][m][0]; v1 = v1 + acc[ai][bj][m][1];
                    if (of) { *(f32x4*)(of + o2) = v0; *(f32x4*)(of + o2 + 4) = v1; }
                    else { u32x4 w; w.x = cvt_pk_bf16(v0[0], v0[1]); w.y = cvt_pk_bf16(v0[2], v0[3]); w.z = cvt_pk_bf16(v1[0], v1[1]); w.w = cvt_pk_bf16(v1[2], v1[3]);
                        u32x4 r; r.x = cvt_pk_bf16(v0[0] - __uint_as_float(w.x << 16), v0[1] - __uint_as_float(w.x & 0xffff0000u)); r.y = cvt_pk_bf16(v0[2] - __uint_as_float(w.y << 16), v0[3] - __uint_as_float(w.y & 0xffff0000u));
                        r.z = cvt_pk_bf16(v1[0] - __uint_as_float(w.z << 16), v1[1] - __uint_as_float(w.z & 0xffff0000u)); r.w = cvt_pk_bf16(v1[2] - __uint_as_float(w.w << 16), v1[3] - __uint_as_float(w.w & 0xffff0000u));
                        *(u32x4*)(hi + o2) = w; *(u32x4*)(lo + o2) = r; }
                    sq += ((v0[0] * v0[0] + v0[1] * v0[1]) + (v0[2] * v0[2] + v0[3] * v0[3])) + ((v1[0] * v1[0] + v1[1] * v1[1]) + (v1[2] * v1[2] + v1[3] * v1[3])); }
                { const int ln = fq * 16 + fr; sq += sx(sq, 16, ln); sq += sx(sq, 32, ln); }
                if (fq == 0) ss[(size_t)row * 16 + u.pn * 4 + wc] = sq;
                asm volatile("" ::: "memory"); }
    }
};
}

namespace at {
constexpr float THR = 8.0f;
__device__ __forceinline__ int crow(int r, int hi) { return (r & 3) + 8 * (r >> 2) + 4 * hi; }
template <int NB> __device__ __forceinline__ int v_st(int k, int c) { const int kk = (k & ~0xC) | ((k & 4) << 1) | ((k & 8) >> 1); return ((kk >> 3) * NB + (c >> 5)) * 512 + ((kk & 7) * 32 + (c & 31)) * 2; }
__device__ __forceinline__ int v_rd_base(int lane) { return ((lane & 3) << 3) | (((lane >> 2) & 3) << 6) | (((lane >> 4) & 1) << 5) | (((lane >> 5) & 1) << 8); }
template <int NB> constexpr int v_rd_off(int d0, int ks, int half) { return d0 * 512 + ks * (NB * 1024) + half * (NB * 512); }
template <int OFF> __device__ __forceinline__ s16x4 tr_read(int vb) { s16x4 r; asm volatile("ds_read_b64_tr_b16 %0, %1 offset:%2" : "=&v"(r) : "v"(vb), "i"(OFF) : "memory"); return r; }
template <int NB, int D0> __device__ __forceinline__ void pv_one(f32x16& od, int vb, bf16x8 pa0, bf16x8 pa1, bf16x8 pa2, bf16x8 pa3) {
    const s16x4 l0 = tr_read<v_rd_off<NB>(D0, 0, 0)>(vb), h0 = tr_read<v_rd_off<NB>(D0, 0, 1)>(vb), l1 = tr_read<v_rd_off<NB>(D0, 1, 0)>(vb), h1 = tr_read<v_rd_off<NB>(D0, 1, 1)>(vb);
    const s16x4 l2 = tr_read<v_rd_off<NB>(D0, 2, 0)>(vb), h2 = tr_read<v_rd_off<NB>(D0, 2, 1)>(vb), l3 = tr_read<v_rd_off<NB>(D0, 3, 0)>(vb), h3 = tr_read<v_rd_off<NB>(D0, 3, 1)>(vb);
    asm volatile("s_waitcnt lgkmcnt(0)" ::: "memory"); __builtin_amdgcn_sched_barrier(0);
#define AT_PK(L, H) (bf16x8){L[0], L[1], L[2], L[3], H[0], H[1], H[2], H[3]}
    od = __builtin_amdgcn_mfma_f32_32x32x16_bf16(pa0, AT_PK(l0, h0), od, 0, 0, 0);
    od = __builtin_amdgcn_mfma_f32_32x32x16_bf16(pa1, AT_PK(l1, h1), od, 0, 0, 0);
    od = __builtin_amdgcn_mfma_f32_32x32x16_bf16(pa2, AT_PK(l2, h2), od, 0, 0, 0);
    od = __builtin_amdgcn_mfma_f32_32x32x16_bf16(pa3, AT_PK(l3, h3), od, 0, 0, 0);
#undef AT_PK
}
__device__ __forceinline__ float slope_of(int h) { return __builtin_amdgcn_exp2f(-(float)(h + 1)); }

constexpr int L_SCR = 65536, L_TBL = 67584, L_X = 69632;

struct Ptrs { const bf16_t* qkv; bf16_t* att; bf16_t* obr; float* lse; const float* rpb; const float* subln; float lam; const float* kn; };

struct PolDil {
    static constexpr int W = 64, KIND = 0;
    int b, h, br, dil, res, qs0, tlo, thi; float nsl;
    __device__ __forceinline__ void init(int u) {
        br = u >> 11; const int v = u & 2047, sub = v & 15, bh = v >> 4; b = bh >> 3; h = bh & 7;
        dil = br == 0 ? 1 : (br == 1 ? 4 : 16); const int L = T / dil, nqb = L / 256;
        res = sub / nqb; qs0 = (sub % nqb) * 256;
        tlo = qs0 > 0 ? 0 : 1; thi = (qs0 + 256 < L) ? 6 : 5;
        nsl = -slope_of(h) * (float)dil * LOG2E;
    }
    __device__ __forceinline__ long qtok(int wid, int i) const { return (long)b * T + res + dil * (qs0 + 32 * wid + i); }
    __device__ __forceinline__ int qcol(int) const { return h * 64; }
    __device__ __forceinline__ int kcol0() const { return 512 + h * 64; }
    __device__ __forceinline__ int vcol0() const { return 1024 + h * 64; }
    __device__ __forceinline__ int kfrag(int) const { return 0; }
    __device__ __forceinline__ long ktok(int t, int row) const { return (long)b * T + res + dil * (qs0 - 64 + 64 * t + row); }
    __device__ __forceinline__ bool need(int t, int wid) const { return (64 * t - 64 <= 32 * wid + 95) && (64 * t - 1 >= 32 * wid - 64); }
    __device__ __forceinline__ void cinit(f32x16& p0, f32x16& p1, int t, int wid, int r32, int hi, const LAS float*, float m) const {
        const float base = (float)(32 * wid + r32 + 64 - 64 * t - 4 * hi);
#pragma unroll
        for (int r = 0; r < 16; ++r) { const float c = (float)((r & 3) + 8 * (r >> 2));
            const float a0 = fabsf(base - c), a1 = fabsf(base - (c + 32.f));
            p0[r] = a0 <= 64.f ? nsl * a0 - m : -INFINITY; p1[r] = a1 <= 64.f ? nsl * a1 - m : -INFINITY; }
    }
};
struct PolNat {
    static constexpr int W = 64, KIND = 1;
    int b, h, qb, r0, kr0, tlo, thi;
    __device__ __forceinline__ static int clip(int v, int lo, int hi_) { return v < lo ? lo : (v > hi_ ? hi_ : v); }
    __device__ __forceinline__ void init(int u) {
        qb = u & 15; const int bh = u >> 4; b = bh >> 3; h = bh & 7; r0 = 4 * qb;
        kr0 = clip(r0 - 4, 0, 56); tlo = 0; thi = clip(r0 - 1, 0, 56) + 8 - kr0;
    }
    __device__ __forceinline__ long qtok(int wid, int i) const { return (long)b * T + 256 * qb + 32 * wid + i; }
    __device__ __forceinline__ int qcol(int) const { return 1536 + h * 64; }
    __device__ __forceinline__ int kcol0() const { return 2048 + h * 64; }
    __device__ __forceinline__ int vcol0() const { return 2560 + h * 64; }
    __device__ __forceinline__ int kfrag(int) const { return 0; }
    __device__ __forceinline__ long ktok(int t, int row) const { return (long)b * T + 64 * (kr0 + t) + row; }
    __device__ __forceinline__ bool need(int t, int wid) const { const int r = r0 + (wid >> 1), rs = clip(r - 4, 0, 56), kr = kr0 + t; return kr >= rs && kr < rs + 8; }
    __device__ __forceinline__ void cinit(f32x16& p0, f32x16& p1, int t, int wid, int r32, int hi, const LAS float* tbl, float m) const {
        const int r = r0 + (wid >> 1), kr = kr0 + t, c = 32 * (wid & 1) + r32, wc = clip(c - 8, 0, 48);
        const LAS float* trow = tbl + (kr - r + 7) * 32;
#pragma unroll
        for (int q = 0; q < 16; ++q) { const int k0 = (q & 3) + 8 * (q >> 2) + 4 * hi, k1 = k0 + 32;
            const float v0 = trow[clip(k0 - c + 15, 0, 30)], v1 = trow[clip(k1 - c + 15, 0, 30)];
            p0[q] = ((unsigned)(k0 - wc) < 16u) ? v0 - m : -INFINITY; p1[q] = ((unsigned)(k1 - wc) < 16u) ? v1 - m : -INFINITY; }
    }
};
struct PolDiff {
    static constexpr int W = 128, KIND = 2;
    int b, h, qb, tlo, thi; float nsl;
    __device__ __forceinline__ void init(int u) { const int k = u >> 8, c0 = u & 255, c = (c0 & 7) * 32 + (c0 >> 3)  , r = (k >> 3) * 256 + c; h = k & 7; b = r >> 5; qb = r & 31; tlo = 0; thi = T / 64; nsl = -slope_of(h) * LOG2E; }
    __device__ __forceinline__ long qtok(int wid, int i) const { return (long)b * T + 128 * qb + 32 * (wid & 3) + i; }
    __device__ __forceinline__ int qcol(int wid) const { return h * 128 + 64 * (wid >> 2); }
    __device__ __forceinline__ int kcol0() const { return 1024 + h * 128; }
    __device__ __forceinline__ int vcol0() const { return 2048 + h * 128; }
    __device__ __forceinline__ int kfrag(int wid) const { return 64 * (wid >> 2); }
    __device__ __forceinline__ long ktok(int t, int row) const { return (long)b * T + 64 * t + row; }
    __device__ __forceinline__ bool need(int, int) const { return true; }
    template <int BLK> __device__ __forceinline__ void cinit_off(f32x16& p, int t, int wid, int r32, int hi) const {
        const float base = (float)(128 * qb + 32 * (wid & 3) + r32 - 64 * t - 4 * hi - 32 * BLK);
        const float sn = t < 2 * qb ? nsl : -nsl, A = sn * base, cf = -sn;
#pragma unroll
        for (int r = 0; r < 16; ++r) p[r] = fmaf(cf, (float)((r & 3) + 8 * (r >> 2)), A);
    }
    template <int BLK> __device__ __forceinline__ void cinit_abs(f32x16& p, int t, int wid, int r32, int hi) const {
        const float base = (float)(128 * qb + 32 * (wid & 3) + r32 - 64 * t - 4 * hi - 32 * BLK);
#pragma unroll
        for (int r = 0; r < 16; ++r) p[r] = nsl * fabsf(base - (float)((r & 3) + 8 * (r >> 2)));
    }
    __device__ __forceinline__ void cinit(f32x16& p0, f32x16& p1, int t, int wid, int r32, int hi, const LAS float*, float m) const {
        const int i0 = 128 * qb + 32 * (wid & 3);
        const float base = (float)(i0 + r32 - 64 * t - 4 * hi);
        if (64 * t + 63 < i0) {
            const float A = nsl * base - m, n2 = -nsl;
#pragma unroll
            for (int r = 0; r < 16; ++r) { const float c = (float)((r & 3) + 8 * (r >> 2)); p0[r] = fmaf(n2, c, A); p1[r] = fmaf(n2, c + 32.f, A); }
        } else if (64 * t > i0 + 31) {
            const float A = -nsl * base - m;
#pragma unroll
            for (int r = 0; r < 16; ++r) { const float c = (float)((r & 3) + 8 * (r >> 2)); p0[r] = fmaf(nsl, c, A); p1[r] = fmaf(nsl, c + 32.f, A); }
        } else {
#pragma unroll
            for (int r = 0; r < 16; ++r) { const float c = (float)((r & 3) + 8 * (r >> 2));
                p0[r] = nsl * fabsf(base - c) - m; p1[r] = nsl * fabsf(base - (c + 32.f)) - m; }
        }
    }
};

template <class Pol> __device__ __forceinline__ void attn_unit(const Pol& P, LAS unsigned char* lds, const Ptrs& X, bf16x8& pq0, bf16x8& pq1, bf16x8& pq2, bf16x8& pq3, bf16x8& pk_, bf16x8& pv_, bool have, const Pol& Pn, bool hasn);
template <class Pol>
__device__ __forceinline__ void attn_unit(const Pol& P, LAS unsigned char* lds, const Ptrs& X, bf16x8& pq0, bf16x8& pq1, bf16x8& pq2, bf16x8& pq3, bf16x8& pk_, bf16x8& pv_, bool have, const Pol& Pn, bool hasn) {
    constexpr int W = Pol::W, NB = W / 32, CH = W / 64, KBYTES = 64 * W * 2, VBYTES = KBYTES, CPR = W / 8;
    int tid_ = threadIdx.x; asm volatile("" : "+v"(tid_));
    const int tid = tid_, wid = __builtin_amdgcn_readfirstlane(tid >> 6), lane = tid & 63, r32 = lane & 31, hi = lane >> 5;
    LAS unsigned char* K_lds = lds; LAS unsigned char* V_lds = lds + 2 * KBYTES;
    LAS float* li_l = (LAS float*)(lds + L_SCR) + wid * 64; LAS float* al_l = li_l + 32;
    LAS float* tbl = (LAS float*)(lds + L_TBL);
    const bf16_t* qkv = X.qkv;
    if constexpr (Pol::KIND == 1) { if (tid < 480) { const int row = tid >> 5, col = tid & 31; tbl[tid] = col < 31 ? X.rpb[(P.h * 15 + row) * 31 + col] * LOG2E : 0.f; } }
    bf16x8 qr[4];
    const bool pre_ok = Pol::KIND == 0 && have;
    if (pre_ok) {
        qr[0] = pq0; qr[1] = pq1; qr[2] = pq2; qr[3] = pq3;
    } else { const bf16_t* qp = qkv + P.qtok(wid, r32) * NQKV + P.qcol(wid) + hi * 8;
#pragma unroll
      for (int d0 = 0; d0 < 4; ++d0) qr[d0] = *(const bf16x8*)(qp + d0 * 16); }
    const int kfb = P.kfrag(wid) * 2;
    bf16x8 ks[CH], vs[CH];
#define AT_SLOAD(t) do { _Pragma("unroll") for (int i_ = 0; i_ < CH; ++i_) { const int id_ = tid + 512 * i_, row_ = id_ / CPR, col_ = (id_ % CPR) * 8; \
        const bf16_t* g_ = qkv + P.ktok((t), row_) * NQKV + col_; ks[i_] = *(const bf16x8*)(g_ + P.kcol0()); vs[i_] = *(const bf16x8*)(g_ + P.vcol0()); } } while (0)
#define AT_SWRITE(b) do { _Pragma("unroll") for (int i_ = 0; i_ < CH; ++i_) { const int id_ = tid + 512 * i_, row_ = id_ / CPR, col_ = (id_ % CPR) * 8; \
        *(LAS bf16x8*)(K_lds + (b) * KBYTES + row_ * (W * 2) + ((col_ * 2) ^ ((row_ & 7) << 4))) = ks[i_]; \
        *(LAS bf16x8*)(V_lds + (b) * VBYTES + v_st<NB>(row_, col_)) = vs[i_]; } } while (0)
    float m_reg = 0.f, l_reg = 0.f; f32x16 o[NB];
#pragma unroll
    for (int d = 0; d < NB; ++d) o[d] = f32x16{};
    const int vb0 = (int)(unsigned)(size_t)V_lds + v_rd_base(lane);
    const int tlo = P.tlo, thi = P.thi;
    if (pre_ok) { ks[0] = pk_; vs[0] = pv_; } else AT_SLOAD(tlo);
    AT_SWRITE(tlo & 1); __syncthreads();
    for (int t = tlo; t < thi; ++t) {
        const int buf = t & 1;
        if constexpr (Pol::KIND != 2) { if (t + 1 < thi) AT_SLOAD(t + 1); }
        if constexpr (Pol::KIND == 0) { if (t + 1 == thi && hasn) {
            const bf16_t* qp = qkv + Pn.qtok(wid, r32) * NQKV + Pn.qcol(wid) + hi * 8;
            pq0 = *(const bf16x8*)(qp); pq1 = *(const bf16x8*)(qp + 16); pq2 = *(const bf16x8*)(qp + 32); pq3 = *(const bf16x8*)(qp + 48);
            const int row_ = tid / CPR, col_ = (tid % CPR) * 8; const bf16_t* g_ = qkv + Pn.ktok(Pn.tlo, row_) * NQKV + col_;
            pk_ = *(const bf16x8*)(g_ + Pn.kcol0()); pv_ = *(const bf16x8*)(g_ + Pn.vcol0()); } }
        if (P.need(t, wid)) {
            f32x16 p0, p1;
            P.cinit(p0, p1, t, wid, r32, hi, tbl, m_reg);
            const LAS unsigned char* Kb = K_lds + buf * KBYTES;
#pragma unroll
            for (int d0 = 0; d0 < 4; ++d0) { const int cb = kfb + (d0 * 16 + hi * 8) * 2, sw = cb ^ ((r32 & 7) << 4);
                const bf16x8 b0 = *(const LAS bf16x8*)(Kb + r32 * (W * 2) + sw);
                const bf16x8 b1 = *(const LAS bf16x8*)(Kb + (32 + r32) * (W * 2) + sw);
                p0 = __builtin_amdgcn_mfma_f32_32x32x16_bf16(b0, qr[d0], p0, 0, 0, 0);
                p1 = __builtin_amdgcn_mfma_f32_32x32x16_bf16(b1, qr[d0], p1, 0, 0, 0); }
            float pmax = fmaxf(p0[0], p1[0]);
#pragma unroll
            for (int r = 1; r < 16; ++r) pmax = fmaxf(fmaxf(pmax, p0[r]), p1[r]);
            { auto rr = __builtin_amdgcn_permlane32_swap(__float_as_uint(pmax), __float_as_uint(pmax), false, false);
              pmax = fmaxf(__uint_as_float(rr[0]), __uint_as_float(rr[1])); }
            float alpha = 1.f;
            if (__builtin_expect(!__all(pmax <= THR), 0)) {
                const float dm = fmaxf(pmax, 0.f); alpha = __builtin_amdgcn_exp2f(-dm); m_reg += dm;
#pragma unroll
                for (int r = 0; r < 16; ++r) { p0[r] -= dm; p1[r] -= dm; }
            }
            float ps = 0.f;
#pragma unroll
            for (int r = 0; r < 16; ++r) { p0[r] = __builtin_amdgcn_exp2f(p0[r]); p1[r] = __builtin_amdgcn_exp2f(p1[r]); ps += p0[r] + p1[r]; }
            { auto rr = __builtin_amdgcn_permlane32_swap(__float_as_uint(ps), __float_as_uint(ps), false, false);
              ps = __uint_as_float(rr[0]) + __uint_as_float(rr[1]); }
            l_reg = l_reg * alpha + ps;
            if (__any(alpha < 1.f)) { if (hi == 0) al_l[r32] = alpha; asm volatile("s_waitcnt lgkmcnt(0)" ::: "memory");
#pragma unroll
                for (int r = 0; r < 16; ++r) { const float a = al_l[crow(r, hi)];
#pragma unroll
                    for (int d = 0; d < NB; ++d) o[d][r] *= a; }
                asm volatile("s_waitcnt lgkmcnt(0)" ::: "memory"); }
            bf16x8 pa0, pa1, pa2, pa3;
#define AT_PK4(PP, BASE, OUT) do { unsigned a0 = cvtpk(PP[BASE + 0], PP[BASE + 1]), a1 = cvtpk(PP[BASE + 2], PP[BASE + 3]); \
    unsigned b0_ = cvtpk(PP[BASE + 4], PP[BASE + 5]), b1_ = cvtpk(PP[BASE + 6], PP[BASE + 7]); \
    auto r0_ = __builtin_amdgcn_permlane32_swap(a0, b0_, false, false); auto r1_ = __builtin_amdgcn_permlane32_swap(a1, b1_, false, false); \
    u32x4 w_ = {r0_[0], r1_[0], r0_[1], r1_[1]}; OUT = *reinterpret_cast<bf16x8*>(&w_); } while (0)
            AT_PK4(p0, 0, pa0); AT_PK4(p0, 8, pa1); AT_PK4(p1, 0, pa2); AT_PK4(p1, 8, pa3);
#undef AT_PK4
            const int vb = vb0 + buf * VBYTES;
            pv_one<NB, 0>(o[0], vb, pa0, pa1, pa2, pa3); pv_one<NB, 1>(o[1], vb, pa0, pa1, pa2, pa3);
            if constexpr (NB == 4) { pv_one<NB, 2>(o[2], vb, pa0, pa1, pa2, pa3); pv_one<NB, 3>(o[3], vb, pa0, pa1, pa2, pa3); }
        }
        if (t + 1 < thi) { if constexpr (Pol::KIND == 2) AT_SLOAD(t + 1); AT_SWRITE(buf ^ 1); }
        __syncthreads();
    }
#undef AT_SLOAD
#undef AT_SWRITE
    if (hi == 0) li_l[r32] = l_reg;
    asm volatile("s_waitcnt lgkmcnt(0)" ::: "memory");
    float rli[16];
#pragma unroll
    for (int r = 0; r < 16; ++r) rli[r] = __builtin_amdgcn_rcpf(li_l[crow(r, hi)]);
    if constexpr (Pol::KIND == 0) {
        bf16_t* ob = X.obr + (size_t)P.br * ((size_t)M * 512);
#pragma unroll
        for (int r = 0; r < 16; ++r) { const long tok = P.qtok(wid, crow(r, hi));
#pragma unroll
            for (int d = 0; d < NB; ++d) ob[tok * 512 + P.h * 64 + d * 32 + r32] = (bf16_t)(cvtpk(o[d][r] * rli[r], 0.f) & 0xffffu); }
        if (hi == 0) X.lse[(size_t)P.br * ((size_t)M * 8) + P.qtok(wid, r32) * 8 + P.h] = m_reg + __builtin_amdgcn_logf(l_reg);
    } else if constexpr (Pol::KIND == 1) {
#pragma unroll
        for (int r = 0; r < 16; ++r) { const long tok = P.qtok(wid, crow(r, hi));
#pragma unroll
            for (int d = 0; d < NB; ++d) X.att[tok * D + 512 + P.h * 64 + d * 32 + r32] = (bf16_t)(cvtpk(o[d][r] * rli[r], 0.f) & 0xffffu); }
    } else {
        LAS float* XB = (LAS float*)(lds + L_X);
        if (wid >= 4) {
#pragma unroll
            for (int r = 0; r < 16; ++r) { const int row = 32 * (wid & 3) + crow(r, hi);
#pragma unroll
                for (int d = 0; d < NB; ++d) XB[row * 128 + d * 32 + r32] = X.lam * o[d][r] * rli[r]; }
        }
        __syncthreads();
        if (wid < 4) {
#pragma unroll
            for (int r = 0; r < 16; ++r) { const int row = 32 * wid + crow(r, hi); float s = 0.f;
#pragma unroll
                for (int d = 0; d < NB; ++d) { const float y = o[d][r] * rli[r] - XB[row * 128 + d * 32 + r32]; o[d][r] = y; s += y * y; }
                s += sx(s, 1, lane); s += sx(s, 2, lane); s += sx(s, 4, lane); s += sx(s, 8, lane); s += sx(s, 16, lane);
                const float rs = (1.0f - LAM_INIT) / sqrtf(s * (1.0f / 128.f) + SUBLN_EPS);
                const long tok = P.qtok(wid, crow(r, hi));
#pragma unroll
                for (int d = 0; d < NB; ++d) X.att[tok * D + P.h * 128 + d * 32 + r32] = (bf16_t)(cvtpk(o[d][r] * rs * X.subln[d * 32 + r32], 0.f) & 0xffffu); }
        }
        __syncthreads();
    }
}

template <class Pol> __device__ __forceinline__ void attn_unit(const Pol& P, LAS unsigned char* lds, const Ptrs& X) { bf16x8 z0_ = {}, z1_ = {}, z2_ = {}, z3_ = {}, z4_ = {}, z5_ = {}; attn_unit(P, lds, X, z0_, z1_, z2_, z3_, z4_, z5_, false, P, false); }
typedef __bf16 bf16x2_t __attribute__((ext_vector_type(2)));
typedef float f32x2_t __attribute__((ext_vector_type(2)));
__device__ __forceinline__ unsigned pk2(float lo, float hi) { const f32x2_t v = {lo, hi}; return __builtin_bit_cast(unsigned, __builtin_convertvector(v, bf16x2_t)); }
__device__ __forceinline__ s16x4 trb(const LAS unsigned char* p) { return __builtin_amdgcn_ds_read_tr16_b64_v4i16((LAS s16x4*)p); }
template <int D0> __device__ __forceinline__ void pv_blk(f32x16& od, const LAS unsigned char* vb, bf16x8 pa0, bf16x8 pa1, bf16x8 pa2, bf16x8 pa3) {
    constexpr int NB = 4;
    const s16x4 l0 = trb(vb + v_rd_off<NB>(D0, 0, 0)), h0 = trb(vb + v_rd_off<NB>(D0, 0, 1)), l1 = trb(vb + v_rd_off<NB>(D0, 1, 0)), h1 = trb(vb + v_rd_off<NB>(D0, 1, 1));
    const s16x4 l2 = trb(vb + v_rd_off<NB>(D0, 2, 0)), h2 = trb(vb + v_rd_off<NB>(D0, 2, 1)), l3 = trb(vb + v_rd_off<NB>(D0, 3, 0)), h3 = trb(vb + v_rd_off<NB>(D0, 3, 1));
#define AT_PK(L, H) (bf16x8){L[0], L[1], L[2], L[3], H[0], H[1], H[2], H[3]}
    od = __builtin_amdgcn_mfma_f32_32x32x16_bf16(pa0, AT_PK(l0, h0), od, 0, 0, 0);
    od = __builtin_amdgcn_mfma_f32_32x32x16_bf16(pa1, AT_PK(l1, h1), od, 0, 0, 0);
    od = __builtin_amdgcn_mfma_f32_32x32x16_bf16(pa2, AT_PK(l2, h2), od, 0, 0, 0);
    od = __builtin_amdgcn_mfma_f32_32x32x16_bf16(pa3, AT_PK(l3, h3), od, 0, 0, 0);
#undef AT_PK
}
constexpr int DF_SCR = 98304;
__device__ __forceinline__ void diff_unit(const PolDiff& P, LAS unsigned char* lds, const Ptrs& X) {
    constexpr int W = 128, NB = 4, CH = 2, KBYTES = 64 * W * 2, VBYTES = KBYTES, NT = T / 64;
    int tid_ = threadIdx.x; asm volatile("" : "+v"(tid_));
    const int tid = tid_, wid = __builtin_amdgcn_readfirstlane(tid >> 6), lane = tid & 63, r32 = lane & 31, hi = lane >> 5;
    LAS unsigned char* K_lds = lds; LAS unsigned char* V_lds = lds + 3 * KBYTES;
    LAS float* li_l = (LAS float*)(lds + DF_SCR) + wid * 64;
    LAS unsigned* flag = (LAS unsigned*)(lds + DF_SCR + 8 * 256);
    const bf16_t* qkv = X.qkv;
    bf16x8 qr[4];
    { const bf16_t* qp = qkv + P.qtok(wid, r32) * NQKV + P.qcol(wid) + hi * 8;
#pragma unroll
      for (int d0 = 0; d0 < 4; ++d0) qr[d0] = *(const bf16x8*)(qp + d0 * 16); }
    const int kfb = P.kfrag(wid) * 2;
    int gko, gvo;
    { const int row = 4 * wid + (lane >> 4), c = (lane & 15) ^ (row & 7); gko = row * NQKV + P.kcol0() + 8 * c; }
    { const int sidx = 2 * wid + (lane >> 5), kk = 8 * (sidx >> 2) + ((lane & 31) >> 2), k = (kk & ~0xC) | ((kk & 4) << 1) | ((kk & 8) >> 1), c = 32 * (sidx & 3) + 8 * (lane & 3);
      gvo = k * NQKV + P.vcol0() + c; }
    const bf16_t* gtile = qkv + (long)P.b * T * NQKV;
    const LAS unsigned char* krd = K_lds + r32 * (W * 2);
    const LAS unsigned char* vrd = V_lds + v_rd_base(lane);
    if (tid == 0) flag[0] = 0u;
    int t_lo, n_tiles;
    { float q2 = 0.f;
#pragma unroll
      for (int d0 = 0; d0 < 4; ++d0)
#pragma unroll
          for (int e = 0; e < 8; ++e) { const float f = bf2f((unsigned short)qr[d0][e]); q2 = fmaf(f, f, q2); }
      q2 += sx(q2, 32, lane);
#pragma unroll
      for (int o_ = 1; o_ < 32; o_ <<= 1) q2 = fmaxf(q2, sx(q2, o_, lane));
      if (lane == 0) li_l[0] = q2;
      __syncthreads();
      float qm1 = 0.f, qm2 = 0.f;
#pragma unroll
      for (int w_ = 0; w_ < 4; ++w_) { qm1 = fmaxf(qm1, ((LAS float*)(lds + DF_SCR))[w_ * 64]); qm2 = fmaxf(qm2, ((LAS float*)(lds + DF_SCR))[(w_ + 4) * 64]); }
      qm1 = sqrtf(qm1) * 1.01f; qm2 = sqrtf(qm2) * 1.01f;
      const float* kn = X.kn + ((P.b * 8 + P.h) * 2) * 128;
      const float k1_ = sqrtf(kn[2 * lane] + kn[2 * lane + 1]) * 1.001f, k2_ = sqrtf(kn[128 + 2 * lane] + kn[128 + 2 * lane + 1]) * 1.001f;
      const float sb = fmaxf(qm1 * k1_, qm2 * k2_);
      const int i0u = 128 * P.qb;
      const int dist = lane < 2 * P.qb ? i0u - (64 * lane + 63) : (lane > 2 * P.qb + 1 ? 64 * lane - (i0u + 127) : 0);
      const bool visit = sb + P.nsl * (float)dist > -152.f;
      const unsigned long long mask = __ballot(visit) | (3ull << (2 * P.qb));
      int lo = __builtin_ctzll(mask), hi_t = 63 - __builtin_clzll(mask);
      if (((hi_t - lo + 1) & 1) != 0) { if (lo > 0) --lo; else ++hi_t; }
      if (hi_t - lo + 1 < 4) { if (lo > 1) lo -= 2; else hi_t += 2; }
      t_lo = __builtin_amdgcn_readfirstlane(lo); n_tiles = __builtin_amdgcn_readfirstlane(hi_t - lo + 1);
      __syncthreads();
    }
#define DF_TL(k) ((k) < 2 ? 2 * P.qb + (k) : (t_lo + (k) - 2 < 2 * P.qb ? t_lo + (k) - 2 : t_lo + (k)))
#define DF_GLDS(k, rb) do { const bf16_t* g_ = gtile + (long)(64 * DF_TL(k)) * NQKV; _Pragma("unroll") for (int i_ = 0; i_ < 2; ++i_) { \
        __builtin_amdgcn_global_load_lds((const unsigned*)(g_ + gko + i_ * (32 * NQKV)), (LAS unsigned*)(K_lds + (rb) * KBYTES + (wid + 8 * i_) * 1024), 16, 0, 0); \
        __builtin_amdgcn_global_load_lds((const unsigned*)(g_ + gvo + i_ * (32 * NQKV)), (LAS unsigned*)(V_lds + (rb) * VBYTES + (wid + 8 * i_) * 1024), 16, 0, 0); } } while (0)
#define DF_QK(p0, p1, rb) do { const LAS unsigned char* Kb_ = krd + (rb) * KBYTES; \
        _Pragma("unroll") for (int d0 = 0; d0 < 4; ++d0) { const int sw_ = (kfb + (d0 * 16 + hi * 8) * 2) ^ ((r32 & 7) << 4); \
            const bf16x8 b0_ = *(const LAS bf16x8*)(Kb_ + sw_); const bf16x8 b1_ = *(const LAS bf16x8*)(Kb_ + 32 * (W * 2) + sw_); \
            p0 = __builtin_amdgcn_mfma_f32_32x32x16_bf16(b0_, qr[d0], p0, 0, 0, 0); p1 = __builtin_amdgcn_mfma_f32_32x32x16_bf16(b1_, qr[d0], p1, 0, 0, 0); } } while (0)
#define DF_KRD(b0v, b1v, rb, d0) do { const LAS unsigned char* Kb_ = krd + (rb) * KBYTES; const int sw_ = (kfb + ((d0) * 16 + hi * 8) * 2) ^ ((r32 & 7) << 4); \
        b0v = *(const LAS bf16x8*)(Kb_ + sw_); b1v = *(const LAS bf16x8*)(Kb_ + 32 * (W * 2) + sw_); } while (0)
#define DF_KMM(p0, p1, b0v, b1v, d0) do { p0 = __builtin_amdgcn_mfma_f32_32x32x16_bf16(b0v, qr[d0], p0, 0, 0, 0); p1 = __builtin_amdgcn_mfma_f32_32x32x16_bf16(b1v, qr[d0], p1, 0, 0, 0); } while (0)
#define DF_QK1(p0, p1, rb, d0) do { const LAS unsigned char* Kb_ = krd + (rb) * KBYTES; const int sw_ = (kfb + ((d0) * 16 + hi * 8) * 2) ^ ((r32 & 7) << 4); \
        const bf16x8 b0_ = *(const LAS bf16x8*)(Kb_ + sw_); const bf16x8 b1_ = *(const LAS bf16x8*)(Kb_ + 32 * (W * 2) + sw_); \
        p0 = __builtin_amdgcn_mfma_f32_32x32x16_bf16(b0_, qr[d0], p0, 0, 0, 0); p1 = __builtin_amdgcn_mfma_f32_32x32x16_bf16(b1_, qr[d0], p1, 0, 0, 0); } while (0)
#define DF_SUM16(p) ((((p[0] + p[1]) + (p[2] + p[3])) + ((p[4] + p[5]) + (p[6] + p[7]))) + (((p[8] + p[9]) + (p[10] + p[11])) + ((p[12] + p[13]) + (p[14] + p[15]))))
#define DF_EXP_H(pp, b8) do { _Pragma("unroll") for (int r = 0; r < 8; ++r) pp[(b8) + r] = __builtin_amdgcn_exp2f(pp[(b8) + r]); } while (0)
#define DF_EXP_A(p0, p1) do { _Pragma("unroll") for (int r = 0; r < 16; ++r) p0[r] = __builtin_amdgcn_exp2f(p0[r]); _Pragma("unroll") for (int r = 0; r < 8; ++r) p1[r] = __builtin_amdgcn_exp2f(p1[r]); } while (0)
#define DF_FINISH(p0, p1) do { _Pragma("unroll") for (int r = 8; r < 16; ++r) p1[r] = __builtin_amdgcn_exp2f(p1[r]); \
        float ps_ = 0.f; _Pragma("unroll") for (int r = 0; r < 16; ++r) ps_ += p0[r] + p1[r]; l_reg += ps_; \
        DF_PK4(p0, 0, pa0); DF_PK4(p0, 8, pa1); DF_PK4(p1, 0, pa2); DF_PK4(p1, 8, pa3); } while (0)
#define DF_PK4(PP, BASE, OUT) do { unsigned a0 = pk2(PP[BASE + 0], PP[BASE + 1]), a1 = pk2(PP[BASE + 2], PP[BASE + 3]); \
    unsigned b0_ = pk2(PP[BASE + 4], PP[BASE + 5]), b1_ = pk2(PP[BASE + 6], PP[BASE + 7]); \
    auto r0_ = __builtin_amdgcn_permlane32_swap(a0, b0_, false, false); auto r1_ = __builtin_amdgcn_permlane32_swap(a1, b1_, false, false); \
    u32x4 w_ = {r0_[0], r1_[0], r0_[1], r1_[1]}; OUT = *reinterpret_cast<bf16x8*>(&w_); } while (0)
#define DF_PV(rb) do { const LAS unsigned char* vb_ = vrd + (rb) * VBYTES; pv_blk<0>(o[0], vb_, pa0, pa1, pa2, pa3); pv_blk<1>(o[1], vb_, pa0, pa1, pa2, pa3); \
        pv_blk<2>(o[2], vb_, pa0, pa1, pa2, pa3); pv_blk<3>(o[3], vb_, pa0, pa1, pa2, pa3); } while (0)
#define DF_HALF(c0, c1, q0, q1, j, LOADS) do { \
        DF_KRD(ka0, ka1, rc, 0); if (LOADS) DF_GLDS((j) + 1, rn); __builtin_amdgcn_sched_barrier(0);     \
        { float ps0_ = 0.f, ps1_ = 0.f; \
          DF_KRD(kb0, kb1, rc, 1); DF_KMM(c0, c1, ka0, ka1, 0); DF_EXP_H(q1, 8); __builtin_amdgcn_sched_barrier(0); \
          DF_KRD(ka0, ka1, rc, 2); DF_KMM(c0, c1, kb0, kb1, 1); ps0_ = DF_SUM16(q0); DF_PK4(q0, 0, pa0); __builtin_amdgcn_sched_barrier(0); \
          DF_KRD(kb0, kb1, rc, 3); DF_KMM(c0, c1, ka0, ka1, 2); ps1_ = DF_SUM16(q1); DF_PK4(q0, 8, pa1); __builtin_amdgcn_sched_barrier(0); \
          DF_KMM(c0, c1, kb0, kb1, 3); l_reg += ps0_ + ps1_; DF_PK4(q1, 0, pa2); DF_PK4(q1, 8, pa3); __builtin_amdgcn_sched_barrier(0); } \
        { const LAS unsigned char* vb_ = vrd + rp * VBYTES; \
          pv_blk<0>(o[0], vb_, pa0, pa1, pa2, pa3); DF_EXP_H(c0, 0); __builtin_amdgcn_sched_barrier(0); \
          pv_blk<1>(o[1], vb_, pa0, pa1, pa2, pa3); DF_EXP_H(c0, 8); __builtin_amdgcn_sched_barrier(0); \
          pv_blk<2>(o[2], vb_, pa0, pa1, pa2, pa3); DF_EXP_H(c1, 0); if (LOADS) P.cinit_off<0>(q0, DF_TL((j) + 1), wid, r32, hi); __builtin_amdgcn_sched_barrier(0); \
          pv_blk<3>(o[3], vb_, pa0, pa1, pa2, pa3); if (LOADS) P.cinit_off<1>(q1, DF_TL((j) + 1), wid, r32, hi); __builtin_amdgcn_sched_barrier(0); } \
        __syncthreads(); { const int t_ = rp; rp = rc; rc = rn; rn = t_; } } while (0)
    float l_reg = 0.f; f32x16 o[NB];
#pragma unroll
    for (int d = 0; d < NB; ++d) o[d] = f32x16{};
    f32x16 pA0, pA1, pB0, pB1; bf16x8 pa0, pa1, pa2, pa3, ka0, ka1, kb0, kb1;
    int rp = 2, rc = 0, rn = 1;
    DF_GLDS(0, 0); DF_GLDS(1, 1); __syncthreads();
    P.cinit_abs<0>(pA0, DF_TL(0), wid, r32, hi); P.cinit_abs<1>(pA1, DF_TL(0), wid, r32, hi); DF_QK(pA0, pA1, 0); DF_EXP_A(pA0, pA1);
    P.cinit_abs<0>(pB0, DF_TL(1), wid, r32, hi); P.cinit_abs<1>(pB1, DF_TL(1), wid, r32, hi);
    rp = 0; rc = 1; rn = 2;
    { int j = 1;
      do { DF_HALF(pB0, pB1, pA0, pA1, j, true);
           DF_HALF(pA0, pA1, pB0, pB1, j + 1, true); j += 2; } while (j + 2 < n_tiles); }
    DF_HALF(pB0, pB1, pA0, pA1, n_tiles - 1, false);
    DF_FINISH(pB0, pB1); DF_PV(rp);
#undef DF_GLDS
#undef DF_TL
#undef DF_QK
#undef DF_EXP_A
#undef DF_QK1
#undef DF_KRD
#undef DF_KMM
#undef DF_SUM16
#undef DF_EXP_H
#undef DF_FINISH
#undef DF_PK4
#undef DF_PV
#undef DF_HALF
    int tid2_ = threadIdx.x; asm volatile("" : "+v"(tid2_));
    const int lane2 = tid2_ & 63, r32b = lane2 & 31, hib = lane2 >> 5;
    { auto rr = __builtin_amdgcn_permlane32_swap(__float_as_uint(l_reg), __float_as_uint(l_reg), false, false);
      l_reg = __uint_as_float(rr[0]) + __uint_as_float(rr[1]); }
    const bool bad = !(l_reg > 7.9e-31f && l_reg < 1.2e30f);
    if (__any(bad) && lane2 == 0) flag[0] = 1u;
    __syncthreads();
    const bool redo = __builtin_amdgcn_readfirstlane((int)flag[0]) != 0;
    __syncthreads();
    if (redo) { attn_unit(P, lds, X); return; }
    if (hib == 0) li_l[r32b] = l_reg;
    asm volatile("s_waitcnt lgkmcnt(0)" ::: "memory");
    float rli[16];
#pragma unroll
    for (int r = 0; r < 16; ++r) rli[r] = __builtin_amdgcn_rcpf(li_l[crow(r, hib)]);
    LAS float* XB = (LAS float*)lds;
    if (wid >= 4) {
#pragma unroll
        for (int r = 0; r < 16; ++r) { const int row = 32 * (wid & 3) + crow(r, hib);
#pragma unroll
            for (int d = 0; d < NB; ++d) XB[row * 128 + d * 32 + r32b] = X.lam * o[d][r] * rli[r]; }
    }
    __syncthreads();
    if (wid < 4) {
#pragma unroll
        for (int r = 0; r < 16; ++r) { const int row = 32 * wid + crow(r, hib); float s = 0.f;
#pragma unroll
            for (int d = 0; d < NB; ++d) { const float y = o[d][r] * rli[r] - XB[row * 128 + d * 32 + r32b]; o[d][r] = y; s += y * y; }
            s += sx(s, 1, lane2); s += sx(s, 2, lane2); s += sx(s, 4, lane2); s += sx(s, 8, lane2); s += sx(s, 16, lane2);
            const float rs = (1.0f - LAM_INIT) / sqrtf(s * (1.0f / 128.f) + SUBLN_EPS);
            const long tok = P.qtok(wid, crow(r, hib));
#pragma unroll
            for (int d = 0; d < NB; ++d) X.att[tok * D + P.h * 128 + d * 32 + r32b] = (bf16_t)(pk2(o[d][r] * rs * X.subln[d * 32 + r32b], 0.f) & 0xffffu); }
    }
    __syncthreads();
}
}

#define XB_TMO      128
#define XB_XCNT(j)  (256  + 64 * (j))
#define XB_XSUB(j)  (1280 + 64 * (j))
#define XB_XGEN(j)  (2304 + 64 * (j))
#define XB_TOP      3328
#define XB_TOPGEN   3392
#define XCD_BAR_WORDS 3456
#define XB_SPIN_CAP (1u << 18)

__device__ __forceinline__ unsigned xb_ld(unsigned* p)              { return __hip_atomic_load(p, __ATOMIC_RELAXED, __HIP_MEMORY_SCOPE_AGENT); }
__device__ __forceinline__ unsigned xb_add(unsigned* p, unsigned v) { return __hip_atomic_fetch_add(p, v, __ATOMIC_RELAXED, __HIP_MEMORY_SCOPE_AGENT); }
__device__ __forceinline__ unsigned xb_xcc_id() { return (unsigned)__builtin_amdgcn_s_getreg((3 << 11) | 20) & 0xFu; }
#define XB_SPIN(cond, bar) do { unsigned _sp = 0; while (cond) { __builtin_amdgcn_s_sleep(1); \
    if ((++_sp & 255u) == 0u) { if (xb_ld(&(bar)[XB_TMO])) break; if (_sp > XB_SPIN_CAP) { atomicAdd(&(bar)[XB_TMO], 1u); break; } } } } while (0)

struct XcdBarrier {
    unsigned* bar; unsigned x;
    volatile LAS unsigned* st;
};

__device__ __forceinline__ XcdBarrier xcd_barrier_post(unsigned* bar, volatile LAS unsigned* st) {
    XcdBarrier b; b.bar = bar; b.x = xb_xcc_id(); b.st = st;
    if (threadIdx.x == 0) (void)xb_add(&bar[XB_XCNT(b.x)], 1u);
    return b;
}
__device__ __forceinline__ void xcd_barrier_complete(unsigned* bar, unsigned x, unsigned& nloc, unsigned& nx) {
    const unsigned G = gridDim.x * gridDim.y * gridDim.z;
    unsigned sum, cnt, mine, sp = 0u;
    for (;;) {
        sum = 0u; cnt = 0u; mine = 0u;
#pragma unroll
        for (unsigned j = 0; j < 16; ++j) { const unsigned c = xb_ld(&bar[XB_XCNT(j)]); sum += c; cnt += (c > 0u) ? 1u : 0u; mine = (j == x) ? c : mine; }
        if (sum == G) break;
        __builtin_amdgcn_s_sleep(1);
        if ((++sp & 255u) == 0u) { if (xb_ld(&bar[XB_TMO])) break; if (sp > XB_SPIN_CAP) { atomicAdd(&bar[XB_TMO], 1u); break; } }
    }
    nloc = mine > 0u ? mine : 1u; nx = cnt > 0u ? cnt : 1u;
}

__device__ __forceinline__ void xcd_barrier(const XcdBarrier& b) {
    asm volatile("s_waitcnt vmcnt(0)" ::: "memory");
    __syncthreads();
    if (threadIdx.x == 0) {
        unsigned* bar = b.bar;
        __builtin_amdgcn_s_waitcnt(0);
        unsigned nloc = b.st[0], nx = b.st[1];
        if (nloc == 0u) { xcd_barrier_complete(bar, b.x, nloc, nx); b.st[0] = nloc; b.st[1] = nx; }
        const unsigned old = xb_add(&bar[XB_XSUB(b.x)], 1u);
        const unsigned gen = old / nloc;
        if (old + 1u == (gen + 1u) * nloc) {
            __builtin_amdgcn_fence(__ATOMIC_RELEASE, "agent");
            asm volatile("s_waitcnt vmcnt(0)" ::: "memory");
            const unsigned og = xb_add(&bar[XB_TOP], 1u);
            const unsigned tg = og / nx;
            if (og + 1u == (tg + 1u) * nx) xb_add(&bar[XB_TOPGEN], 1u);
            else XB_SPIN(xb_ld(&bar[XB_TOPGEN]) == tg, bar);
            __builtin_amdgcn_fence(__ATOMIC_ACQUIRE, "agent");
            xb_add(&bar[XB_XGEN(b.x)], 1u);
            asm volatile("s_waitcnt vmcnt(0)" ::: "memory");
        } else {
            XB_SPIN(xb_ld(&bar[XB_XGEN(b.x)]) == gen, bar);
            __builtin_amdgcn_fence(__ATOMIC_ACQUIRE, "agent");
            asm volatile("s_waitcnt vmcnt(0)" ::: "memory");
        }
    }
    __syncthreads();
}

__device__ __forceinline__ void grp_barrier(unsigned* cnt, unsigned& epoch, unsigned nmem) {
    asm volatile("s_waitcnt vmcnt(0)" ::: "memory");
    __syncthreads();
    epoch += 1u;
    if (threadIdx.x == 0) {
        __builtin_amdgcn_fence(__ATOMIC_RELEASE, "agent"); asm volatile("s_waitcnt vmcnt(0)" ::: "memory");
        (void)xb_add(cnt, 1u);
        const unsigned target = nmem * epoch; unsigned sp = 0u;
        while (xb_ld(cnt) < target) { __builtin_amdgcn_s_sleep(1); if (++sp > (1u << 22)) break; }
        __builtin_amdgcn_fence(__ATOMIC_ACQUIRE, "agent"); asm volatile("s_waitcnt vmcnt(0)" ::: "memory");
    }
    __syncthreads();
}

constexpr size_t MiB = 1u << 20;
constexpr size_t WS_W = 2 * MiB, WS_WL = 26 * MiB;
constexpr size_t WO_IN = 0, WO_O = 6 * MiB, WO_GU = 8 * MiB, WO_D = 19 * MiB;
constexpr size_t WS_BAR = 512 * 1024, WS_BAR_BYTES = 16384;
constexpr size_t WS_KN = 0;
constexpr size_t WS_SS = 56 * MiB, WS_LSE = 60 * MiB, WS_XB = 68 * MiB, WS_ATT = 196 * MiB, WS_OBR = 324 * MiB, WS_QKV = 516 * MiB, WS_H = WS_QKV, WS_END = 900 * MiB;
constexpr int LDS_BYTES = 147456;

struct Args { const float* in[22]; float* out; unsigned char* ws; int ph_lo, ph_hi; };
enum { I_X = 0, I_A0N = 1, I_A0IN = 2, I_A0OUT = 3, I_RPB = 4, I_F0N = 5, I_F0G = 6, I_F0U = 7, I_F0D = 8, I_A1N = 9, I_A1QKV = 10, I_A1OUT = 11,
       I_LQ1 = 12, I_LK1 = 13, I_LQ2 = 14, I_LK2 = 15, I_SUBLN = 16, I_F1N = 17, I_F1G = 18, I_F1U = 19, I_F1D = 20, I_FN = 21 };
constexpr int NPH = 14;

__device__ __forceinline__ float wave_sum(float v, int lane) {
#pragma unroll
    for (int o = 1; o < 64; o <<= 1) v += sx(v, o, lane);
    return v;
}
__device__ __forceinline__ void transpose_item(const float* W, const float* gain, int K, int N, bf16_t* WT, int mode, LAS float* scr, int item, int lane) {
    const int nblk = N / 32, kb = item / nblk, nb = item % nblk, k0 = 64 * kb, n0 = 32 * nb;
#pragma unroll 8
    for (int i = 0; i < 32; ++i) { const int kk = 2 * i + (lane >> 5); const float g = gain ? gain[k0 + kk] : 1.0f; scr[kk * 33 + (lane & 31)] = W[(size_t)(k0 + kk) * N + n0 + (lane & 31)] * g; }
    asm volatile("s_waitcnt lgkmcnt(0)" ::: "memory");
    const int c = lane & 7;
    const int ob = mode == 0 ? n0 : 256 * (n0 >> 7) + 128 * (mode - 1) + (n0 & 127);
#pragma unroll
    for (int j = 0; j < 4; ++j) { const int n = (lane >> 3) + 8 * j; const LAS float* s = scr + (8 * c) * 33 + n;
        u32x4 o; o.x = cvtpk(s[0 * 33], s[1 * 33]); o.y = cvtpk(s[2 * 33], s[3 * 33]); o.z = cvtpk(s[4 * 33], s[5 * 33]); o.w = cvtpk(s[6 * 33], s[7 * 33]);
        *(u32x4*)(WT + (size_t)(ob + n) * K + k0 + 8 * c) = o; }
    asm volatile("s_waitcnt lgkmcnt(0)" ::: "memory");
}

__global__ void __launch_bounds__(512, 2) mk_fwd(Args a) {
    extern __shared__ __attribute__((aligned(16))) unsigned char lds_raw[];
    LAS unsigned char* lds = (LAS unsigned char*)lds_raw;
    cg::grid_group grid = cg::this_grid();
    { volatile LAS unsigned* st_ = (volatile LAS unsigned*)(lds + LDS_BYTES - 64); if (threadIdx.x < 2) st_[threadIdx.x] = 0u; }
    __syncthreads();
    const XcdBarrier bar = xcd_barrier_post((unsigned*)(a.ws + WS_BAR), (volatile LAS unsigned*)(lds + LDS_BYTES - 64));
    if (a.ph_lo < 0) grid.sync();
    const int wave = __builtin_amdgcn_readfirstlane((int)threadIdx.x >> 6);
    const int G = gridDim.x, gw = blockIdx.x * 8 + wave, NGW = G * 8;
    const bool grp = (G == M / 256) && (G % 8 == 0) && MK_DUP_MASK == 0;
    unsigned grp_epoch = 0u; unsigned* const grp_cnt = (unsigned*)(a.ws + WS_BAR) + 3520 + 64 * ((int)blockIdx.x & 7);
    unsigned char* ws = a.ws;
    float* ss = (float*)(ws + WS_SS); float* lse = (float*)(ws + WS_LSE);
    bf16_t* xb = (bf16_t*)(ws + WS_XB); bf16_t* att = (bf16_t*)(ws + WS_ATT); bf16_t* obr = (bf16_t*)(ws + WS_OBR);
    bf16_t* qkv = (bf16_t*)(ws + WS_QKV); bf16_t* hb = (bf16_t*)(ws + WS_H);

#ifdef MK_PROBE_SYNCS
    for (int i_ = 0; i_ < MK_PROBE_SYNCS; ++i_) xcd_barrier(bar);
#endif
    for (int ph = a.ph_lo; ph < a.ph_hi; ++ph)
    for (int rep = 0; rep <= ((MK_DUP_MASK >> ph) & 1); ++rep) {
        if (ph == 0) {
            int tq_ = threadIdx.x; asm volatile("" : "+v"(tq_)); const int lane = tq_ & 63;
            LAS float* scr = (LAS float*)(lds + wave * 16384);
            constexpr int I_IN = 16 * 96, I_O = 16 * 32, I_G = 16 * 88, I_D = 44 * 32, I_L = I_IN + I_O + 2 * I_G + I_D;
            for (int it = gw; it < 2 * I_L; it += NGW) {
                const int l = it / I_L; int r = it % I_L; unsigned char* wl = ws + WS_W + (size_t)l * WS_WL;
                const float* an = a.in[l ? I_A1N : I_A0N]; const float* fn = a.in[l ? I_F1N : I_F0N];
                if (r < I_IN) { transpose_item(a.in[l ? I_A1QKV : I_A0IN], an, D, NQKV, (bf16_t*)(wl + WO_IN), 0, scr, r, lane); continue; } r -= I_IN;
                if (r < I_O) { transpose_item(a.in[l ? I_A1OUT : I_A0OUT], nullptr, D, D, (bf16_t*)(wl + WO_O), 0, scr, r, lane); continue; } r -= I_O;
                if (r < I_G) { transpose_item(a.in[l ? I_F1G : I_F0G], fn, D, FF, (bf16_t*)(wl + WO_GU), 1, scr, r, lane); continue; } r -= I_G;
                if (r < I_G) { transpose_item(a.in[l ? I_F1U : I_F0U], fn, D, FF, (bf16_t*)(wl + WO_GU), 2, scr, r, lane); continue; } r -= I_G;
                transpose_item(a.in[l ? I_F1D : I_F0D], nullptr, FF, D, (bf16_t*)(wl + WO_D), 0, scr, r, lane);
            }
            const float* x = a.in[I_X];
            for (int m = gw; m < M; m += 2 * NGW) {
                const f32x4* xr0 = (const f32x4*)(x + (size_t)m * D) + lane; const f32x4* xr1 = (const f32x4*)(x + (size_t)(m + NGW) * D) + lane; f32x4 v0[4], v1[4];
#pragma unroll
                for (int j = 0; j < 4; ++j) { v0[j] = xr0[64 * j]; v1[j] = xr1[64 * j]; }
                float s0 = 0.f, s1 = 0.f;
#pragma unroll
                for (int j = 0; j < 4; ++j) { s0 += (v0[j][0] * v0[j][0] + v0[j][1] * v0[j][1]) + (v0[j][2] * v0[j][2] + v0[j][3] * v0[j][3]);
                                              s1 += (v1[j][0] * v1[j][0] + v1[j][1] * v1[j][1]) + (v1[j][2] * v1[j][2] + v1[j][3] * v1[j][3]); }
                s0 = wave_sum(s0, lane); s1 = wave_sum(s1, lane);
                u32x2* o0 = (u32x2*)(xb + (size_t)m * D) + lane; u32x2* o1 = (u32x2*)(xb + (size_t)(m + NGW) * D) + lane;
#pragma unroll
                for (int j = 0; j < 4; ++j) { u32x2 w; w.x = cvtpk(v0[j][0], v0[j][1]); w.y = cvtpk(v0[j][2], v0[j][3]); o0[64 * j] = w;
                                              u32x2 z; z.x = cvtpk(v1[j][0], v1[j][1]); z.y = cvtpk(v1[j][2], v1[j][3]); o1[64 * j] = z; }
                if (lane < 16) { ss[(size_t)m * 16 + lane] = lane == 0 ? s0 : 0.f; ss[(size_t)(m + NGW) * 16 + lane] = lane == 0 ? s1 : 0.f; }
            }
        } else if (ph == 13) {
            int tq_ = threadIdx.x; asm volatile("" : "+v"(tq_)); const int lane = tq_ & 63;
            const float* g = a.in[I_FN];
            f32x4 gg[4];
#pragma unroll
            for (int j = 0; j < 4; ++j) gg[j] = ((const f32x4*)g)[lane + 64 * j];
            const int pm_ = ((int)blockIdx.x & 7) * 32 + ((int)blockIdx.x >> 3);
            const int m_lo = grp ? pm_ * 256 + wave : gw, m_hi = grp ? pm_ * 256 + 256 : M, m_st = grp ? 8 : NGW;
            for (int m = m_lo; m < m_hi; m += 2 * m_st) {
                f32x4* xr0 = (f32x4*)(a.out + (size_t)m * D) + lane; f32x4* xr1 = (f32x4*)(a.out + (size_t)(m + m_st) * D) + lane; f32x4 v0[4], v1[4];
#pragma unroll
                for (int j = 0; j < 4; ++j) { v0[j] = xr0[64 * j]; v1[j] = xr1[64 * j]; }
                float s0 = 0.f, s1 = 0.f;
#pragma unroll
                for (int j = 0; j < 4; ++j) { s0 += (v0[j][0] * v0[j][0] + v0[j][1] * v0[j][1]) + (v0[j][2] * v0[j][2] + v0[j][3] * v0[j][3]);
                                              s1 += (v1[j][0] * v1[j][0] + v1[j][1] * v1[j][1]) + (v1[j][2] * v1[j][2] + v1[j][3] * v1[j][3]); }
                s0 = wave_sum(s0, lane); s1 = wave_sum(s1, lane);
                const float rs0 = 1.0f / sqrtf(s0 * (1.0f / D) + RMS_EPS), rs1 = 1.0f / sqrtf(s1 * (1.0f / D) + RMS_EPS);
#pragma unroll
                for (int j = 0; j < 4; ++j) { xr0[64 * j] = v0[j] * rs0 * gg[j]; xr1[64 * j] = v1[j] * rs1 * gg[j]; }
            }
        } else {
            const int l = (ph - 1) / 6, s = (ph - 1) % 6;
            unsigned char* wl = ws + WS_W + (size_t)l * WS_WL;
            if (s == 0) {
                pg8::Gemm g{xb, (const bf16_t*)(wl + WO_IN), M, NQKV, D}; pg8::StaticOrder S; S.init(M, NQKV, G, (int)blockIdx.x);
                pg8::EpiScaleBf16 E{qkv, NQKV, ss, l == 0 ? 0xC3u : 0xFu, l == 1 ? (float*)(ws + WS_KN) : nullptr};
#ifndef SKIP_G1
                pg8::gemm_phase<pg8::EpiScaleBf16, pg8::StaticOrder, true, true>(lds, g, S, E);
#endif
            } else if (s == 1) {
                at::Ptrs X{qkv, att, obr, lse, a.in[I_RPB], a.in[I_SUBLN], 0.f, (const float*)(ws + WS_KN)};
                if (l == 0) {
                    const int vc0 = ((int)blockIdx.x & 7) * (G >> 3) + ((int)blockIdx.x >> 3);
#ifndef SKIP_NAT
                    for (int u = vc0; u < 2048; u += G) { at::PolNat P; P.init(u); at::attn_unit(P, lds, X); }
#endif
#ifndef SKIP_DIL
                    { bf16x8 pq0 = {}, pq1 = {}, pq2 = {}, pq3 = {}, pk_ = {}, pv_ = {}; bool have = false;
                      for (int u = 2048 + vc0; u < 8192; u += G) { at::PolDil P, Pn; P.init(u - 2048); const bool hasn = u + G < 8192; if (hasn) Pn.init(u + G - 2048); else Pn = P;
                          at::attn_unit(P, lds, X, pq0, pq1, pq2, pq3, pk_, pv_, have, Pn, hasn); have = hasn; } }
#endif
                }
            } else if (s == 2) {
                if (l == 0) {
                    int tq_ = threadIdx.x; asm volatile("" : "+v"(tq_)); const int lane = tq_ & 63;
                    const int hd = lane >> 3;
                    for (int m0 = gw; m0 < M; m0 += 2 * NGW) {
                        float L[2][3]; bf16x8 ov[2][3];
#pragma unroll
                        for (int r = 0; r < 2; ++r) { const size_t m = (size_t)m0 + (size_t)r * NGW;
#pragma unroll
                            for (int i = 0; i < 3; ++i) { L[r][i] = lse[(size_t)i * M * 8 + m * 8 + hd]; ov[r][i] = *(const bf16x8*)(obr + (size_t)i * M * 512 + m * 512 + lane * 8); } }
#pragma unroll
                        for (int r = 0; r < 2; ++r) { const size_t m = (size_t)m0 + (size_t)r * NGW;
                            const float mx = fmaxf(L[r][0], fmaxf(L[r][1], L[r][2]));
                            float w0 = __builtin_amdgcn_exp2f(L[r][0] - mx), w1 = __builtin_amdgcn_exp2f(L[r][1] - mx), w2 = __builtin_amdgcn_exp2f(L[r][2] - mx);
                            const float inv = 1.0f / (w0 + w1 + w2); w0 *= inv; w1 *= inv; w2 *= inv;
                            float y[8];
#pragma unroll
                            for (int e = 0; e < 8; ++e) y[e] = w0 * bf2f((unsigned short)ov[r][0][e]) + w1 * bf2f((unsigned short)ov[r][1][e]) + w2 * bf2f((unsigned short)ov[r][2][e]);
                            u32x4 w; w.x = cvtpk(y[0], y[1]); w.y = cvtpk(y[2], y[3]); w.z = cvtpk(y[4], y[5]); w.w = cvtpk(y[6], y[7]);
                            *(u32x4*)(att + m * D + lane * 8) = w; }
                    }
                } else {
                    float d1 = 0.f, d2 = 0.f;
                    for (int i = 0; i < 64; ++i) { d1 += a.in[I_LQ1][i] * a.in[I_LK1][i]; d2 += a.in[I_LQ2][i] * a.in[I_LK2][i]; }
                    at::Ptrs X{qkv, att, obr, lse, a.in[I_RPB], a.in[I_SUBLN], 0.f, (const float*)(ws + WS_KN)};
                    X.lam = __int_as_float(__builtin_amdgcn_readfirstlane(__float_as_int(__expf(d1) - __expf(d2) + LAM_INIT)));
#ifndef SKIP_DIFF
                    for (int u = blockIdx.x; u < 4096; u += G) { at::PolDiff P; P.init(u); at::diff_unit(P, lds, X); }
#endif
                }
            } else if (s == 3 || s == 5) {
                const bool dn = s == 5;
                pg8::Gemm g{dn ? hb : att, (const bf16_t*)(wl + (dn ? WO_D : WO_O)), M, D, dn ? FF : D}; pg8::StaticOrder S; S.init(M, D, G, (int)blockIdx.x);
                pg8::EpiResid E{(l == 0 && !dn) ? a.in[I_X] : nullptr, (l == 1 && dn) ? a.out : nullptr, xb, (bf16_t*)(ws + WS_OBR)  , ss};
#ifndef SKIP_G2
                pg8::gemm_phase<pg8::EpiResid, pg8::StaticOrder, true, true>(lds, g, S, E);
#endif
            } else {
                pg8::Gemm g{xb, (const bf16_t*)(wl + WO_GU), M, NGU, D}; pg8::StaticOrder S; S.init(M, NGU, G, (int)blockIdx.x);
                pg8::EpiSwiGLU E{hb, ss};
#ifndef SKIP_G3
                pg8::gemm_phase<pg8::EpiSwiGLU, pg8::StaticOrder, true, true>(lds, g, S, E);
#endif
            }
        }
        if ((ph + 1 < a.ph_hi || rep < ((MK_DUP_MASK >> ph) & 1)) && ph != 8) {
            if (grp && ((ph >= 4 && ph <= 5) || (ph >= 10 && ph <= 12))) grp_barrier(grp_cnt, grp_epoch, (unsigned)(G >> 3));
            else xcd_barrier(bar); }
    }
}

extern "C" void kernel_launch(void* const* d_in, const int* in_sizes, int n_in, void* d_out, int out_size, void* d_ws, size_t ws_size, hipStream_t stream) {
    static int grid = 0;
    if (grid == 0) {
        if (n_in != 22 || in_sizes[0] != M * D || out_size != M * D || ws_size < WS_END) { fprintf(stderr, "kernel_launch: unexpected shapes (n_in %d, in0 %d, out %d, ws %zu)\n", n_in, n_in > 0 ? in_sizes[0] : -1, out_size, ws_size); grid = -1; return; }
        int dev = 0, cus = 0, per_cu = 0;
        hipGetDevice(&dev); hipDeviceGetAttribute(&cus, hipDeviceAttributeMultiprocessorCount, dev);
        if (hipFuncSetAttribute((const void*)mk_fwd, hipFuncAttributeMaxDynamicSharedMemorySize, LDS_BYTES) != hipSuccess) { fprintf(stderr, "kernel_launch: hipFuncSetAttribute failed\n"); grid = -1; return; }
        hipOccupancyMaxActiveBlocksPerMultiprocessor(&per_cu, (const void*)mk_fwd, 512, LDS_BYTES);
        (void)hipGetLastError();
        if (per_cu < 1) { fprintf(stderr, "kernel_launch: occupancy query says %d blocks/CU\n", per_cu); per_cu = 1; }
        grid = cus * 1;
    }
    if (grid < 0) return;
    Args a{};
    for (int i = 0; i < 22; ++i) a.in[i] = (const float*)d_in[i];
    a.out = (float*)d_out; a.ws = (unsigned char*)d_ws;
#if MK_ONE_LAUNCH
    if (hipMemsetAsync((char*)d_ws + WS_BAR, 0, WS_BAR_BYTES, stream) != hipSuccess) { fprintf(stderr, "kernel_launch: memset of the barrier words failed\n"); return; }
    a.ph_lo = 0; a.ph_hi = NPH;
    void* args[] = {&a};
    hipError_t e = hipLaunchCooperativeKernel((const void*)mk_fwd, dim3(grid), dim3(512), args, LDS_BYTES, stream);
    if (e != hipSuccess) fprintf(stderr, "cooperative launch failed: %s (grid %d)\n", hipGetErrorString(e), grid);
#else
    for (int ph = 0; ph < NPH; ++ph) {
        a.ph_lo = ph; a.ph_hi = ph + 1;
        hipLaunchKernelGGL(mk_fwd, dim3(grid), dim3(512), LDS_BYTES, stream, a);
    }
#endif
}
```

```cpp
#include <hip/hip_runtime.h>
#include <hip/hip_cooperative_groups.h>
#include <cstdio>
#include <cstdint>
namespace cg = cooperative_groups;
#ifndef MK_DUP_MASK
#define MK_DUP_MASK 0x0
#endif
#ifndef MK_ONE_LAUNCH
#define MK_ONE_LAUNCH 1
#endif
namespace pg8 {
#define PG8_LAS __attribute__((address_space(3)))
typedef unsigned short bf16_t;
typedef short bf16x8 __attribute__((ext_vector_type(8)));
typedef float f32x4 __attribute__((ext_vector_type(4)));
typedef unsigned u32x4 __attribute__((ext_vector_type(4)));
constexpr int BM = 256, BK = 64, HALF = 128, HTB = HALF * BK * 2  , STAGE_BYTES = 8 * HTB, NXCD = 8, WGM = 8;

__host__ __device__ __forceinline__ int lds_byte(int r, int c) { const int st = (r >> 4) * 2 + (c >> 5), rr = r & 15, cc = c & 31, ob = rr * 64 + cc * 2; return st * 1024 + (ob ^ (((ob >> 9) & 1) << 5)); }
__host__ __device__ __forceinline__ void stage_rc(int b, int& R, int& C) { const int st = b / 1024, sb = b % 1024, swz = sb ^ (((sb >> 9) & 1) << 5); R = (st >> 1) * 16 + swz / 64; C = (st & 1) * 32 + (swz % 64) / 2; }
__host__ __device__ __forceinline__ int perm32(int rho) { const int n = rho >> 4, i = rho & 15; return 8 * (i >> 2) + 4 * n + (i & 3); }

struct Unit { int pm, pn; };
struct Gemm { const bf16_t* A; const bf16_t* Bt; int M, N, K; };

struct StaticOrder {
    int nM, nN, nwg, G, c;
    __host__ __device__ void init(int M, int N, int G_, int c_) { nM = M / BM; nN = N / BM; nwg = nM * nN; G = G_; c = c_; }
    __host__ __device__ bool next(int i, Unit& u) const {
        const long L = (long)i * G + c; if (L >= nwg) return false;
        int wgid = (int)L; { const int q = nwg / NXCD, r = nwg % NXCD, xcd = wgid % NXCD, off = wgid / NXCD; wgid = (xcd < r ? xcd * (q + 1) : r * (q + 1) + (xcd - r) * q) + off; }
        const int nig = WGM * nN, gid = wgid / nig, fm = gid * WGM, gsz = (nM - fm) < WGM ? (nM - fm) : WGM;
        u.pm = fm + ((wgid % nig) % gsz); u.pn = (wgid % nig) / gsz; return true;
    }
    __device__ __forceinline__ void a_ready(const Unit&) const {}
    __device__ __forceinline__ void done(const Unit&) const {}
};

__device__ __forceinline__ unsigned cvt_pk_bf16(float lo, float hi) { unsigned r; asm volatile("v_cvt_pk_bf16_f32 %0, %1, %2" : "=v"(r) : "v"(lo), "v"(hi)); return r; }
typedef float f32x2 __attribute__((ext_vector_type(2)));
template <class Epi, class Sched, bool ALIGN_EPI = false, bool SP2 = false>
__device__ __forceinline__ void gemm_phase(PG8_LAS unsigned char* lds, const Gemm g, const Sched& S, const Epi& E) {
    int tid_ = threadIdx.x; asm volatile("" : "+v"(tid_));
    const int tid = tid_, wid = __builtin_amdgcn_readfirstlane(tid >> 6), lane = tid & 63, wr = wid >> 2, wc = wid & 3, fr = lane & 15, fq = lane >> 4;
    const int K = g.K, nt = K / BK;
    unsigned voffA[2], voffB[2];
#pragma unroll
    for (int i = 0; i < 2; ++i) { int R, C; stage_rc(tid * 16 + i * 8192, R, C); const int Rb = Epi::PERM ? ((R & ~31) + perm32(R & 31)) : R;
        voffA[i] = (unsigned)(R * K + C) * 2u; voffB[i] = (unsigned)(Rb * K + C) * 2u; }
    const size_t kstep = (size_t)(BK * 2);
    const size_t hstep = (size_t)HALF * K * 2;
    const size_t tstep = 2 * hstep;
    const unsigned ldsw = (unsigned)wid * 1024u;
    const int aoff = lds_byte(wr * 64 + fr, fq * 8), boff = lds_byte(wc * 32 + fr, fq * 8);
#define PG8_SA(b, h) (((b) * 2 + (h)) * HTB)
#define PG8_SB(b, h) ((4 + (b) * 2 + (h)) * HTB)
#define PG8_STAGE(bufoff, gbase, voff) do { _Pragma("unroll") for (int _i = 0; _i < 2; ++_i) \
        __builtin_amdgcn_global_load_lds((const unsigned*)((const char*)(gbase) + (voff)[_i]), (PG8_LAS unsigned*)(lds + (bufoff) + ldsw + _i * 8192), 16, 0, 0); } while (0)
#define PG8_LDA(dst, b, h) do { _Pragma("unroll") for (int m = 0; m < 4; ++m) _Pragma("unroll") for (int k = 0; k < 2; ++k) dst[m][k] = *(const PG8_LAS bf16x8*)(lds + PG8_SA(b, h) + aoff + m * 2048 + k * 1024); } while (0)
#define PG8_LDB(dst, b, h) do { _Pragma("unroll") for (int n = 0; n < 2; ++n) _Pragma("unroll") for (int k = 0; k < 2; ++k) dst[n][k] = *(const PG8_LAS bf16x8*)(lds + PG8_SB(b, h) + boff + n * 2048 + k * 1024); } while (0)
#define PG8_MMA(ai, bj, At, Bt) do { __builtin_amdgcn_s_setprio(1); _Pragma("unroll") for (int m = 0; m < 4; ++m) _Pragma("unroll") for (int n = 0; n < 2; ++n) _Pragma("unroll") for (int k = 0; k < 2; ++k) \
        acc[ai][bj][m][n] = __builtin_amdgcn_mfma_f32_16x16x32_bf16(Bt[n][k], At[m][k], acc[ai][bj][m][n], 0, 0, 0); __builtin_amdgcn_s_setprio(0); } while (0)
#define PG8_WAIT_V(n) asm volatile("s_waitcnt vmcnt(" #n ")" ::: "memory")
#define PG8_WAIT_L(n) asm volatile("s_waitcnt lgkmcnt(" #n ")" ::: "memory")
#define PG8_BAR __builtin_amdgcn_s_barrier()
#define PG8_SCHED __builtin_amdgcn_sched_barrier(0)
    Unit cur, nxt; int ui = 0;
    if (!S.next(0, cur)) return;
    f32x4 acc[2][2][4][2];
#pragma unroll
    for (int a = 0; a < 2; ++a)
#pragma unroll
        for (int b = 0; b < 2; ++b)
#pragma unroll
            for (int m = 0; m < 4; ++m)
#pragma unroll
                for (int n = 0; n < 2; ++n) acc[a][b][m][n] = (f32x4){0.f, 0.f, 0.f, 0.f};
    bf16x8 At[4][2], B0[2][2], B1[2][2];
    const char* cA = (const char*)g.A + (size_t)cur.pm * tstep; const char* cB = (const char*)g.Bt + (size_t)cur.pn * tstep;
    S.a_ready(cur);
    if constexpr (SP2) {
        PG8_STAGE(PG8_SB(0, 0), cB, voffB); PG8_STAGE(PG8_SB(0, 1), cB + hstep, voffB); PG8_STAGE(PG8_SA(0, 0), cA, voffA); PG8_STAGE(PG8_SA(0, 1), cA + hstep, voffA);
        if (wr == 1) PG8_BAR;
        PG8_WAIT_V(2); PG8_BAR;
        PG8_STAGE(PG8_SB(1, 0), cB + kstep, voffB); PG8_STAGE(PG8_SA(1, 0), cA + kstep, voffA); PG8_STAGE(PG8_SB(1, 1), cB + hstep + kstep, voffB);
        PG8_WAIT_V(6); PG8_BAR;
    } else {
        PG8_STAGE(PG8_SB(0, 0), cB, voffB); PG8_STAGE(PG8_SA(0, 0), cA, voffA); PG8_STAGE(PG8_SB(0, 1), cB + hstep, voffB); PG8_STAGE(PG8_SA(0, 1), cA + hstep, voffA);
        if (wr == 1) PG8_BAR;
        PG8_WAIT_V(4); PG8_BAR;
        PG8_STAGE(PG8_SB(1, 0), cB + kstep, voffB); PG8_STAGE(PG8_SA(1, 0), cA + kstep, voffA); PG8_STAGE(PG8_SB(1, 1), cB + hstep + kstep, voffB);
        PG8_WAIT_V(6); PG8_BAR;
    }
    for (;;) {
        const bool has_next = S.next(ui + 1, nxt);
        const char* nA = has_next ? (const char*)g.A + (size_t)nxt.pm * tstep : cA; const char* nB = has_next ? (const char*)g.Bt + (size_t)nxt.pn * tstep : cB;
        for (int t = 0; t < nt; t += 2) {
            const bool last = (t == nt - 2);
            const char* a1 = cA + (size_t)(t + 1) * kstep;
            const char* a2 = last ? nA : cA + (size_t)(t + 2) * kstep; const char* b2 = last ? nB : cB + (size_t)(t + 2) * kstep;
            const char* a3 = a2 + kstep; const char* b3 = b2 + kstep;
            if (last && has_next) S.a_ready(nxt);
            if constexpr (SP2) {
            PG8_LDB(B0, 0, 0); PG8_LDB(B1, 0, 1); PG8_SCHED; PG8_LDA(At, 0, 0); PG8_STAGE(PG8_SA(1, 1), a1 + hstep, voffA);
            PG8_WAIT_V(8); PG8_WAIT_L(0); PG8_BAR; PG8_MMA(0, 0, At, B0); PG8_MMA(0, 1, At, B1); PG8_BAR; PG8_SCHED;
            PG8_LDA(At, 0, 1); PG8_STAGE(PG8_SB(0, 0), b2, voffB); PG8_STAGE(PG8_SB(0, 1), b2 + hstep, voffB); PG8_STAGE(PG8_SA(0, 0), a2, voffA);
            PG8_WAIT_V(8); PG8_WAIT_L(0); PG8_BAR; PG8_MMA(1, 0, At, B0); PG8_MMA(1, 1, At, B1); PG8_BAR; PG8_SCHED;
            PG8_LDB(B0, 1, 0); PG8_LDB(B1, 1, 1); PG8_SCHED; PG8_LDA(At, 1, 0); PG8_STAGE(PG8_SA(0, 1), a2 + hstep, voffA);
            PG8_WAIT_V(8); PG8_WAIT_L(0); PG8_BAR; PG8_MMA(0, 0, At, B0); PG8_MMA(0, 1, At, B1); PG8_BAR; PG8_SCHED;
            PG8_LDA(At, 1, 1); PG8_STAGE(PG8_SB(1, 0), b3, voffB); PG8_STAGE(PG8_SB(1, 1), b3 + hstep, voffB); PG8_STAGE(PG8_SA(1, 0), a3, voffA);
            PG8_WAIT_V(8); PG8_WAIT_L(0); PG8_BAR; PG8_MMA(1, 0, At, B0); PG8_MMA(1, 1, At, B1); PG8_BAR; PG8_SCHED;
            } else {
            PG8_LDB(B0, 0, 0); PG8_SCHED; PG8_LDA(At, 0, 0); PG8_STAGE(PG8_SA(1, 1), a1 + hstep, voffA);
            PG8_WAIT_L(8); PG8_BAR; PG8_WAIT_L(0); PG8_MMA(0, 0, At, B0); PG8_BAR; PG8_SCHED;
            PG8_LDB(B1, 0, 1); PG8_STAGE(PG8_SB(0, 0), b2, voffB);
            PG8_BAR; PG8_WAIT_L(0); PG8_MMA(0, 1, At, B1); PG8_BAR;
            PG8_LDA(At, 0, 1); PG8_STAGE(PG8_SA(0, 0), a2, voffA);
            PG8_BAR; PG8_WAIT_L(0); PG8_MMA(1, 0, At, B0); PG8_BAR; PG8_SCHED;
            PG8_STAGE(PG8_SB(0, 1), b2 + hstep, voffB);
            PG8_WAIT_V(6); PG8_BAR; PG8_MMA(1, 1, At, B1); PG8_BAR;
            PG8_LDB(B0, 1, 0); PG8_SCHED; PG8_LDA(At, 1, 0); PG8_STAGE(PG8_SA(0, 1), a2 + hstep, voffA);
            PG8_WAIT_L(8); PG8_BAR; PG8_WAIT_L(0); PG8_MMA(0, 0, At, B0); PG8_BAR; PG8_SCHED;
            PG8_LDB(B1, 1, 1); PG8_STAGE(PG8_SB(1, 0), b3, voffB);
            PG8_BAR; PG8_WAIT_L(0); PG8_MMA(0, 1, At, B1); PG8_BAR;
            PG8_LDA(At, 1, 1); PG8_STAGE(PG8_SA(1, 0), a3, voffA);
            PG8_BAR; PG8_WAIT_L(0); PG8_MMA(1, 0, At, B0); PG8_BAR; PG8_SCHED;
            PG8_STAGE(PG8_SB(1, 1), b3 + hstep, voffB);
            PG8_WAIT_V(6); PG8_BAR; PG8_MMA(1, 1, At, B1); PG8_BAR;
            }
        }
        if constexpr (ALIGN_EPI) { if (wr == 0) PG8_BAR; }
        if constexpr (!Epi::AFTER_DRAIN) { E(acc, cur, wr, wc, fr, fq); S.done(cur); }
        if (!has_next) break;
#pragma unroll
        for (int a = 0; a < 2; ++a)
#pragma unroll
            for (int b = 0; b < 2; ++b)
#pragma unroll
                for (int m = 0; m < 4; ++m)
#pragma unroll
                    for (int n = 0; n < 2; ++n) acc[a][b][m][n] = (f32x4){0.f, 0.f, 0.f, 0.f};
        cur = nxt; cA = nA; cB = nB; ++ui;
        if constexpr (ALIGN_EPI) { if (wr == 1) PG8_BAR; }
    }
    PG8_WAIT_V(0);
    if constexpr (!ALIGN_EPI) { if (wr == 0) PG8_BAR; }
    PG8_BAR;
    if constexpr (Epi::AFTER_DRAIN) { E.fused(acc, cur, wr, wc, fr, fq, lds, wid, lane); S.done(cur); }
#undef PG8_SA
#undef PG8_SB
#undef PG8_STAGE
#undef PG8_LDA
#undef PG8_LDB
#undef PG8_MMA
#undef PG8_WAIT_V
#undef PG8_WAIT_L
#undef PG8_BAR
#undef PG8_SCHED
}
}

constexpr int BATCH = 16, T = 4096, D = 1024, M = BATCH * T, NQKV = 3072, FF = 2816, NGU = 2 * FF;
constexpr float RMS_EPS = 1e-6f, SUBLN_EPS = 1e-5f;
constexpr float LOG2E = 1.4426950408889634f;
constexpr float QSCALE = 0.125f * LOG2E;
constexpr float LAM_INIT = 0.35550906f;

#define LAS __attribute__((address_space(3)))
typedef unsigned short bf16_t;
typedef short bf16x8 __attribute__((ext_vector_type(8)));
typedef short s16x4 __attribute__((ext_vector_type(4)));
typedef float f32x4 __attribute__((ext_vector_type(4)));
typedef float f32x16 __attribute__((ext_vector_type(16)));
typedef unsigned u32x4 __attribute__((ext_vector_type(4)));
typedef unsigned u32x2 __attribute__((ext_vector_type(2)));

__device__ __forceinline__ unsigned cvtpk(float lo, float hi) { unsigned r; asm volatile("v_cvt_pk_bf16_f32 %0, %1, %2" : "=v"(r) : "v"(lo), "v"(hi)); return r; }
__device__ __forceinline__ float sx(float v, int mask, int lane) { return __int_as_float(__builtin_amdgcn_ds_bpermute((lane ^ mask) << 2, __float_as_int(v))); }
__device__ __forceinline__ float bf2f(unsigned short u) { return __uint_as_float((unsigned)u << 16); }

namespace pg8 {
__device__ __forceinline__ float row_rs(const float* ss, int row, int fq, int fr) {
#ifdef TRIV_EPI
    return 1.0f;
#endif
    const f32x4 a = *(const f32x4*)(ss + (size_t)row * 16 + 4 * fq);
    float s = (a[0] + a[1]) + (a[2] + a[3]);
    const int ln = fq * 16 + fr; s += sx(s, 16, ln); s += sx(s, 32, ln);
    return 1.0f / sqrtf(s * (1.0f / D) + RMS_EPS);
}
struct EpiScaleBf16 {
    static constexpr bool PERM = true, AFTER_DRAIN = false;
    bf16_t* O; int ldc; const float* ss; unsigned qmask;
    float* kn2;
    __device__ __forceinline__ void operator()(const f32x4 (&acc)[2][2][4][2], const Unit& u, int wr, int wc, int fr, int fq) const {
        const int row0 = u.pm * BM + wr * 64 + fr, col0 = u.pn * BM + wc * 32 + 8 * fq;
        const float qs = ((qmask >> u.pn) & 1u) ? QSCALE : 1.0f;
        const bool kt = kn2 != nullptr && u.pn >= 4 && u.pn < 8;
        const int ln = fq * 16 + fr;
        float km[2][2] = {{0.f, 0.f}, {0.f, 0.f}};
#pragma unroll
        for (int ai = 0; ai < 2; ++ai)
#pragma unroll
            for (int m = 0; m < 4; ++m) { const int row = row0 + ai * HALF + m * 16; const float rs = row_rs(ss, row, fq, fr) * qs;
                bf16_t* rowp = O + (size_t)row * ldc + col0;
#pragma unroll
                for (int bj = 0; bj < 2; ++bj) { const f32x4 v0 = acc[ai][bj][m][0] * rs, v1 = acc[ai][bj][m][1] * rs;
                    u32x4 w; w.x = cvt_pk_bf16(v0[0], v0[1]); w.y = cvt_pk_bf16(v0[2], v0[3]); w.z = cvt_pk_bf16(v1[0], v1[1]); w.w = cvt_pk_bf16(v1[2], v1[3]);
                    *(u32x4*)(rowp + bj * HALF) = w;
                    if (kt) { float s8 = 0.f;
#pragma unroll
                        for (int e = 0; e < 4; ++e) { const unsigned ww = e == 0 ? w.x : (e == 1 ? w.y : (e == 2 ? w.z : w.w)); const float lo_ = __uint_as_float(ww << 16), hi_ = __uint_as_float(ww & 0xffff0000u);
                            s8 = fmaf(lo_, lo_, s8); s8 = fmaf(hi_, hi_, s8); }
                        s8 += sx(s8, 16, ln); s8 += sx(s8, 32, ln);
                        km[ai][bj] = fmaxf(km[ai][bj], s8); } }
                if (m & 1) asm volatile("" ::: "memory"); }
        if (kt) {
#pragma unroll
            for (int ai = 0; ai < 2; ++ai)
#pragma unroll
                for (int bj = 0; bj < 2; ++bj) { float v = km[ai][bj];
                    v = fmaxf(v, sx(v, 1, ln)); v = fmaxf(v, sx(v, 2, ln)); v = fmaxf(v, sx(v, 4, ln)); v = fmaxf(v, sx(v, 8, ln));
                    const int rt = u.pm * BM + ai * HALF + wr * 64, bb = rt >> 12, tile = (rt & 4095) >> 6, head = (u.pn - 4) * 2 + bj;
                    if (ln == 0) kn2[((((bb * 8 + head) * 2 + (wc >> 1)) * 64 + tile) << 1) + (wc & 1)] = v; }
        }
    }
};
struct EpiSwiGLU {
    static constexpr bool PERM = true, AFTER_DRAIN = false;
    bf16_t* H; const float* ss;
    __device__ __forceinline__ void operator()(const f32x4 (&acc)[2][2][4][2], const Unit& u, int wr, int wc, int fr, int fq) const {
        const int row0 = u.pm * BM + wr * 64 + fr, col0 = u.pn * HALF + wc * 32 + 8 * fq;
#pragma unroll
        for (int ai = 0; ai < 2; ++ai)
#pragma unroll
            for (int m = 0; m < 4; ++m) { const int row = row0 + ai * HALF + m * 16; const float rs = row_rs(ss, row, fq, fr);
                float o[8];
#pragma unroll
                for (int n = 0; n < 2; ++n)
#pragma unroll
                    for (int e = 0; e < 4; ++e) { const float g = acc[ai][0][m][n][e] * rs, up = acc[ai][1][m][n][e] * rs;
                        o[n * 4 + e] = g * __builtin_amdgcn_rcpf(1.0f + __builtin_amdgcn_exp2f(-g * LOG2E)) * up; }
                u32x4 w; w.x = cvt_pk_bf16(o[0], o[1]); w.y = cvt_pk_bf16(o[2], o[3]); w.z = cvt_pk_bf16(o[4], o[5]); w.w = cvt_pk_bf16(o[6], o[7]);
                *(u32x4*)(H + (size_t)row * FF + col0) = w;
                if (m & 1) asm volatile("" ::: "memory"); }
    }
};
struct EpiResid {
    static constexpr bool PERM = true, AFTER_DRAIN = false;
    const float* bf; float* of; bf16_t* hi; bf16_t* lo; float* ss;
    __device__ __forceinline__ void operator()(const f32x4 (&acc)[2][2][4][2], const Unit& u, int wr, int wc, int fr, int fq) const {
        const int row0 = u.pm * BM + wr * 64 + fr, col0 = u.pn * BM + wc * 32 + 8 * fq;
#pragma unroll
        for (int ai = 0; ai < 2; ++ai)
#pragma unroll
            for (int m = 0; m < 4; ++m) { const int row = row0 + ai * HALF + m * 16; const size_t off = (size_t)row * D + col0; float sq = 0.f;
#pragma unroll
                for (int bj = 0; bj < 2; ++bj) { const size_t o2 = off + bj * HALF; f32x4 v0, v1;
                    if (bf) { v0 = *(const f32x4*)(bf + o2); v1 = *(const f32x4*)(bf + o2 + 4); }
                    else { const u32x4 h = *(const u32x4*)(hi + o2), l = *(const u32x4*)(lo + o2);
                        v0[0] = __uint_as_float(h.x << 16) + __uint_as_float(l.x << 16); v0[1] = __uint_as_float(h.x & 0xffff0000u) + __uint_as_float(l.x & 0xffff0000u);
                        v0[2] = __uint_as_float(h.y << 16) + __uint_as_float(l.y << 16); v0[3] = __uint_as_float(h.y & 0xffff0000u) + __uint_as_float(l.y & 0xffff0000u);
                        v1[0] = __uint_as_float(h.z << 16) + __uint_as_float(l.z << 16); v1[1] = __uint_as_float(h.z & 0xffff0000u) + __uint_as_float(l.z & 0xffff0000u);
                        v1[2] = __uint_as_float(h.w << 16) + __uint_as_float(l.w << 16); v1[3] = __uint_as_float(h.w & 0xffff0000u) + __uint_as_float(l.w & 0xffff0000u); }
                    v0 = v0 + acc[ai][bj][m][0]; v1 = v1 + acc[ai][bj][m][1];
                    if (of) { *(f32x4*)(of + o2) = v0; *(f32x4*)(of + o2 + 4) = v1; }
                    else { u32x4 w; w.x = cvt_pk_bf16(v0[0], v0[1]); w.y = cvt_pk_bf16(v0[2], v0[3]); w.z = cvt_pk_bf16(v1[0], v1[1]); w.w = cvt_pk_bf16(v1[2], v1[3]);
                        u32x4 r; r.x = cvt_pk_bf16(v0[0] - __uint_as_float(w.x << 16), v0[1] - __uint_as_float(w.x & 0xffff0000u)); r.y = cvt_pk_bf16(v0[2] - __uint_as_float(w.y << 16), v0[3] - __uint_as_float(w.y & 0xffff0000u));
                        r.z = cvt_pk_bf16(v1[0] - __uint_as_float(w.z << 16), v1[1] - __uint_as_float(w.z & 0xffff0000u)); r.w = cvt_pk_bf16(v1[2] - __uint_as_float(w.w << 16), v1[3] - __uint_as_float(w.w & 0xffff0000u));
                        *(u32x4*)(hi + o2) = w; *(u32x4*)(lo + o2) = r; }
                    sq += ((v0[0] * v0[0] + v0[1] * v0[1]) + (v0[2] * v0[2] + v0[3] * v0[3])) + ((v1[0] * v1[0] + v1[1] * v1[1]) + (v1[2] * v1[2] + v1[3] * v1[3])); }
                { const int ln = fq * 16 + fr; sq += sx(sq, 16, ln); sq += sx(sq, 32, ln); }
                if (fq == 0) ss[(size_t)row * 16 + u.pn * 4 + wc] = sq;
                asm volatile("" ::: "memory"); }
    }
};
}

namespace at {
constexpr float THR = 8.0f;
__device__ __forceinline__ int crow(int r, int hi) { return (r & 3) + 8 * (r >> 2) + 4 * hi; }
template <int NB> __device__ __forceinline__ int v_st(int k, int c) { const int kk = (k & ~0xC) | ((k & 4) << 1) | ((k & 8) >> 1); return ((kk >> 3) * NB + (c >> 5)) * 512 + ((kk & 7) * 32 + (c & 31)) * 2; }
__device__ __forceinline__ int v_rd_base(int lane) { return ((lane & 3) << 3) | (((lane >> 2) & 3) << 6) | (((lane >> 4) & 1) << 5) | (((lane >> 5) & 1) << 8); }
template <int NB> constexpr int v_rd_off(int d0, int ks, int half) { return d0 * 512 + ks * (NB * 1024) + half * (NB * 512); }
template <int OFF> __device__ __forceinline__ s16x4 tr_read(int vb) { s16x4 r; asm volatile("ds_read_b64_tr_b16 %0, %1 offset:%2" : "=&v"(r) : "v"(vb), "i"(OFF) : "memory"); return r; }
template <int NB, int D0> __device__ __forceinline__ void pv_one(f32x16& od, int vb, bf16x8 pa0, bf16x8 pa1, bf16x8 pa2, bf16x8 pa3) {
    const s16x4 l0 = tr_read<v_rd_off<NB>(D0, 0, 0)>(vb), h0 = tr_read<v_rd_off<NB>(D0, 0, 1)>(vb), l1 = tr_read<v_rd_off<NB>(D0, 1, 0)>(vb), h1 = tr_read<v_rd_off<NB>(D0, 1, 1)>(vb);
    const s16x4 l2 = tr_read<v_rd_off<NB>(D0, 2, 0)>(vb), h2 = tr_read<v_rd_off<NB>(D0, 2, 1)>(vb), l3 = tr_read<v_rd_off<NB>(D0, 3, 0)>(vb), h3 = tr_read<v_rd_off<NB>(D0, 3, 1)>(vb);
    asm volatile("s_waitcnt lgkmcnt(0)" ::: "memory"); __builtin_amdgcn_sched_barrier(0);
#define AT_PK(L, H) (bf16x8){L[0], L[1], L[2], L[3], H[0], H[1], H[2], H[3]}
    od = __builtin_amdgcn_mfma_f32_32x32x16_bf16(pa0, AT_PK(l0, h0), od, 0, 0, 0);
    od = __builtin_amdgcn_mfma_f32_32x32x16_bf16(pa1, AT_PK(l1, h1), od, 0, 0, 0);
    od = __builtin_amdgcn_mfma_f32_32x32x16_bf16(pa2, AT_PK(l2, h2), od, 0, 0, 0);
    od = __builtin_amdgcn_mfma_f32_32x32x16_bf16(pa3, AT_PK(l3, h3), od, 0, 0, 0);
#undef AT_PK
}
__device__ __forceinline__ float slope_of(int h) { return __builtin_amdgcn_exp2f(-(float)(h + 1)); }

constexpr int L_SCR = 65536, L_TBL = 67584, L_X = 69632;

struct Ptrs { const bf16_t* qkv; bf16_t* att; bf16_t* obr; float* lse; const float* rpb; const float* subln; float lam; const float* kn; };

struct PolDil {
    static constexpr int W = 64, KIND = 0;
    int b, h, br, dil, res, qs0, tlo, thi; float nsl;
    __device__ __forceinline__ void init(int u) {
        br = u >> 11; const int v = u & 2047, sub = v & 15, bh = v >> 4; b = bh >> 3; h = bh & 7;
        dil = br == 0 ? 1 : (br == 1 ? 4 : 16); const int L = T / dil, nqb = L / 256;
        res = sub / nqb; qs0 = (sub % nqb) * 256;
        tlo = qs0 > 0 ? 0 : 1; thi = (qs0 + 256 < L) ? 6 : 5;
        nsl = -slope_of(h) * (float)dil * LOG2E;
    }
    __device__ __forceinline__ long qtok(int wid, int i) const { return (long)b * T + res + dil * (qs0 + 32 * wid + i); }
    __device__ __forceinline__ int qcol(int) const { return h * 64; }
    __device__ __forceinline__ int kcol0() const { return 512 + h * 64; }
    __device__ __forceinline__ int vcol0() const { return 1024 + h * 64; }
    __device__ __forceinline__ int kfrag(int) const { return 0; }
    __device__ __forceinline__ long ktok(int t, int row) const { return (long)b * T + res + dil * (qs0 - 64 + 64 * t + row); }
    __device__ __forceinline__ bool need(int t, int wid) const { return (64 * t - 64 <= 32 * wid + 95) && (64 * t - 1 >= 32 * wid - 64); }
    __device__ __forceinline__ void cinit(f32x16& p0, f32x16& p1, int t, int wid, int r32, int hi, const LAS float*, float m) const {
        const float base = (float)(32 * wid + r32 + 64 - 64 * t - 4 * hi);
#pragma unroll
        for (int r = 0; r < 16; ++r) { const float c = (float)((r & 3) + 8 * (r >> 2));
            const float a0 = fabsf(base - c), a1 = fabsf(base - (c + 32.f));
            p0[r] = a0 <= 64.f ? nsl * a0 - m : -INFINITY; p1[r] = a1 <= 64.f ? nsl * a1 - m : -INFINITY; }
    }
};
struct PolNat {
    static constexpr int W = 64, KIND = 1;
    int b, h, qb, r0, kr0, tlo, thi;
    __device__ __forceinline__ static int clip(int v, int lo, int hi_) { return v < lo ? lo : (v > hi_ ? hi_ : v); }
    __device__ __forceinline__ void init(int u) {
        qb = u & 15; const int bh = u >> 4; b = bh >> 3; h = bh & 7; r0 = 4 * qb;
        kr0 = clip(r0 - 4, 0, 56); tlo = 0; thi = clip(r0 - 1, 0, 56) + 8 - kr0;
    }
    __device__ __forceinline__ long qtok(int wid, int i) const { return (long)b * T + 256 * qb + 32 * wid + i; }
    __device__ __forceinline__ int qcol(int) const { return 1536 + h * 64; }
    __device__ __forceinline__ int kcol0() const { return 2048 + h * 64; }
    __device__ __forceinline__ int vcol0() const { return 2560 + h * 64; }
    __device__ __forceinline__ int kfrag(int) const { return 0; }
    __device__ __forceinline__ long ktok(int t, int row) const { return (long)b * T + 64 * (kr0 + t) + row; }
    __device__ __forceinline__ bool need(int t, int wid) const { const int r = r0 + (wid >> 1), rs = clip(r - 4, 0, 56), kr = kr0 + t; return kr >= rs && kr < rs + 8; }
    __device__ __forceinline__ void cinit(f32x16& p0, f32x16& p1, int t, int wid, int r32, int hi, const LAS float* tbl, float m) const {
        const int r = r0 + (wid >> 1), kr = kr0 + t, c = 32 * (wid & 1) + r32, wc = clip(c - 8, 0, 48);
        const LAS float* trow = tbl + (kr - r + 7) * 32;
#pragma unroll
        for (int q = 0; q < 16; ++q) { const int k0 = (q & 3) + 8 * (q >> 2) + 4 * hi, k1 = k0 + 32;
            const float v0 = trow[clip(k0 - c + 15, 0, 30)], v1 = trow[clip(k1 - c + 15, 0, 30)];
            p0[q] = ((unsigned)(k0 - wc) < 16u) ? v0 - m : -INFINITY; p1[q] = ((unsigned)(k1 - wc) < 16u) ? v1 - m : -INFINITY; }
    }
};
struct PolDiff {
    static constexpr int W = 128, KIND = 2;
    int b, h, qb, tlo, thi; float nsl;
    __device__ __forceinline__ void init(int u) { const int k = u >> 8, c0 = u & 255, c = (c0 & 7) * 32 + (c0 >> 3)  , r = (k >> 3) * 256 + c; h = k & 7; b = r >> 5; qb = r & 31; tlo = 0; thi = T / 64; nsl = -slope_of(h) * LOG2E; }
    __device__ __forceinline__ long qtok(int wid, int i) const { return (long)b * T + 128 * qb + 32 * (wid & 3) + i; }
    __device__ __forceinline__ int qcol(int wid) const { return h * 128 + 64 * (wid >> 2); }
    __device__ __forceinline__ int kcol0() const { return 1024 + h * 128; }
    __device__ __forceinline__ int vcol0() const { return 2048 + h * 128; }
    __device__ __forceinline__ int kfrag(int wid) const { return 64 * (wid >> 2); }
    __device__ __forceinline__ long ktok(int t, int row) const { return (long)b * T + 64 * t + row; }
    __device__ __forceinline__ bool need(int, int) const { return true; }
    template <int BLK> __device__ __forceinline__ void cinit_off(f32x16& p, int t, int wid, int r32, int hi) const {
        const float base = (float)(128 * qb + 32 * (wid & 3) + r32 - 64 * t - 4 * hi - 32 * BLK);
        const float sn = t < 2 * qb ? nsl : -nsl, A = sn * base, cf = -sn;
#pragma unroll
        for (int r = 0; r < 16; ++r) p[r] = fmaf(cf, (float)((r & 3) + 8 * (r >> 2)), A);
    }
    template <int BLK> __device__ __forceinline__ void cinit_abs(f32x16& p, int t, int wid, int r32, int hi) const {
        const float base = (float)(128 * qb + 32 * (wid & 3) + r32 - 64 * t - 4 * hi - 32 * BLK);
#pragma unroll
        for (int r = 0; r < 16; ++r) p[r] = nsl * fabsf(base - (float)((r & 3) + 8 * (r >> 2)));
    }
    __device__ __forceinline__ void cinit(f32x16& p0, f32x16& p1, int t, int wid, int r32, int hi, const LAS float*, float m) const {
        const int i0 = 128 * qb + 32 * (wid & 3);
        const float base = (float)(i0 + r32 - 64 * t - 4 * hi);
        if (64 * t + 63 < i0) {
            const float A = nsl * base - m, n2 = -nsl;
#pragma unroll
            for (int r = 0; r < 16; ++r) { const float c = (float)((r & 3) + 8 * (r >> 2)); p0[r] = fmaf(n2, c, A); p1[r] = fmaf(n2, c + 32.f, A); }
        } else if (64 * t > i0 + 31) {
            const float A = -nsl * base - m;
#pragma unroll
            for (int r = 0; r < 16; ++r) { const float c = (float)((r & 3) + 8 * (r >> 2)); p0[r] = fmaf(nsl, c, A); p1[r] = fmaf(nsl, c + 32.f, A); }
        } else {
#pragma unroll
            for (int r = 0; r < 16; ++r) { const float c = (float)((r & 3) + 8 * (r >> 2));
                p0[r] = nsl * fabsf(base - c) - m; p1[r] = nsl * fabsf(base - (c + 32.f)) - m; }
        }
    }
};

template <class Pol> __device__ __forceinline__ void attn_unit(const Pol& P, LAS unsigned char* lds, const Ptrs& X, bf16x8& pq0, bf16x8& pq1, bf16x8& pq2, bf16x8& pq3, bf16x8& pk_, bf16x8& pv_, bool have, const Pol& Pn, bool hasn);
template <class Pol>
__device__ __forceinline__ void attn_unit(const Pol& P, LAS unsigned char* lds, const Ptrs& X, bf16x8& pq0, bf16x8& pq1, bf16x8& pq2, bf16x8& pq3, bf16x8& pk_, bf16x8& pv_, bool have, const Pol& Pn, bool hasn) {
    constexpr int W = Pol::W, NB = W / 32, CH = W / 64, KBYTES = 64 * W * 2, VBYTES = KBYTES, CPR = W / 8;
    int tid_ = threadIdx.x; asm volatile("" : "+v"(tid_));
    const int tid = tid_, wid = __builtin_amdgcn_readfirstlane(tid >> 6), lane = tid & 63, r32 = lane & 31, hi = lane >> 5;
    LAS unsigned char* K_lds = lds; LAS unsigned char* V_lds = lds + 2 * KBYTES;
    LAS float* li_l = (LAS float*)(lds + L_SCR) + wid * 64; LAS float* al_l = li_l + 32;
    LAS float* tbl = (LAS float*)(lds + L_TBL);
    const bf16_t* qkv = X.qkv;
    if constexpr (Pol::KIND == 1) { if (tid < 480) { const int row = tid >> 5, col = tid & 31; tbl[tid] = col < 31 ? X.rpb[(P.h * 15 + row) * 31 + col] * LOG2E : 0.f; } }
    bf16x8 qr[4];
    const bool pre_ok = Pol::KIND == 0 && have;
    if (pre_ok) {
        qr[0] = pq0; qr[1] = pq1; qr[2] = pq2; qr[3] = pq3;
    } else { const bf16_t* qp = qkv + P.qtok(wid, r32) * NQKV + P.qcol(wid) + hi * 8;
#pragma unroll
      for (int d0 = 0; d0 < 4; ++d0) qr[d0] = *(const bf16x8*)(qp + d0 * 16); }
    const int kfb = P.kfrag(wid) * 2;
    bf16x8 ks[CH], vs[CH];
#define AT_SLOAD(t) do { _Pragma("unroll") for (int i_ = 0; i_ < CH; ++i_) { const int id_ = tid + 512 * i_, row_ = id_ / CPR, col_ = (id_ % CPR) * 8; \
        const bf16_t* g_ = qkv + P.ktok((t), row_) * NQKV + col_; ks[i_] = *(const bf16x8*)(g_ + P.kcol0()); vs[i_] = *(const bf16x8*)(g_ + P.vcol0()); } } while (0)
#define AT_SWRITE(b) do { _Pragma("unroll") for (int i_ = 0; i_ < CH; ++i_) { const int id_ = tid + 512 * i_, row_ = id_ / CPR, col_ = (id_ % CPR) * 8; \
        *(LAS bf16x8*)(K_lds + (b) * KBYTES + row_ * (W * 2) + ((col_ * 2) ^ ((row_ & 7) << 4))) = ks[i_]; \
        *(LAS bf16x8*)(V_lds + (b) * VBYTES + v_st<NB>(row_, col_)) = vs[i_]; } } while (0)
    float m_reg = 0.f, l_reg = 0.f; f32x16 o[NB];
#pragma unroll
    for (int d = 0; d < NB; ++d) o[d] = f32x16{};
    const int vb0 = (int)(unsigned)(size_t)V_lds + v_rd_base(lane);
    const int tlo = P.tlo, thi = P.thi;
    if (pre_ok) { ks[0] = pk_; vs[0] = pv_; } else AT_SLOAD(tlo);
    AT_SWRITE(tlo & 1); __syncthreads();
    for (int t = tlo; t < thi; ++t) {
        const int buf = t & 1;
        if constexpr (Pol::KIND != 2) { if (t + 1 < thi) AT_SLOAD(t + 1); }
        if constexpr (Pol::KIND == 0) { if (t + 1 == thi && hasn) {
            const bf16_t* qp = qkv + Pn.qtok(wid, r32) * NQKV + Pn.qcol(wid) + hi * 8;
            pq0 = *(const bf16x8*)(qp); pq1 = *(const bf16x8*)(qp + 16); pq2 = *(const bf16x8*)(qp + 32); pq3 = *(const bf16x8*)(qp + 48);
            const int row_ = tid / CPR, col_ = (tid % CPR) * 8; const bf16_t* g_ = qkv + Pn.ktok(Pn.tlo, row_) * NQKV + col_;
            pk_ = *(const bf16x8*)(g_ + Pn.kcol0()); pv_ = *(const bf16x8*)(g_ + Pn.vcol0()); } }
        if (P.need(t, wid)) {
            f32x16 p0, p1;
            P.cinit(p0, p1, t, wid, r32, hi, tbl, m_reg);
            const LAS unsigned char* Kb = K_lds + buf * KBYTES;
#pragma unroll
            for (int d0 = 0; d0 < 4; ++d0) { const int cb = kfb + (d0 * 16 + hi * 8) * 2, sw = cb ^ ((r32 & 7) << 4);
                const bf16x8 b0 = *(const LAS bf16x8*)(Kb + r32 * (W * 2) + sw);
                const bf16x8 b1 = *(const LAS bf16x8*)(Kb + (32 + r32) * (W * 2) + sw);
                p0 = __builtin_amdgcn_mfma_f32_32x32x16_bf16(b0, qr[d0], p0, 0, 0, 0);
                p1 = __builtin_amdgcn_mfma_f32_32x32x16_bf16(b1, qr[d0], p1, 0, 0, 0); }
            float pmax = fmaxf(p0[0], p1[0]);
#pragma unroll
            for (int r = 1; r < 16; ++r) pmax = fmaxf(fmaxf(pmax, p0[r]), p1[r]);
            { auto rr = __builtin_amdgcn_permlane32_swap(__float_as_uint(pmax), __float_as_uint(pmax), false, false);
              pmax = fmaxf(__uint_as_float(rr[0]), __uint_as_float(rr[1])); }
            float alpha = 1.f;
            if (__builtin_expect(!__all(pmax <= THR), 0)) {
                const float dm = fmaxf(pmax, 0.f); alpha = __builtin_amdgcn_exp2f(-dm); m_reg += dm;
#pragma unroll
                for (int r = 0; r < 16; ++r) { p0[r] -= dm; p1[r] -= dm; }
            }
            float ps = 0.f;
#pragma unroll
            for (int r = 0; r < 16; ++r) { p0[r] = __builtin_amdgcn_exp2f(p0[r]); p1[r] = __builtin_amdgcn_exp2f(p1[r]); ps += p0[r] + p1[r]; }
            { auto rr = __builtin_amdgcn_permlane32_swap(__float_as_uint(ps), __float_as_uint(ps), false, false);
              ps = __uint_as_float(rr[0]) + __uint_as_float(rr[1]); }
            l_reg = l_reg * alpha + ps;
            if (__any(alpha < 1.f)) { if (hi == 0) al_l[r32] = alpha; asm volatile("s_waitcnt lgkmcnt(0)" ::: "memory");
#pragma unroll
                for (int r = 0; r < 16; ++r) { const float a = al_l[crow(r, hi)];
#pragma unroll
                    for (int d = 0; d < NB; ++d) o[d][r] *= a; }
                asm volatile("s_waitcnt lgkmcnt(0)" ::: "memory"); }
            bf16x8 pa0, pa1, pa2, pa3;
#define AT_PK4(PP, BASE, OUT) do { unsigned a0 = cvtpk(PP[BASE + 0], PP[BASE + 1]), a1 = cvtpk(PP[BASE + 2], PP[BASE + 3]); \
    unsigned b0_ = cvtpk(PP[BASE + 4], PP[BASE + 5]), b1_ = cvtpk(PP[BASE + 6], PP[BASE + 7]); \
    auto r0_ = __builtin_amdgcn_permlane32_swap(a0, b0_, false, false); auto r1_ = __builtin_amdgcn_permlane32_swap(a1, b1_, false, false); \
    u32x4 w_ = {r0_[0], r1_[0], r0_[1], r1_[1]}; OUT = *reinterpret_cast<bf16x8*>(&w_); } while (0)
            AT_PK4(p0, 0, pa0); AT_PK4(p0, 8, pa1); AT_PK4(p1, 0, pa2); AT_PK4(p1, 8, pa3);
#undef AT_PK4
            const int vb = vb0 + buf * VBYTES;
            pv_one<NB, 0>(o[0], vb, pa0, pa1, pa2, pa3); pv_one<NB, 1>(o[1], vb, pa0, pa1, pa2, pa3);
            if constexpr (NB == 4) { pv_one<NB, 2>(o[2], vb, pa0, pa1, pa2, pa3); pv_one<NB, 3>(o[3], vb, pa0, pa1, pa2, pa3); }
        }
        if (t + 1 < thi) { if constexpr (Pol::KIND == 2) AT_SLOAD(t + 1); AT_SWRITE(buf ^ 1); }
        __syncthreads();
    }
#undef AT_SLOAD
#undef AT_SWRITE
    if (hi == 0) li_l[r32] = l_reg;
    asm volatile("s_waitcnt lgkmcnt(0)" ::: "memory");
    float rli[16];
#pragma unroll
    for (int r = 0; r < 16; ++r) rli[r] = __builtin_amdgcn_rcpf(li_l[crow(r, hi)]);
    if constexpr (Pol::KIND == 0) {
        bf16_t* ob = X.obr + (size_t)P.br * ((size_t)M * 512);
#pragma unroll
        for (int r = 0; r < 16; ++r) { const long tok = P.qtok(wid, crow(r, hi));
#pragma unroll
            for (int d = 0; d < NB; ++d) ob[tok * 512 + P.h * 64 + d * 32 + r32] = (bf16_t)(cvtpk(o[d][r] * rli[r], 0.f) & 0xffffu); }
        if (hi == 0) X.lse[(size_t)P.br * ((size_t)M * 8) + P.qtok(wid, r32) * 8 + P.h] = m_reg + __builtin_amdgcn_logf(l_reg);
    } else if constexpr (Pol::KIND == 1) {
#pragma unroll
        for (int r = 0; r < 16; ++r) { const long tok = P.qtok(wid, crow(r, hi));
#pragma unroll
            for (int d = 0; d < NB; ++d) X.att[tok * D + 512 + P.h * 64 + d * 32 + r32] = (bf16_t)(cvtpk(o[d][r] * rli[r], 0.f) & 0xffffu); }
    } else {
        LAS float* XB = (LAS float*)(lds + L_X);
        if (wid >= 4) {
#pragma unroll
            for (int r = 0; r < 16; ++r) { const int row = 32 * (wid & 3) + crow(r, hi);
#pragma unroll
                for (int d = 0; d < NB; ++d) XB[row * 128 + d * 32 + r32] = X.lam * o[d][r] * rli[r]; }
        }
        __syncthreads();
        if (wid < 4) {
#pragma unroll
            for (int r = 0; r < 16; ++r) { const int row = 32 * wid + crow(r, hi); float s = 0.f;
#pragma unroll
                for (int d = 0; d < NB; ++d) { const float y = o[d][r] * rli[r] - XB[row * 128 + d * 32 + r32]; o[d][r] = y; s += y * y; }
                s += sx(s, 1, lane); s += sx(s, 2, lane); s += sx(s, 4, lane); s += sx(s, 8, lane); s += sx(s, 16, lane);
                const float rs = (1.0f - LAM_INIT) / sqrtf(s * (1.0f / 128.f) + SUBLN_EPS);
                const long tok = P.qtok(wid, crow(r, hi));
#pragma unroll
                for (int d = 0; d < NB; ++d) X.att[tok * D + P.h * 128 + d * 32 + r32] = (bf16_t)(cvtpk(o[d][r] * rs * X.subln[d * 32 + r32], 0.f) & 0xffffu); }
        }
        __syncthreads();
    }
}

template <class Pol> __device__ __forceinline__ void attn_unit(const Pol& P, LAS unsigned char* lds, const Ptrs& X) { bf16x8 z0_ = {}, z1_ = {}, z2_ = {}, z3_ = {}, z4_ = {}, z5_ = {}; attn_unit(P, lds, X, z0_, z1_, z2_, z3_, z4_, z5_, false, P, false); }
typedef __bf16 bf16x2_t __attribute__((ext_vector_type(2)));
typedef float f32x2_t __attribute__((ext_vector_type(2)));
__device__ __forceinline__ unsigned pk2(float lo, float hi) { const f32x2_t v = {lo, hi}; return __builtin_bit_cast(unsigned, __builtin_convertvector(v, bf16x2_t)); }
__device__ __forceinline__ s16x4 trb(const LAS unsigned char* p) { return __builtin_amdgcn_ds_read_tr16_b64_v4i16((LAS s16x4*)p); }
template <int D0> __device__ __forceinline__ void pv_blk(f32x16& od, const LAS unsigned char* vb, bf16x8 pa0, bf16x8 pa1, bf16x8 pa2, bf16x8 pa3) {
    constexpr int NB = 4;
    const s16x4 l0 = trb(vb + v_rd_off<NB>(D0, 0, 0)), h0 = trb(vb + v_rd_off<NB>(D0, 0, 1)), l1 = trb(vb + v_rd_off<NB>(D0, 1, 0)), h1 = trb(vb + v_rd_off<NB>(D0, 1, 1));
    const s16x4 l2 = trb(vb + v_rd_off<NB>(D0, 2, 0)), h2 = trb(vb + v_rd_off<NB>(D0, 2, 1)), l3 = trb(vb + v_rd_off<NB>(D0, 3, 0)), h3 = trb(vb + v_rd_off<NB>(D0, 3, 1));
#define AT_PK(L, H) (bf16x8){L[0], L[1], L[2], L[3], H[0], H[1], H[2], H[3]}
    od = __builtin_amdgcn_mfma_f32_32x32x16_bf16(pa0, AT_PK(l0, h0), od, 0, 0, 0);
    od = __builtin_amdgcn_mfma_f32_32x32x16_bf16(pa1, AT_PK(l1, h1), od, 0, 0, 0);
    od = __builtin_amdgcn_mfma_f32_32x32x16_bf16(pa2, AT_PK(l2, h2), od, 0, 0, 0);
    od = __builtin_amdgcn_mfma_f32_32x32x16_bf16(pa3, AT_PK(l3, h3), od, 0, 0, 0);
#undef AT_PK
}
constexpr int DF_SCR = 98304;
__device__ __forceinline__ void diff_unit(const PolDiff& P, LAS unsigned char* lds, const Ptrs& X) {
    constexpr int W = 128, NB = 4, CH = 2, KBYTES = 64 * W * 2, VBYTES = KBYTES, NT = T / 64;
    int tid_ = threadIdx.x; asm volatile("" : "+v"(tid_));
    const int tid = tid_, wid = __builtin_amdgcn_readfirstlane(tid >> 6), lane = tid & 63, r32 = lane & 31, hi = lane >> 5;
    LAS unsigned char* K_lds = lds; LAS unsigned char* V_lds = lds + 3 * KBYTES;
    LAS float* li_l = (LAS float*)(lds + DF_SCR) + wid * 64;
    LAS unsigned* flag = (LAS unsigned*)(lds + DF_SCR + 8 * 256);
    const bf16_t* qkv = X.qkv;
    bf16x8 qr[4];
    { const bf16_t* qp = qkv + P.qtok(wid, r32) * NQKV + P.qcol(wid) + hi * 8;
#pragma unroll
      for (int d0 = 0; d0 < 4; ++d0) qr[d0] = *(const bf16x8*)(qp + d0 * 16); }
    const int kfb = P.kfrag(wid) * 2;
    int gko, gvo;
    { const int row = 4 * wid + (lane >> 4), c = (lane & 15) ^ (row & 7); gko = row * NQKV + P.kcol0() + 8 * c; }
    { const int sidx = 2 * wid + (lane >> 5), kk = 8 * (sidx >> 2) + ((lane & 31) >> 2), k = (kk & ~0xC) | ((kk & 4) << 1) | ((kk & 8) >> 1), c = 32 * (sidx & 3) + 8 * (lane & 3);
      gvo = k * NQKV + P.vcol0() + c; }
    const bf16_t* gtile = qkv + (long)P.b * T * NQKV;
    const LAS unsigned char* krd = K_lds + r32 * (W * 2);
    const LAS unsigned char* vrd = V_lds + v_rd_base(lane);
    if (tid == 0) flag[0] = 0u;
    int t_lo, n_tiles;
    { float q2 = 0.f;
#pragma unroll
      for (int d0 = 0; d0 < 4; ++d0)
#pragma unroll
          for (int e = 0; e < 8; ++e) { const float f = bf2f((unsigned short)qr[d0][e]); q2 = fmaf(f, f, q2); }
      q2 += sx(q2, 32, lane);
#pragma unroll
      for (int o_ = 1; o_ < 32; o_ <<= 1) q2 = fmaxf(q2, sx(q2, o_, lane));
      if (lane == 0) li_l[0] = q2;
      __syncthreads();
      float qm1 = 0.f, qm2 = 0.f;
#pragma unroll
      for (int w_ = 0; w_ < 4; ++w_) { qm1 = fmaxf(qm1, ((LAS float*)(lds + DF_SCR))[w_ * 64]); qm2 = fmaxf(qm2, ((LAS float*)(lds + DF_SCR))[(w_ + 4) * 64]); }
      qm1 = sqrtf(qm1) * 1.01f; qm2 = sqrtf(qm2) * 1.01f;
      const float* kn = X.kn + ((P.b * 8 + P.h) * 2) * 128;
      const float k1_ = sqrtf(kn[2 * lane] + kn[2 * lane + 1]) * 1.001f, k2_ = sqrtf(kn[128 + 2 * lane] + kn[128 + 2 * lane + 1]) * 1.001f;
      const float sb = fmaxf(qm1 * k1_, qm2 * k2_);
      const int i0u = 128 * P.qb;
      const int dist = lane < 2 * P.qb ? i0u - (64 * lane + 63) : (lane > 2 * P.qb + 1 ? 64 * lane - (i0u + 127) : 0);
      const bool visit = sb + P.nsl * (float)dist > -152.f;
      const unsigned long long mask = __ballot(visit) | (3ull << (2 * P.qb));
      int lo = __builtin_ctzll(mask), hi_t = 63 - __builtin_clzll(mask);
      if (((hi_t - lo + 1) & 1) != 0) { if (lo > 0) --lo; else ++hi_t; }
      if (hi_t - lo + 1 < 4) { if (lo > 1) lo -= 2; else hi_t += 2; }
      t_lo = __builtin_amdgcn_readfirstlane(lo); n_tiles = __builtin_amdgcn_readfirstlane(hi_t - lo + 1);
      __syncthreads();
    }
#define DF_TL(k) ((k) < 2 ? 2 * P.qb + (k) : (t_lo + (k) - 2 < 2 * P.qb ? t_lo + (k) - 2 : t_lo + (k)))
#define DF_GLDS(k, rb) do { const bf16_t* g_ = gtile + (long)(64 * DF_TL(k)) * NQKV; _Pragma("unroll") for (int i_ = 0; i_ < 2; ++i_) { \
        __builtin_amdgcn_global_load_lds((const unsigned*)(g_ + gko + i_ * (32 * NQKV)), (LAS unsigned*)(K_lds + (rb) * KBYTES + (wid + 8 * i_) * 1024), 16, 0, 0); \
        __builtin_amdgcn_global_load_lds((const unsigned*)(g_ + gvo + i_ * (32 * NQKV)), (LAS unsigned*)(V_lds + (rb) * VBYTES + (wid + 8 * i_) * 1024), 16, 0, 0); } } while (0)
#define DF_QK(p0, p1, rb) do { const LAS unsigned char* Kb_ = krd + (rb) * KBYTES; \
        _Pragma("unroll") for (int d0 = 0; d0 < 4; ++d0) { const int sw_ = (kfb + (d0 * 16 + hi * 8) * 2) ^ ((r32 & 7) << 4); \
            const bf16x8 b0_ = *(const LAS bf16x8*)(Kb_ + sw_); const bf16x8 b1_ = *(const LAS bf16x8*)(Kb_ + 32 * (W * 2) + sw_); \
            p0 = __builtin_amdgcn_mfma_f32_32x32x16_bf16(b0_, qr[d0], p0, 0, 0, 0); p1 = __builtin_amdgcn_mfma_f32_32x32x16_bf16(b1_, qr[d0], p1, 0, 0, 0); } } while (0)
#define DF_KRD(b0v, b1v, rb, d0) do { const LAS unsigned char* Kb_ = krd + (rb) * KBYTES; const int sw_ = (kfb + ((d0) * 16 + hi * 8) * 2) ^ ((r32 & 7) << 4); \
        b0v = *(const LAS bf16x8*)(Kb_ + sw_); b1v = *(const LAS bf16x8*)(Kb_ + 32 * (W * 2) + sw_); } while (0)
#define DF_KMM(p0, p1, b0v, b1v, d0) do { p0 = __builtin_amdgcn_mfma_f32_32x32x16_bf16(b0v, qr[d0], p0, 0, 0, 0); p1 = __builtin_amdgcn_mfma_f32_32x32x16_bf16(b1v, qr[d0], p1, 0, 0, 0); } while (0)
#define DF_QK1(p0, p1, rb, d0) do { const LAS unsigned char* Kb_ = krd + (rb) * KBYTES; const int sw_ = (kfb + ((d0) * 16 + hi * 8) * 2) ^ ((r32 & 7) << 4); \
        const bf16x8 b0_ = *(const LAS bf16x8*)(Kb_ + sw_); const bf16x8 b1_ = *(const LAS bf16x8*)(Kb_ + 32 * (W * 2) + sw_); \
        p0 = __builtin_amdgcn_mfma_f32_32x32x16_bf16(b0_, qr[d0], p0, 0, 0, 0); p1 = __builtin_amdgcn_mfma_f32_32x32x16_bf16(b1_, qr[d0], p1, 0, 0, 0); } while (0)
#define DF_SUM16(p) ((((p[0] + p[1]) + (p[2] + p[3])) + ((p[4] + p[5]) + (p[6] + p[7]))) + (((p[8] + p[9]) + (p[10] + p[11])) + ((p[12] + p[13]) + (p[14] + p[15]))))
#define DF_EXP_H(pp, b8) do { _Pragma("unroll") for (int r = 0; r < 8; ++r) pp[(b8) + r] = __builtin_amdgcn_exp2f(pp[(b8) + r]); } while (0)
#define DF_EXP_A(p0, p1) do { _Pragma("unroll") for (int r = 0; r < 16; ++r) p0[r] = __builtin_amdgcn_exp2f(p0[r]); _Pragma("unroll") for (int r = 0; r < 8; ++r) p1[r] = __builtin_amdgcn_exp2f(p1[r]); } while (0)
#define DF_FINISH(p0, p1) do { _Pragma("unroll") for (int r = 8; r < 16; ++r) p1[r] = __builtin_amdgcn_exp2f(p1[r]); \
        float ps_ = 0.f; _Pragma("unroll") for (int r = 0; r < 16; ++r) ps_ += p0[r] + p1[r]; l_reg += ps_; \
        DF_PK4(p0, 0, pa0); DF_PK4(p0, 8, pa1); DF_PK4(p1, 0, pa2); DF_PK4(p1, 8, pa3); } while (0)
#define DF_PK4(PP, BASE, OUT) do { unsigned a0 = pk2(PP[BASE + 0], PP[BASE + 1]), a1 = pk2(PP[BASE + 2], PP[BASE + 3]); \
    unsigned b0_ = pk2(PP[BASE + 4], PP[BASE + 5]), b1_ = pk2(PP[BASE + 6], PP[BASE + 7]); \
    auto r0_ = __builtin_amdgcn_permlane32_swap(a0, b0_, false, false); auto r1_ = __builtin_amdgcn_permlane32_swap(a1, b1_, false, false); \
    u32x4 w_ = {r0_[0], r1_[0], r0_[1], r1_[1]}; OUT = *reinterpret_cast<bf16x8*>(&w_); } while (0)
#define DF_PV(rb) do { const LAS unsigned char* vb_ = vrd + (rb) * VBYTES; pv_blk<0>(o[0], vb_, pa0, pa1, pa2, pa3); pv_blk<1>(o[1], vb_, pa0, pa1, pa2, pa3); \
        pv_blk<2>(o[2], vb_, pa0, pa1, pa2, pa3); pv_blk<3>(o[3], vb_, pa0, pa1, pa2, pa3); } while (0)
#define DF_HALF(c0, c1, q0, q1, j, LOADS) do { \
        DF_KRD(ka0, ka1, rc, 0); if (LOADS) DF_GLDS((j) + 1, rn); __builtin_amdgcn_sched_barrier(0);     \
        { float ps0_ = 0.f, ps1_ = 0.f; \
          DF_KRD(kb0, kb1, rc, 1); DF_KMM(c0, c1, ka0, ka1, 0); DF_EXP_H(q1, 8); __builtin_amdgcn_sched_barrier(0); \
          DF_KRD(ka0, ka1, rc, 2); DF_KMM(c0, c1, kb0, kb1, 1); ps0_ = DF_SUM16(q0); DF_PK4(q0, 0, pa0); __builtin_amdgcn_sched_barrier(0); \
          DF_KRD(kb0, kb1, rc, 3); DF_KMM(c0, c1, ka0, ka1, 2); ps1_ = DF_SUM16(q1); DF_PK4(q0, 8, pa1); __builtin_amdgcn_sched_barrier(0); \
          DF_KMM(c0, c1, kb0, kb1, 3); l_reg += ps0_ + ps1_; DF_PK4(q1, 0, pa2); DF_PK4(q1, 8, pa3); __builtin_amdgcn_sched_barrier(0); } \
        { const LAS unsigned char* vb_ = vrd + rp * VBYTES; \
          pv_blk<0>(o[0], vb_, pa0, pa1, pa2, pa3); DF_EXP_H(c0, 0); __builtin_amdgcn_sched_barrier(0); \
          pv_blk<1>(o[1], vb_, pa0, pa1, pa2, pa3); DF_EXP_H(c0, 8); __builtin_amdgcn_sched_barrier(0); \
          pv_blk<2>(o[2], vb_, pa0, pa1, pa2, pa3); DF_EXP_H(c1, 0); if (LOADS) P.cinit_off<0>(q0, DF_TL((j) + 1), wid, r32, hi); __builtin_amdgcn_sched_barrier(0); \
          pv_blk<3>(o[3], vb_, pa0, pa1, pa2, pa3); if (LOADS) P.cinit_off<1>(q1, DF_TL((j) + 1), wid, r32, hi); __builtin_amdgcn_sched_barrier(0); } \
        __syncthreads(); { const int t_ = rp; rp = rc; rc = rn; rn = t_; } } while (0)
    float l_reg = 0.f; f32x16 o[NB];
#pragma unroll
    for (int d = 0; d < NB; ++d) o[d] = f32x16{};
    f32x16 pA0, pA1, pB0, pB1; bf16x8 pa0, pa1, pa2, pa3, ka0, ka1, kb0, kb1;
    int rp = 2, rc = 0, rn = 1;
    DF_GLDS(0, 0); DF_GLDS(1, 1); __syncthreads();
    P.cinit_abs<0>(pA0, DF_TL(0), wid, r32, hi); P.cinit_abs<1>(pA1, DF_TL(0), wid, r32, hi); DF_QK(pA0, pA1, 0); DF_EXP_A(pA0, pA1);
    P.cinit_abs<0>(pB0, DF_TL(1), wid, r32, hi); P.cinit_abs<1>(pB1, DF_TL(1), wid, r32, hi);
    rp = 0; rc = 1; rn = 2;
    { int j = 1;
      do { DF_HALF(pB0, pB1, pA0, pA1, j, true);
           DF_HALF(pA0, pA1, pB0, pB1, j + 1, true); j += 2; } while (j + 2 < n_tiles); }
    DF_HALF(pB0, pB1, pA0, pA1, n_tiles - 1, false);
    DF_FINISH(pB0, pB1); DF_PV(rp);
#undef DF_GLDS
#undef DF_TL
#undef DF_QK
#undef DF_EXP_A
#undef DF_QK1
#undef DF_KRD
#undef DF_KMM
#undef DF_SUM16
#undef DF_EXP_H
#undef DF_FINISH
#undef DF_PK4
#undef DF_PV
#undef DF_HALF
    int tid2_ = threadIdx.x; asm volatile("" : "+v"(tid2_));
    const int lane2 = tid2_ & 63, r32b = lane2 & 31, hib = lane2 >> 5;
    { auto rr = __builtin_amdgcn_permlane32_swap(__float_as_uint(l_reg), __float_as_uint(l_reg), false, false);
      l_reg = __uint_as_float(rr[0]) + __uint_as_float(rr[1]); }
    const bool bad = !(l_reg > 7.9e-31f && l_reg < 1.2e30f);
    if (__any(bad) && lane2 == 0) flag[0] = 1u;
    __syncthreads();
    const bool redo = __builtin_amdgcn_readfirstlane((int)flag[0]) != 0;
    __syncthreads();
    if (redo) { attn_unit(P, lds, X); return; }
    if (hib == 0) li_l[r32b] = l_reg;
    asm volatile("s_waitcnt lgkmcnt(0)" ::: "memory");
    float rli[16];
#pragma unroll
    for (int r = 0; r < 16; ++r) rli[r] = __builtin_amdgcn_rcpf(li_l[crow(r, hib)]);
    LAS float* XB = (LAS float*)lds;
    if (wid >= 4) {
#pragma unroll
        for (int r = 0; r < 16; ++r) { const int row = 32 * (wid & 3) + crow(r, hib);
#pragma unroll
            for (int d = 0; d < NB; ++d) XB[row * 128 + d * 32 + r32b] = X.lam * o[d][r] * rli[r]; }
    }
    __syncthreads();
    if (wid < 4) {
#pragma unroll
        for (int r = 0; r < 16; ++r) { const int row = 32 * wid + crow(r, hib); float s = 0.f;
#pragma unroll
            for (int d = 0; d < NB; ++d) { const float y = o[d][r] * rli[r] - XB[row * 128 + d * 32 + r32b]; o[d][r] = y; s += y * y; }
            s += sx(s, 1, lane2); s += sx(s, 2, lane2); s += sx(s, 4, lane2); s += sx(s, 8, lane2); s += sx(s, 16, lane2);
            const float rs = (1.0f - LAM_INIT) / sqrtf(s * (1.0f / 128.f) + SUBLN_EPS);
            const long tok = P.qtok(wid, crow(r, hib));
#pragma unroll
            for (int d = 0; d < NB; ++d) X.att[tok * D + P.h * 128 + d * 32 + r32b] = (bf16_t)(pk2(o[d][r] * rs * X.subln[d * 32 + r32b], 0.f) & 0xffffu); }
    }
    __syncthreads();
}
}

#define XB_TMO      128
#define XB_XCNT(j)  (256  + 64 * (j))
#define XB_XSUB(j)  (1280 + 64 * (j))
#define XB_XGEN(j)  (2304 + 64 * (j))
#define XB_TOP      3328
#define XB_TOPGEN   3392
#define XCD_BAR_WORDS 3456
#define XB_SPIN_CAP (1u << 18)

__device__ __forceinline__ unsigned xb_ld(unsigned* p)              { return __hip_atomic_load(p, __ATOMIC_RELAXED, __HIP_MEMORY_SCOPE_AGENT); }
__device__ __forceinline__ unsigned xb_add(unsigned* p, unsigned v) { return __hip_atomic_fetch_add(p, v, __ATOMIC_RELAXED, __HIP_MEMORY_SCOPE_AGENT); }
__device__ __forceinline__ unsigned xb_xcc_id() { return (unsigned)__builtin_amdgcn_s_getreg((3 << 11) | 20) & 0xFu; }
#define XB_SPIN(cond, bar) do { unsigned _sp = 0; while (cond) { __builtin_amdgcn_s_sleep(1); \
    if ((++_sp & 255u) == 0u) { if (xb_ld(&(bar)[XB_TMO])) break; if (_sp > XB_SPIN_CAP) { atomicAdd(&(bar)[XB_TMO], 1u); break; } } } } while (0)

struct XcdBarrier {
    unsigned* bar; unsigned x;
    volatile LAS unsigned* st;
};

__device__ __forceinline__ XcdBarrier xcd_barrier_post(unsigned* bar, volatile LAS unsigned* st) {
    XcdBarrier b; b.bar = bar; b.x = xb_xcc_id(); b.st = st;
    if (threadIdx.x == 0) (void)xb_add(&bar[XB_XCNT(b.x)], 1u);
    return b;
}
__device__ __forceinline__ void xcd_barrier_complete(unsigned* bar, unsigned x, unsigned& nloc, unsigned& nx) {
    const unsigned G = gridDim.x * gridDim.y * gridDim.z;
    unsigned sum, cnt, mine, sp = 0u;
    for (;;) {
        sum = 0u; cnt = 0u; mine = 0u;
#pragma unroll
        for (unsigned j = 0; j < 16; ++j) { const unsigned c = xb_ld(&bar[XB_XCNT(j)]); sum += c; cnt += (c > 0u) ? 1u : 0u; mine = (j == x) ? c : mine; }
        if (sum == G) break;
        __builtin_amdgcn_s_sleep(1);
        if ((++sp & 255u) == 0u) { if (xb_ld(&bar[XB_TMO])) break; if (sp > XB_SPIN_CAP) { atomicAdd(&bar[XB_TMO], 1u); break; } }
    }
    nloc = mine > 0u ? mine : 1u; nx = cnt > 0u ? cnt : 1u;
}

__device__ __forceinline__ void xcd_barrier(const XcdBarrier& b) {
    asm volatile("s_waitcnt vmcnt(0)" ::: "memory");
    __syncthreads();
    if (threadIdx.x == 0) {
        unsigned* bar = b.bar;
        __builtin_amdgcn_s_waitcnt(0);
        unsigned nloc = b.st[0], nx = b.st[1];
        if (nloc == 0u) { xcd_barrier_complete(bar, b.x, nloc, nx); b.st[0] = nloc; b.st[1] = nx; }
        const unsigned old = xb_add(&bar[XB_XSUB(b.x)], 1u);
        const unsigned gen = old / nloc;
        if (old + 1u == (gen + 1u) * nloc) {
            __builtin_amdgcn_fence(__ATOMIC_RELEASE, "agent");
            asm volatile("s_waitcnt vmcnt(0)" ::: "memory");
            const unsigned og = xb_add(&bar[XB_TOP], 1u);
            const unsigned tg = og / nx;
            if (og + 1u == (tg + 1u) * nx) xb_add(&bar[XB_TOPGEN], 1u);
            else XB_SPIN(xb_ld(&bar[XB_TOPGEN]) == tg, bar);
            __builtin_amdgcn_fence(__ATOMIC_ACQUIRE, "agent");
            xb_add(&bar[XB_XGEN(b.x)], 1u);
            asm volatile("s_waitcnt vmcnt(0)" ::: "memory");
        } else {
            XB_SPIN(xb_ld(&bar[XB_XGEN(b.x)]) == gen, bar);
            __builtin_amdgcn_fence(__ATOMIC_ACQUIRE, "agent");
            asm volatile("s_waitcnt vmcnt(0)" ::: "memory");
        }
    }
    __syncthreads();
}

__device__ __forceinline__ void grp_barrier(unsigned* cnt, unsigned& epoch, unsigned nmem) {
    asm volatile("s_waitcnt vmcnt(0)" ::: "memory");
    __syncthreads();
    epoch += 1u;
    if (threadIdx.x == 0) {
        __builtin_amdgcn_fence(__ATOMIC_RELEASE, "agent"); asm volatile("s_waitcnt vmcnt(0)" ::: "memory");
        (void)xb_add(cnt, 1u);
        const unsigned target = nmem * epoch; unsigned sp = 0u;
        while (xb_ld(cnt) < target) { __builtin_amdgcn_s_sleep(1); if (++sp > (1u << 22)) break; }
        __builtin_amdgcn_fence(__ATOMIC_ACQUIRE, "agent"); asm volatile("s_waitcnt vmcnt(0)" ::: "memory");
    }
    __syncthreads();
}

constexpr size_t MiB = 1u << 20;
constexpr size_t WS_W = 2 * MiB, WS_WL = 26 * MiB;
constexpr size_t WO_IN = 0, WO_O = 6 * MiB, WO_GU = 8 * MiB, WO_D = 19 * MiB;
constexpr size_t WS_BAR = 512 * 1024, WS_BAR_BYTES = 32768;
constexpr size_t WS_KN = 0;
constexpr size_t WS_SS = 56 * MiB, WS_LSE = 60 * MiB, WS_XB = 68 * MiB, WS_ATT = 196 * MiB, WS_OBR = 324 * MiB, WS_QKV = 516 * MiB, WS_H = WS_QKV, WS_END = 900 * MiB;
constexpr int LDS_BYTES = 147456;

struct Args { const float* in[22]; float* out; unsigned char* ws; int ph_lo, ph_hi; };
enum { I_X = 0, I_A0N = 1, I_A0IN = 2, I_A0OUT = 3, I_RPB = 4, I_F0N = 5, I_F0G = 6, I_F0U = 7, I_F0D = 8, I_A1N = 9, I_A1QKV = 10, I_A1OUT = 11,
       I_LQ1 = 12, I_LK1 = 13, I_LQ2 = 14, I_LK2 = 15, I_SUBLN = 16, I_F1N = 17, I_F1G = 18, I_F1U = 19, I_F1D = 20, I_FN = 21 };
constexpr int NPH = 14;

__device__ __forceinline__ float wave_sum(float v, int lane) {
#pragma unroll
    for (int o = 1; o < 64; o <<= 1) v += sx(v, o, lane);
    return v;
}
__device__ __forceinline__ void transpose_item(const float* W, const float* gain, int K, int N, bf16_t* WT, int mode, LAS float* scr, int item, int lane) {
    const int nblk = N / 32, kb = item / nblk, nb = item % nblk, k0 = 64 * kb, n0 = 32 * nb;
#pragma unroll 8
    for (int i = 0; i < 32; ++i) { const int kk = 2 * i + (lane >> 5); const float g = gain ? gain[k0 + kk] : 1.0f; scr[kk * 33 + (lane & 31)] = W[(size_t)(k0 + kk) * N + n0 + (lane & 31)] * g; }
    asm volatile("s_waitcnt lgkmcnt(0)" ::: "memory");
    const int c = lane & 7;
    const int ob = mode == 0 ? n0 : 256 * (n0 >> 7) + 128 * (mode - 1) + (n0 & 127);
#pragma unroll
    for (int j = 0; j < 4; ++j) { const int n = (lane >> 3) + 8 * j; const LAS float* s = scr + (8 * c) * 33 + n;
        u32x4 o; o.x = cvtpk(s[0 * 33], s[1 * 33]); o.y = cvtpk(s[2 * 33], s[3 * 33]); o.z = cvtpk(s[4 * 33], s[5 * 33]); o.w = cvtpk(s[6 * 33], s[7 * 33]);
        *(u32x4*)(WT + (size_t)(ob + n) * K + k0 + 8 * c) = o; }
    asm volatile("s_waitcnt lgkmcnt(0)" ::: "memory");
}

__global__ void __launch_bounds__(512, 2) mk_fwd(Args a) {
    extern __shared__ __attribute__((aligned(16))) unsigned char lds_raw[];
    LAS unsigned char* lds = (LAS unsigned char*)lds_raw;
    cg::grid_group grid = cg::this_grid();
    { volatile LAS unsigned* st_ = (volatile LAS unsigned*)(lds + LDS_BYTES - 64); if (threadIdx.x < 2) st_[threadIdx.x] = 0u; }
    __syncthreads();
    const XcdBarrier bar = xcd_barrier_post((unsigned*)(a.ws + WS_BAR), (volatile LAS unsigned*)(lds + LDS_BYTES - 64));
    if (a.ph_lo < 0) grid.sync();
    const int wave = __builtin_amdgcn_readfirstlane((int)threadIdx.x >> 6);
    const int G = gridDim.x, gw = blockIdx.x * 8 + wave, NGW = G * 8;
    const bool grp = (G == M / 256) && (G % 8 == 0) && MK_DUP_MASK == 0;
    unsigned grp_epoch = 0u; unsigned* const grp_cnt = (unsigned*)(a.ws + WS_BAR) + 3520 + 64 * ((int)blockIdx.x & 7);
    unsigned char* ws = a.ws;
    float* ss = (float*)(ws + WS_SS); float* lse = (float*)(ws + WS_LSE);
    bf16_t* xb = (bf16_t*)(ws + WS_XB); bf16_t* att = (bf16_t*)(ws + WS_ATT); bf16_t* obr = (bf16_t*)(ws + WS_OBR);
    bf16_t* qkv = (bf16_t*)(ws + WS_QKV); bf16_t* hb = (bf16_t*)(ws + WS_H);

#ifdef MK_PROBE_SYNCS
    for (int i_ = 0; i_ < MK_PROBE_SYNCS; ++i_) xcd_barrier(bar);
#endif
    for (int ph = a.ph_lo; ph < a.ph_hi; ++ph)
    for (int rep = 0; rep <= ((MK_DUP_MASK >> ph) & 1); ++rep) {
        if (ph == 0) {
            int tq_ = threadIdx.x; asm volatile("" : "+v"(tq_)); const int lane = tq_ & 63;
            LAS float* scr = (LAS float*)(lds + wave * 16384);
            constexpr int I_IN = 16 * 96, I_O = 16 * 32, I_G = 16 * 88, I_D = 44 * 32, I_L = I_IN + I_O + 2 * I_G + I_D;
            for (int it = gw; it < 2 * I_L; it += NGW) {
                const int l = it / I_L; int r = it % I_L; unsigned char* wl = ws + WS_W + (size_t)l * WS_WL;
                const float* an = a.in[l ? I_A1N : I_A0N]; const float* fn = a.in[l ? I_F1N : I_F0N];
                if (r < I_IN) { transpose_item(a.in[l ? I_A1QKV : I_A0IN], an, D, NQKV, (bf16_t*)(wl + WO_IN), 0, scr, r, lane); continue; } r -= I_IN;
                if (r < I_O) { transpose_item(a.in[l ? I_A1OUT : I_A0OUT], nullptr, D, D, (bf16_t*)(wl + WO_O), 0, scr, r, lane); continue; } r -= I_O;
                if (r < I_G) { transpose_item(a.in[l ? I_F1G : I_F0G], fn, D, FF, (bf16_t*)(wl + WO_GU), 1, scr, r, lane); continue; } r -= I_G;
                if (r < I_G) { transpose_item(a.in[l ? I_F1U : I_F0U], fn, D, FF, (bf16_t*)(wl + WO_GU), 2, scr, r, lane); continue; } r -= I_G;
                transpose_item(a.in[l ? I_F1D : I_F0D], nullptr, FF, D, (bf16_t*)(wl + WO_D), 0, scr, r, lane);
            }
            const float* x = a.in[I_X];
            for (int m = gw; m < M; m += 2 * NGW) {
                const f32x4* xr0 = (const f32x4*)(x + (size_t)m * D) + lane; const f32x4* xr1 = (const f32x4*)(x + (size_t)(m + NGW) * D) + lane; f32x4 v0[4], v1[4];
#pragma unroll
                for (int j = 0; j < 4; ++j) { v0[j] = xr0[64 * j]; v1[j] = xr1[64 * j]; }
                float s0 = 0.f, s1 = 0.f;
#pragma unroll
                for (int j = 0; j < 4; ++j) { s0 += (v0[j][0] * v0[j][0] + v0[j][1] * v0[j][1]) + (v0[j][2] * v0[j][2] + v0[j][3] * v0[j][3]);
                                              s1 += (v1[j][0] * v1[j][0] + v1[j][1] * v1[j][1]) + (v1[j][2] * v1[j][2] + v1[j][3] * v1[j][3]); }
                s0 = wave_sum(s0, lane); s1 = wave_sum(s1, lane);
                u32x2* o0 = (u32x2*)(xb + (size_t)m * D) + lane; u32x2* o1 = (u32x2*)(xb + (size_t)(m + NGW) * D) + lane;
#pragma unroll
                for (int j = 0; j < 4; ++j) { u32x2 w; w.x = cvtpk(v0[j][0], v0[j][1]); w.y = cvtpk(v0[j][2], v0[j][3]); o0[64 * j] = w;
                                              u32x2 z; z.x = cvtpk(v1[j][0], v1[j][1]); z.y = cvtpk(v1[j][2], v1[j][3]); o1[64 * j] = z; }
                if (lane < 16) { ss[(size_t)m * 16 + lane] = lane == 0 ? s0 : 0.f; ss[(size_t)(m + NGW) * 16 + lane] = lane == 0 ? s1 : 0.f; }
            }
        } else if (ph == 13) {
            int tq_ = threadIdx.x; asm volatile("" : "+v"(tq_)); const int lane = tq_ & 63;
            const float* g = a.in[I_FN];
            f32x4 gg[4];
#pragma unroll
            for (int j = 0; j < 4; ++j) gg[j] = ((const f32x4*)g)[lane + 64 * j];
            const int pm_ = ((int)blockIdx.x & 7) * 32 + ((int)blockIdx.x >> 3);
            const int m_lo = grp ? pm_ * 256 + wave : gw, m_hi = grp ? pm_ * 256 + 256 : M, m_st = grp ? 8 : NGW;
            for (int m = m_lo; m < m_hi; m += 2 * m_st) {
                f32x4* xr0 = (f32x4*)(a.out + (size_t)m * D) + lane; f32x4* xr1 = (f32x4*)(a.out + (size_t)(m + m_st) * D) + lane; f32x4 v0[4], v1[4];
#pragma unroll
                for (int j = 0; j < 4; ++j) { v0[j] = xr0[64 * j]; v1[j] = xr1[64 * j]; }
                float s0 = 0.f, s1 = 0.f;
#pragma unroll
                for (int j = 0; j < 4; ++j) { s0 += (v0[j][0] * v0[j][0] + v0[j][1] * v0[j][1]) + (v0[j][2] * v0[j][2] + v0[j][3] * v0[j][3]);
                                              s1 += (v1[j][0] * v1[j][0] + v1[j][1] * v1[j][1]) + (v1[j][2] * v1[j][2] + v1[j][3] * v1[j][3]); }
                s0 = wave_sum(s0, lane); s1 = wave_sum(s1, lane);
                const float rs0 = 1.0f / sqrtf(s0 * (1.0f / D) + RMS_EPS), rs1 = 1.0f / sqrtf(s1 * (1.0f / D) + RMS_EPS);
#pragma unroll
                for (int j = 0; j < 4; ++j) { xr0[64 * j] = v0[j] * rs0 * gg[j]; xr1[64 * j] = v1[j] * rs1 * gg[j]; }
            }
        } else {
            const int l = (ph - 1) / 6, s = (ph - 1) % 6;
            unsigned char* wl = ws + WS_W + (size_t)l * WS_WL;
            if (s == 0) {
                pg8::Gemm g{xb, (const bf16_t*)(wl + WO_IN), M, NQKV, D}; pg8::StaticOrder S; S.init(M, NQKV, G, (int)blockIdx.x);
                pg8::EpiScaleBf16 E{qkv, NQKV, ss, l == 0 ? 0xC3u : 0xFu, l == 1 ? (float*)(ws + WS_KN) : nullptr};
#ifndef SKIP_G1
                pg8::gemm_phase<pg8::EpiScaleBf16, pg8::StaticOrder, true, true>(lds, g, S, E);
#endif
            } else if (s == 1) {
                at::Ptrs X{qkv, att, obr, lse, a.in[I_RPB], a.in[I_SUBLN], 0.f, (const float*)(ws + WS_KN)};
                if (l == 0) {
                    const int vc0 = ((int)blockIdx.x & 7) * (G >> 3) + ((int)blockIdx.x >> 3);
#ifndef SKIP_NAT
                    for (int u = vc0; u < 2048; u += G) { at::PolNat P; P.init(u); at::attn_unit(P, lds, X); }
#endif
#ifndef SKIP_DIL
                    { bf16x8 pq0 = {}, pq1 = {}, pq2 = {}, pq3 = {}, pk_ = {}, pv_ = {}; bool have = false;
                      for (int u = 2048 + vc0; u < 8192; u += G) { at::PolDil P, Pn; P.init(u - 2048); const bool hasn = u + G < 8192; if (hasn) Pn.init(u + G - 2048); else Pn = P;
                          at::attn_unit(P, lds, X, pq0, pq1, pq2, pq3, pk_, pv_, have, Pn, hasn); have = hasn; } }
#endif
                }
            } else if (s == 2) {
                if (l == 0) {
                    int tq_ = threadIdx.x; asm volatile("" : "+v"(tq_)); const int lane = tq_ & 63;
                    const int hd = lane >> 3;
                    for (int m0 = gw; m0 < M; m0 += 2 * NGW) {
                        float L[2][3]; bf16x8 ov[2][3];
#pragma unroll
                        for (int r = 0; r < 2; ++r) { const size_t m = (size_t)m0 + (size_t)r * NGW;
#pragma unroll
                            for (int i = 0; i < 3; ++i) { L[r][i] = lse[(size_t)i * M * 8 + m * 8 + hd]; ov[r][i] = *(const bf16x8*)(obr + (size_t)i * M * 512 + m * 512 + lane * 8); } }
#pragma unroll
                        for (int r = 0; r < 2; ++r) { const size_t m = (size_t)m0 + (size_t)r * NGW;
                            const float mx = fmaxf(L[r][0], fmaxf(L[r][1], L[r][2]));
                            float w0 = __builtin_amdgcn_exp2f(L[r][0] - mx), w1 = __builtin_amdgcn_exp2f(L[r][1] - mx), w2 = __builtin_amdgcn_exp2f(L[r][2] - mx);
                            const float inv = 1.0f / (w0 + w1 + w2); w0 *= inv; w1 *= inv; w2 *= inv;
                            float y[8];
#pragma unroll
                            for (int e = 0; e < 8; ++e) y[e] = w0 * bf2f((unsigned short)ov[r][0][e]) + w1 * bf2f((unsigned short)ov[r][1][e]) + w2 * bf2f((unsigned short)ov[r][2][e]);
                            u32x4 w; w.x = cvtpk(y[0], y[1]); w.y = cvtpk(y[2], y[3]); w.z = cvtpk(y[4], y[5]); w.w = cvtpk(y[6], y[7]);
                            *(u32x4*)(att + m * D + lane * 8) = w; }
                    }
                } else {
                    float d1 = 0.f, d2 = 0.f;
                    for (int i = 0; i < 64; ++i) { d1 += a.in[I_LQ1][i] * a.in[I_LK1][i]; d2 += a.in[I_LQ2][i] * a.in[I_LK2][i]; }
                    at::Ptrs X{qkv, att, obr, lse, a.in[I_RPB], a.in[I_SUBLN], 0.f, (const float*)(ws + WS_KN)};
                    X.lam = __int_as_float(__builtin_amdgcn_readfirstlane(__float_as_int(__expf(d1) - __expf(d2) + LAM_INIT)));
#ifndef SKIP_DIFF
                    if (grp) {
                        unsigned* qctr = (unsigned*)(a.ws + WS_BAR) + 4096 + 64 * ((int)blockIdx.x & 7);
                        LAS unsigned* qs = (LAS unsigned*)(lds + LDS_BYTES - 32);
                        if (threadIdx.x == 0) qs[0] = xb_add(qctr, 1u);
                        __syncthreads();
                        int cur = 0;
                        for (;;) {
                            const unsigned i = (unsigned)__builtin_amdgcn_readfirstlane((int)qs[cur]);
                            if (i >= 512u) break;
                            unsigned nxt = 0u; if (threadIdx.x == 0) nxt = xb_add(qctr, 1u);
                            at::PolDiff P; { const int hq = 7 - (int)(i >> 6), bs = (int)(i >> 5) & 1, x_ = (int)blockIdx.x & 7;
                                P.h = hq; P.b = x_ + 8 * bs; P.qb = (int)(i & 31u); P.tlo = 0; P.thi = T / 64; P.nsl = -at::slope_of(hq) * LOG2E; }
                            at::diff_unit(P, lds, X);
                            if (threadIdx.x == 0) qs[cur ^ 1] = nxt;
                            __syncthreads(); cur ^= 1;
                        }
                    } else
                    for (int u = blockIdx.x; u < 4096; u += G) { at::PolDiff P; P.init(u); at::diff_unit(P, lds, X); }
#endif
                }
            } else if (s == 3 || s == 5) {
                const bool dn = s == 5;
                pg8::Gemm g{dn ? hb : att, (const bf16_t*)(wl + (dn ? WO_D : WO_O)), M, D, dn ? FF : D}; pg8::StaticOrder S; S.init(M, D, G, (int)blockIdx.x);
                pg8::EpiResid E{(l == 0 && !dn) ? a.in[I_X] : nullptr, (l == 1 && dn) ? a.out : nullptr, xb, (bf16_t*)(ws + WS_OBR)  , ss};
#ifndef SKIP_G2
                pg8::gemm_phase<pg8::EpiResid, pg8::StaticOrder, true, true>(lds, g, S, E);
#endif
            } else {
                pg8::Gemm g{xb, (const bf16_t*)(wl + WO_GU), M, NGU, D}; pg8::StaticOrder S; S.init(M, NGU, G, (int)blockIdx.x);
                pg8::EpiSwiGLU E{hb, ss};
#ifndef SKIP_G3
                pg8::gemm_phase<pg8::EpiSwiGLU, pg8::StaticOrder, true, true>(lds, g, S, E);
#endif
            }
        }
        if ((ph + 1 < a.ph_hi || rep < ((MK_DUP_MASK >> ph) & 1)) && ph != 8) {
            if (grp && ((ph >= 4 && ph <= 5) || (ph >= 10 && ph <= 12))) grp_barrier(grp_cnt, grp_epoch, (unsigned)(G >> 3));
            else xcd_barrier(bar); }
    }
}

extern "C" void kernel_launch(void* const* d_in, const int* in_sizes, int n_in, void* d_out, int out_size, void* d_ws, size_t ws_size, hipStream_t stream) {
    static int grid = 0;
    if (grid == 0) {
        if (n_in != 22 || in_sizes[0] != M * D || out_size != M * D || ws_size < WS_END) { fprintf(stderr, "kernel_launch: unexpected shapes (n_in %d, in0 %d, out %d, ws %zu)\n", n_in, n_in > 0 ? in_sizes[0] : -1, out_size, ws_size); grid = -1; return; }
        int dev = 0, cus = 0, per_cu = 0;
        hipGetDevice(&dev); hipDeviceGetAttribute(&cus, hipDeviceAttributeMultiprocessorCount, dev);
        if (hipFuncSetAttribute((const void*)mk_fwd, hipFuncAttributeMaxDynamicSharedMemorySize, LDS_BYTES) != hipSuccess) { fprintf(stderr, "kernel_launch: hipFuncSetAttribute failed\n"); grid = -1; return; }
        hipOccupancyMaxActiveBlocksPerMultiprocessor(&per_cu, (const void*)mk_fwd, 512, LDS_BYTES);
        (void)hipGetLastError();
        if (per_cu < 1) { fprintf(stderr, "kernel_launch: occupancy query says %d blocks/CU\n", per_cu); per_cu = 1; }
        grid = cus * 1;
    }
    if (grid < 0) return;
    Args a{};
    for (int i = 0; i < 22; ++i) a.in[i] = (const float*)d_in[i];
    a.out = (float*)d_out; a.ws = (unsigned char*)d_ws;
#if MK_ONE_LAUNCH
    if (hipMemsetAsync((char*)d_ws + WS_BAR, 0, WS_BAR_BYTES, stream) != hipSuccess) { fprintf(stderr, "kernel_launch: memset of the barrier words failed\n"); return; }
    a.ph_lo = 0; a.ph_hi = NPH;
    void* args[] = {&a};
    hipError_t e = hipLaunchCooperativeKernel((const void*)mk_fwd, dim3(grid), dim3(512), args, LDS_BYTES, stream);
    if (e != hipSuccess) fprintf(stderr, "cooperative launch failed: %s (grid %d)\n", hipGetErrorString(e), grid);
#else
    for (int ph = 0; ph < NPH; ++ph) {
        a.ph_lo = ph; a.ph_hi = ph + 1;
        hipLaunchKernelGGL(mk_fwd, dim3(grid), dim3(512), LDS_BYTES, stream, a);
    }
#endif
}
```

```cpp
#include <hip/hip_runtime.h>
#include <hip/hip_cooperative_groups.h>
#include <cstdio>
#include <cstdint>
namespace cg = cooperative_groups;
#ifndef MK_DUP_MASK
#define MK_DUP_MASK 0x0
#endif
#ifndef MK_ONE_LAUNCH
#define MK_ONE_LAUNCH 1
#endif
namespace pg8 {
#define PG8_LAS __attribute__((address_space(3)))
typedef unsigned short bf16_t;
typedef short bf16x8 __attribute__((ext_vector_type(8)));
typedef float f32x4 __attribute__((ext_vector_type(4)));
typedef unsigned u32x4 __attribute__((ext_vector_type(4)));
constexpr int BM = 256, BK = 64, HALF = 128, HTB = HALF * BK * 2  , STAGE_BYTES = 8 * HTB, NXCD = 8, WGM = 8;

__host__ __device__ __forceinline__ int lds_byte(int r, int c) { const int st = (r >> 4) * 2 + (c >> 5), rr = r & 15, cc = c & 31, ob = rr * 64 + cc * 2; return st * 1024 + (ob ^ (((ob >> 9) & 1) << 5)); }
__host__ __device__ __forceinline__ void stage_rc(int b, int& R, int& C) { const int st = b / 1024, sb = b % 1024, swz = sb ^ (((sb >> 9) & 1) << 5); R = (st >> 1) * 16 + swz / 64; C = (st & 1) * 32 + (swz % 64) / 2; }
__host__ __device__ __forceinline__ int perm32(int rho) { const int n = rho >> 4, i = rho & 15; return 8 * (i >> 2) + 4 * n + (i & 3); }

struct Unit { int pm, pn; };
struct Gemm { const bf16_t* A; const bf16_t* Bt; int M, N, K; };

struct StaticOrder {
    int nM, nN, nwg, G, c;
    __host__ __device__ void init(int M, int N, int G_, int c_) { nM = M / BM; nN = N / BM; nwg = nM * nN; G = G_; c = c_; }
    __host__ __device__ bool next(int i, Unit& u) const {
        const long L = (long)i * G + c; if (L >= nwg) return false;
        int wgid = (int)L; { const int q = nwg / NXCD, r = nwg % NXCD, xcd = wgid % NXCD, off = wgid / NXCD; wgid = (xcd < r ? xcd * (q + 1) : r * (q + 1) + (xcd - r) * q) + off; }
        const int nig = WGM * nN, gid = wgid / nig, fm = gid * WGM, gsz = (nM - fm) < WGM ? (nM - fm) : WGM;
        u.pm = fm + ((wgid % nig) % gsz); u.pn = (wgid % nig) / gsz; return true;
    }
    __device__ __forceinline__ void a_ready(const Unit&) const {}
    __device__ __forceinline__ void done(const Unit&) const {}
};

__device__ __forceinline__ unsigned cvt_pk_bf16(float lo, float hi) { unsigned r; asm volatile("v_cvt_pk_bf16_f32 %0, %1, %2" : "=v"(r) : "v"(lo), "v"(hi)); return r; }
typedef float f32x2 __attribute__((ext_vector_type(2)));
template <class Epi, class Sched, bool ALIGN_EPI = false, bool SP2 = false>
__device__ __forceinline__ void gemm_phase(PG8_LAS unsigned char* lds, const Gemm g, const Sched& S, const Epi& E) {
    int tid_ = threadIdx.x; asm volatile("" : "+v"(tid_));
    const int tid = tid_, wid = __builtin_amdgcn_readfirstlane(tid >> 6), lane = tid & 63, wr = wid >> 2, wc = wid & 3, fr = lane & 15, fq = lane >> 4;
    const int K = g.K, nt = K / BK;
    unsigned voffA[2], voffB[2];
#pragma unroll
    for (int i = 0; i < 2; ++i) { int R, C; stage_rc(tid * 16 + i * 8192, R, C); const int Rb = Epi::PERM ? ((R & ~31) + perm32(R & 31)) : R;
        voffA[i] = (unsigned)(R * K + C) * 2u; voffB[i] = (unsigned)(Rb * K + C) * 2u; }
    const size_t kstep = (size_t)(BK * 2);
    const size_t hstep = (size_t)HALF * K * 2;
    const size_t tstep = 2 * hstep;
    const unsigned ldsw = (unsigned)wid * 1024u;
    const int aoff = lds_byte(wr * 64 + fr, fq * 8), boff = lds_byte(wc * 32 + fr, fq * 8);
#define PG8_SA(b, h) (((b) * 2 + (h)) * HTB)
#define PG8_SB(b, h) ((4 + (b) * 2 + (h)) * HTB)
#define PG8_STAGE(bufoff, gbase, voff) do { _Pragma("unroll") for (int _i = 0; _i < 2; ++_i) \
        __builtin_amdgcn_global_load_lds((const unsigned*)((const char*)(gbase) + (voff)[_i]), (PG8_LAS unsigned*)(lds + (bufoff) + ldsw + _i * 8192), 16, 0, 0); } while (0)
#define PG8_LDA(dst, b, h) do { _Pragma("unroll") for (int m = 0; m < 4; ++m) _Pragma("unroll") for (int k = 0; k < 2; ++k) dst[m][k] = *(const PG8_LAS bf16x8*)(lds + PG8_SA(b, h) + aoff + m * 2048 + k * 1024); } while (0)
#define PG8_LDB(dst, b, h) do { _Pragma("unroll") for (int n = 0; n < 2; ++n) _Pragma("unroll") for (int k = 0; k < 2; ++k) dst[n][k] = *(const PG8_LAS bf16x8*)(lds + PG8_SB(b, h) + boff + n * 2048 + k * 1024); } while (0)
#define PG8_MMA(ai, bj, At, Bt) do { __builtin_amdgcn_s_setprio(1); _Pragma("unroll") for (int m = 0; m < 4; ++m) _Pragma("unroll") for (int n = 0; n < 2; ++n) _Pragma("unroll") for (int k = 0; k < 2; ++k) \
        acc[ai][bj][m][n] = __builtin_amdgcn_mfma_f32_16x16x32_bf16(Bt[n][k], At[m][k], acc[ai][bj][m][n], 0, 0, 0); __builtin_amdgcn_s_setprio(0); } while (0)
#define PG8_WAIT_V(n) asm volatile("s_waitcnt vmcnt(" #n ")" ::: "memory")
#define PG8_WAIT_L(n) asm volatile("s_waitcnt lgkmcnt(" #n ")" ::: "memory")
#define PG8_BAR __builtin_amdgcn_s_barrier()
#define PG8_SCHED __builtin_amdgcn_sched_barrier(0)
    Unit cur, nxt; int ui = 0;
    if (!S.next(0, cur)) return;
    f32x4 acc[2][2][4][2];
#pragma unroll
    for (int a = 0; a < 2; ++a)
#pragma unroll
        for (int b = 0; b < 2; ++b)
#pragma unroll
            for (int m = 0; m < 4; ++m)
#pragma unroll
                for (int n = 0; n < 2; ++n) acc[a][b][m][n] = (f32x4){0.f, 0.f, 0.f, 0.f};
    bf16x8 At[4][2], B0[2][2], B1[2][2];
    const char* cA = (const char*)g.A + (size_t)cur.pm * tstep; const char* cB = (const char*)g.Bt + (size_t)cur.pn * tstep;
    S.a_ready(cur);
    if constexpr (SP2) {
        PG8_STAGE(PG8_SB(0, 0), cB, voffB); PG8_STAGE(PG8_SB(0, 1), cB + hstep, voffB); PG8_STAGE(PG8_SA(0, 0), cA, voffA); PG8_STAGE(PG8_SA(0, 1), cA + hstep, voffA);
        if (wr == 1) PG8_BAR;
        PG8_WAIT_V(2); PG8_BAR;
        PG8_STAGE(PG8_SB(1, 0), cB + kstep, voffB); PG8_STAGE(PG8_SA(1, 0), cA + kstep, voffA); PG8_STAGE(PG8_SB(1, 1), cB + hstep + kstep, voffB);
        PG8_WAIT_V(6); PG8_BAR;
    } else {
        PG8_STAGE(PG8_SB(0, 0), cB, voffB); PG8_STAGE(PG8_SA(0, 0), cA, voffA); PG8_STAGE(PG8_SB(0, 1), cB + hstep, voffB); PG8_STAGE(PG8_SA(0, 1), cA + hstep, voffA);
        if (wr == 1) PG8_BAR;
        PG8_WAIT_V(4); PG8_BAR;
        PG8_STAGE(PG8_SB(1, 0), cB + kstep, voffB); PG8_STAGE(PG8_SA(1, 0), cA + kstep, voffA); PG8_STAGE(PG8_SB(1, 1), cB + hstep + kstep, voffB);
        PG8_WAIT_V(6); PG8_BAR;
    }
    for (;;) {
        const bool has_next = S.next(ui + 1, nxt);
        const char* nA = has_next ? (const char*)g.A + (size_t)nxt.pm * tstep : cA; const char* nB = has_next ? (const char*)g.Bt + (size_t)nxt.pn * tstep : cB;
        for (int t = 0; t < nt; t += 2) {
            const bool last = (t == nt - 2);
            const char* a1 = cA + (size_t)(t + 1) * kstep;
            const char* a2 = last ? nA : cA + (size_t)(t + 2) * kstep; const char* b2 = last ? nB : cB + (size_t)(t + 2) * kstep;
            const char* a3 = a2 + kstep; const char* b3 = b2 + kstep;
            if (last && has_next) S.a_ready(nxt);
            if constexpr (SP2) {
            PG8_LDB(B0, 0, 0); PG8_LDB(B1, 0, 1); PG8_SCHED; PG8_LDA(At, 0, 0); PG8_STAGE(PG8_SA(1, 1), a1 + hstep, voffA);
            PG8_WAIT_V(8); PG8_WAIT_L(0); PG8_BAR; PG8_MMA(0, 0, At, B0); PG8_MMA(0, 1, At, B1); PG8_BAR; PG8_SCHED;
            PG8_LDA(At, 0, 1); PG8_STAGE(PG8_SB(0, 0), b2, voffB); PG8_STAGE(PG8_SB(0, 1), b2 + hstep, voffB); PG8_STAGE(PG8_SA(0, 0), a2, voffA);
            PG8_WAIT_V(8); PG8_WAIT_L(0); PG8_BAR; PG8_MMA(1, 0, At, B0); PG8_MMA(1, 1, At, B1); PG8_BAR; PG8_SCHED;
            PG8_LDB(B0, 1, 0); PG8_LDB(B1, 1, 1); PG8_SCHED; PG8_LDA(At, 1, 0); PG8_STAGE(PG8_SA(0, 1), a2 + hstep, voffA);
            PG8_WAIT_V(8); PG8_WAIT_L(0); PG8_BAR; PG8_MMA(0, 0, At, B0); PG8_MMA(0, 1, At, B1); PG8_BAR; PG8_SCHED;
            PG8_LDA(At, 1, 1); PG8_STAGE(PG8_SB(1, 0), b3, voffB); PG8_STAGE(PG8_SB(1, 1), b3 + hstep, voffB); PG8_STAGE(PG8_SA(1, 0), a3, voffA);
            PG8_WAIT_V(8); PG8_WAIT_L(0); PG8_BAR; PG8_MMA(1, 0, At, B0); PG8_MMA(1, 1, At, B1); PG8_BAR; PG8_SCHED;
            } else {
            PG8_LDB(B0, 0, 0); PG8_SCHED; PG8_LDA(At, 0, 0); PG8_STAGE(PG8_SA(1, 1), a1 + hstep, voffA);
            PG8_WAIT_L(8); PG8_BAR; PG8_WAIT_L(0); PG8_MMA(0, 0, At, B0); PG8_BAR; PG8_SCHED;
            PG8_LDB(B1, 0, 1); PG8_STAGE(PG8_SB(0, 0), b2, voffB);
            PG8_BAR; PG8_WAIT_L(0); PG8_MMA(0, 1, At, B1); PG8_BAR;
            PG8_LDA(At, 0, 1); PG8_STAGE(PG8_SA(0, 0), a2, voffA);
            PG8_BAR; PG8_WAIT_L(0); PG8_MMA(1, 0, At, B0); PG8_BAR; PG8_SCHED;
            PG8_STAGE(PG8_SB(0, 1), b2 + hstep, voffB);
            PG8_WAIT_V(6); PG8_BAR; PG8_MMA(1, 1, At, B1); PG8_BAR;
            PG8_LDB(B0, 1, 0); PG8_SCHED; PG8_LDA(At, 1, 0); PG8_STAGE(PG8_SA(0, 1), a2 + hstep, voffA);
            PG8_WAIT_L(8); PG8_BAR; PG8_WAIT_L(0); PG8_MMA(0, 0, At, B0); PG8_BAR; PG8_SCHED;
            PG8_LDB(B1, 1, 1); PG8_STAGE(PG8_SB(1, 0), b3, voffB);
            PG8_BAR; PG8_WAIT_L(0); PG8_MMA(0, 1, At, B1); PG8_BAR;
            PG8_LDA(At, 1, 1); PG8_STAGE(PG8_SA(1, 0), a3, voffA);
            PG8_BAR; PG8_WAIT_L(0); PG8_MMA(1, 0, At, B0); PG8_BAR; PG8_SCHED;
            PG8_STAGE(PG8_SB(1, 1), b3 + hstep, voffB);
            PG8_WAIT_V(6); PG8_BAR; PG8_MMA(1, 1, At, B1); PG8_BAR;
            }
        }
        if constexpr (ALIGN_EPI) { if (wr == 0) PG8_BAR; }
        if constexpr (!Epi::AFTER_DRAIN) { E(acc, cur, wr, wc, fr, fq); S.done(cur); }
        if (!has_next) break;
#pragma unroll
        for (int a = 0; a < 2; ++a)
#pragma unroll
            for (int b = 0; b < 2; ++b)
#pragma unroll
                for (int m = 0; m < 4; ++m)
#pragma unroll
                    for (int n = 0; n < 2; ++n) acc[a][b][m][n] = (f32x4){0.f, 0.f, 0.f, 0.f};
        cur = nxt; cA = nA; cB = nB; ++ui;
        if constexpr (ALIGN_EPI) { if (wr == 1) PG8_BAR; }
    }
    PG8_WAIT_V(0);
    if constexpr (!ALIGN_EPI) { if (wr == 0) PG8_BAR; }
    PG8_BAR;
    if constexpr (Epi::AFTER_DRAIN) { E.fused(acc, cur, wr, wc, fr, fq, lds, wid, lane); S.done(cur); }
#undef PG8_SA
#undef PG8_SB
#undef PG8_STAGE
#undef PG8_LDA
#undef PG8_LDB
#undef PG8_MMA
#undef PG8_WAIT_V
#undef PG8_WAIT_L
#undef PG8_BAR
#undef PG8_SCHED
}
}

constexpr int BATCH = 16, T = 4096, D = 1024, M = BATCH * T, NQKV = 3072, FF = 2816, NGU = 2 * FF;
constexpr float RMS_EPS = 1e-6f, SUBLN_EPS = 1e-5f;
constexpr float LOG2E = 1.4426950408889634f;
constexpr float QSCALE = 0.125f * LOG2E;
constexpr float LAM_INIT = 0.35550906f;

#define LAS __attribute__((address_space(3)))
typedef unsigned short bf16_t;
typedef short bf16x8 __attribute__((ext_vector_type(8)));
typedef short s16x4 __attribute__((ext_vector_type(4)));
typedef float f32x4 __attribute__((ext_vector_type(4)));
typedef float f32x16 __attribute__((ext_vector_type(16)));
typedef unsigned u32x4 __attribute__((ext_vector_type(4)));
typedef unsigned u32x2 __attribute__((ext_vector_type(2)));

__device__ __forceinline__ unsigned cvtpk(float lo, float hi) { unsigned r; asm volatile("v_cvt_pk_bf16_f32 %0, %1, %2" : "=v"(r) : "v"(lo), "v"(hi)); return r; }
__device__ __forceinline__ float sx(float v, int mask, int lane) { return __int_as_float(__builtin_amdgcn_ds_bpermute((lane ^ mask) << 2, __float_as_int(v))); }
__device__ __forceinline__ float bf2f(unsigned short u) { return __uint_as_float((unsigned)u << 16); }

namespace pg8 {
__device__ __forceinline__ float row_rs(const float* ss, int row, int fq, int fr) {
#ifdef TRIV_EPI
    return 1.0f;
#endif
    const f32x4 a = *(const f32x4*)(ss + (size_t)row * 16 + 4 * fq);
    float s = (a[0] + a[1]) + (a[2] + a[3]);
    const int ln = fq * 16 + fr; s += sx(s, 16, ln); s += sx(s, 32, ln);
    return 1.0f / sqrtf(s * (1.0f / D) + RMS_EPS);
}
struct EpiScaleBf16 {
    static constexpr bool PERM = true, AFTER_DRAIN = false;
    bf16_t* O; int ldc; const float* ss; unsigned qmask;
    float* kn2;
    __device__ __forceinline__ void operator()(const f32x4 (&acc)[2][2][4][2], const Unit& u, int wr, int wc, int fr, int fq) const {
        const int row0 = u.pm * BM + wr * 64 + fr, col0 = u.pn * BM + wc * 32 + 8 * fq;
        const float qs = ((qmask >> u.pn) & 1u) ? QSCALE : 1.0f;
        const bool kt = kn2 != nullptr && u.pn >= 4 && u.pn < 8;
        const int ln = fq * 16 + fr;
        float km[2][2] = {{0.f, 0.f}, {0.f, 0.f}};
#pragma unroll
        for (int ai = 0; ai < 2; ++ai)
#pragma unroll
            for (int m = 0; m < 4; ++m) { const int row = row0 + ai * HALF + m * 16; const float rs = row_rs(ss, row, fq, fr) * qs;
                bf16_t* rowp = O + (size_t)row * ldc + col0;
#pragma unroll
                for (int bj = 0; bj < 2; ++bj) { const f32x4 v0 = acc[ai][bj][m][0] * rs, v1 = acc[ai][bj][m][1] * rs;
                    u32x4 w; w.x = cvt_pk_bf16(v0[0], v0[1]); w.y = cvt_pk_bf16(v0[2], v0[3]); w.z = cvt_pk_bf16(v1[0], v1[1]); w.w = cvt_pk_bf16(v1[2], v1[3]);
                    *(u32x4*)(rowp + bj * HALF) = w;
                    if (kt) { float s8 = 0.f;
#pragma unroll
                        for (int e = 0; e < 4; ++e) { const unsigned ww = e == 0 ? w.x : (e == 1 ? w.y : (e == 2 ? w.z : w.w)); const float lo_ = __uint_as_float(ww << 16), hi_ = __uint_as_float(ww & 0xffff0000u);
                            s8 = fmaf(lo_, lo_, s8); s8 = fmaf(hi_, hi_, s8); }
                        s8 += sx(s8, 16, ln); s8 += sx(s8, 32, ln);
                        km[ai][bj] = fmaxf(km[ai][bj], s8); } }
                if (m & 1) asm volatile("" ::: "memory"); }
        if (kt) {
#pragma unroll
            for (int ai = 0; ai < 2; ++ai)
#pragma unroll
                for (int bj = 0; bj < 2; ++bj) { float v = km[ai][bj];
                    v = fmaxf(v, sx(v, 1, ln)); v = fmaxf(v, sx(v, 2, ln)); v = fmaxf(v, sx(v, 4, ln)); v = fmaxf(v, sx(v, 8, ln));
                    const int rt = u.pm * BM + ai * HALF + wr * 64, bb = rt >> 12, tile = (rt & 4095) >> 6, head = (u.pn - 4) * 2 + bj;
                    if (ln == 0) kn2[((((bb * 8 + head) * 2 + (wc >> 1)) * 64 + tile) << 1) + (wc & 1)] = v; }
        }
    }
};
struct EpiSwiGLU {
    static constexpr bool PERM = true, AFTER_DRAIN = false;
    bf16_t* H; const float* ss;
    __device__ __forceinline__ void operator()(const f32x4 (&acc)[2][2][4][2], const Unit& u, int wr, int wc, int fr, int fq) const {
        const int row0 = u.pm * BM + wr * 64 + fr, col0 = u.pn * HALF + wc * 32 + 8 * fq;
#pragma unroll
        for (int ai = 0; ai < 2; ++ai)
#pragma unroll
            for (int m = 0; m < 4; ++m) { const int row = row0 + ai * HALF + m * 16; const float rs = row_rs(ss, row, fq, fr);
                float o[8];
#pragma unroll
                for (int n = 0; n < 2; ++n)
#pragma unroll
                    for (int e = 0; e < 4; ++e) { const float g = acc[ai][0][m][n][e] * rs, up = acc[ai][1][m][n][e] * rs;
                        o[n * 4 + e] = g * __builtin_amdgcn_rcpf(1.0f + __builtin_amdgcn_exp2f(-g * LOG2E)) * up; }
                u32x4 w; w.x = cvt_pk_bf16(o[0], o[1]); w.y = cvt_pk_bf16(o[2], o[3]); w.z = cvt_pk_bf16(o[4], o[5]); w.w = cvt_pk_bf16(o[6], o[7]);
                *(u32x4*)(H + (size_t)row * FF + col0) = w;
                if (m & 1) asm volatile("" ::: "memory"); }
    }
};
struct EpiResid {
    static constexpr bool PERM = true, AFTER_DRAIN = false;
    const float* bf; float* of; bf16_t* hi; bf16_t* lo; float* ss;
    __device__ __forceinline__ void operator()(const f32x4 (&acc)[2][2][4][2], const Unit& u, int wr, int wc, int fr, int fq) const {
        const int row0 = u.pm * BM + wr * 64 + fr, col0 = u.pn * BM + wc * 32 + 8 * fq;
#pragma unroll
        for (int ai = 0; ai < 2; ++ai)
#pragma unroll
            for (int m = 0; m < 4; ++m) { const int row = row0 + ai * HALF + m * 16; const size_t off = (size_t)row * D + col0; float sq = 0.f;
#pragma unroll
                for (int bj = 0; bj < 2; ++bj) { const size_t o2 = off + bj * HALF; f32x4 v0, v1;
                    if (bf) { v0 = *(const f32x4*)(bf + o2); v1 = *(const f32x4*)(bf + o2 + 4); }
                    else { const u32x4 h = *(const u32x4*)(hi + o2), l = *(const u32x4*)(lo + o2);
                        v0[0] = __uint_as_float(h.x << 16) + __uint_as_float(l.x << 16); v0[1] = __uint_as_float(h.x & 0xffff0000u) + __uint_as_float(l.x & 0xffff0000u);
                        v0[2] = __uint_as_float(h.y << 16) + __uint_as_float(l.y << 16); v0[3] = __uint_as_float(h.y & 0xffff0000u) + __uint_as_float(l.y & 0xffff0000u);
                        v1[0] = __uint_as_float(h.z << 16) + __uint_as_float(l.z << 16); v1[1] = __uint_as_float(h.z & 0xffff0000u) + __uint_as_float(l.z & 0xffff0000u);
                        v1[2] = __uint_as_float(h.w << 16) + __uint_as_float(l.w << 16); v1[3] = __uint_as_float(h.w & 0xffff0000u) + __uint_as_float(l.w & 0xffff0000u); }
                    v0 = v0 + acc[ai][bj][m][0]; v1 = v1 + acc[ai][bj][m][1];
                    if (of) { *(f32x4*)(of + o2) = v0; *(f32x4*)(of + o2 + 4) = v1; }
                    else { u32x4 w; w.x = cvt_pk_bf16(v0[0], v0[1]); w.y = cvt_pk_bf16(v0[2], v0[3]); w.z = cvt_pk_bf16(v1[0], v1[1]); w.w = cvt_pk_bf16(v1[2], v1[3]);
                        u32x4 r; r.x = cvt_pk_bf16(v0[0] - __uint_as_float(w.x << 16), v0[1] - __uint_as_float(w.x & 0xffff0000u)); r.y = cvt_pk_bf16(v0[2] - __uint_as_float(w.y << 16), v0[3] - __uint_as_float(w.y & 0xffff0000u));
                        r.z = cvt_pk_bf16(v1[0] - __uint_as_float(w.z << 16), v1[1] - __uint_as_float(w.z & 0xffff0000u)); r.w = cvt_pk_bf16(v1[2] - __uint_as_float(w.w << 16), v1[3] - __uint_as_float(w.w & 0xffff0000u));
                        *(u32x4*)(hi + o2) = w; *(u32x4*)(lo + o2) = r; }
                    sq += ((v0[0] * v0[0] + v0[1] * v0[1]) + (v0[2] * v0[2] + v0[3] * v0[3])) + ((v1[0] * v1[0] + v1[1] * v1[1]) + (v1[2] * v1[2] + v1[3] * v1[3])); }
                { const int ln = fq * 16 + fr; sq += sx(sq, 16, ln); sq += sx(sq, 32, ln); }
                if (fq == 0) ss[(size_t)row * 16 + u.pn * 4 + wc] = sq;
                asm volatile("" ::: "memory"); }
    }
};
}

namespace at {
constexpr float THR = 8.0f;
__device__ __forceinline__ int crow(int r, int hi) { return (r & 3) + 8 * (r >> 2) + 4 * hi; }
template <int NB> __device__ __forceinline__ int v_st(int k, int c) { const int kk = (k & ~0xC) | ((k & 4) << 1) | ((k & 8) >> 1); return ((kk >> 3) * NB + (c >> 5)) * 512 + ((kk & 7) * 32 + (c & 31)) * 2; }
__device__ __forceinline__ int v_rd_base(int lane) { return ((lane & 3) << 3) | (((lane >> 2) & 3) << 6) | (((lane >> 4) & 1) << 5) | (((lane >> 5) & 1) << 8); }
template <int NB> constexpr int v_rd_off(int d0, int ks, int half) { return d0 * 512 + ks * (NB * 1024) + half * (NB * 512); }
template <int OFF> __device__ __forceinline__ s16x4 tr_read(int vb) { s16x4 r; asm volatile("ds_read_b64_tr_b16 %0, %1 offset:%2" : "=&v"(r) : "v"(vb), "i"(OFF) : "memory"); return r; }
template <int NB, int D0> __device__ __forceinline__ void pv_one(f32x16& od, int vb, bf16x8 pa0, bf16x8 pa1, bf16x8 pa2, bf16x8 pa3) {
    const s16x4 l0 = tr_read<v_rd_off<NB>(D0, 0, 0)>(vb), h0 = tr_read<v_rd_off<NB>(D0, 0, 1)>(vb), l1 = tr_read<v_rd_off<NB>(D0, 1, 0)>(vb), h1 = tr_read<v_rd_off<NB>(D0, 1, 1)>(vb);
    const s16x4 l2 = tr_read<v_rd_off<NB>(D0, 2, 0)>(vb), h2 = tr_read<v_rd_off<NB>(D0, 2, 1)>(vb), l3 = tr_read<v_rd_off<NB>(D0, 3, 0)>(vb), h3 = tr_read<v_rd_off<NB>(D0, 3, 1)>(vb);
    asm volatile("s_waitcnt lgkmcnt(0)" ::: "memory"); __builtin_amdgcn_sched_barrier(0);
#define AT_PK(L, H) (bf16x8){L[0], L[1], L[2], L[3], H[0], H[1], H[2], H[3]}
    od = __builtin_amdgcn_mfma_f32_32x32x16_bf16(pa0, AT_PK(l0, h0), od, 0, 0, 0);
    od = __builtin_amdgcn_mfma_f32_32x32x16_bf16(pa1, AT_PK(l1, h1), od, 0, 0, 0);
    od = __builtin_amdgcn_mfma_f32_32x32x16_bf16(pa2, AT_PK(l2, h2), od, 0, 0, 0);
    od = __builtin_amdgcn_mfma_f32_32x32x16_bf16(pa3, AT_PK(l3, h3), od, 0, 0, 0);
#undef AT_PK
}
__device__ __forceinline__ float slope_of(int h) { return __builtin_amdgcn_exp2f(-(float)(h + 1)); }

constexpr int L_SCR = 65536, L_TBL = 67584, L_X = 69632;

struct Ptrs { const bf16_t* qkv; bf16_t* att; bf16_t* obr; float* lse; const float* rpb; const float* subln; float lam; const float* kn; };

struct PolDil {
    static constexpr int W = 64, KIND = 0;
    int b, h, br, dil, res, qs0, tlo, thi; float nsl;
    __device__ __forceinline__ void init(int u) {
        br = u >> 11; const int v = u & 2047, sub = v & 15, bh = v >> 4; b = bh >> 3; h = bh & 7;
        dil = br == 0 ? 1 : (br == 1 ? 4 : 16); const int L = T / dil, nqb = L / 256;
        res = sub / nqb; qs0 = (sub % nqb) * 256;
        tlo = qs0 > 0 ? 0 : 1; thi = (qs0 + 256 < L) ? 6 : 5;
        nsl = -slope_of(h) * (float)dil * LOG2E;
    }
    __device__ __forceinline__ long qtok(int wid, int i) const { return (long)b * T + res + dil * (qs0 + 32 * wid + i); }
    __device__ __forceinline__ int qcol(int) const { return h * 64; }
    __device__ __forceinline__ int kcol0() const { return 512 + h * 64; }
    __device__ __forceinline__ int vcol0() const { return 1024 + h * 64; }
    __device__ __forceinline__ int kfrag(int) const { return 0; }
    __device__ __forceinline__ long ktok(int t, int row) const { return (long)b * T + res + dil * (qs0 - 64 + 64 * t + row); }
    __device__ __forceinline__ bool need(int t, int wid) const { return (64 * t - 64 <= 32 * wid + 95) && (64 * t - 1 >= 32 * wid - 64); }
    __device__ __forceinline__ void cinit(f32x16& p0, f32x16& p1, int t, int wid, int r32, int hi, const LAS float*, float m) const {
        const float base = (float)(32 * wid + r32 + 64 - 64 * t - 4 * hi);
#pragma unroll
        for (int r = 0; r < 16; ++r) { const float c = (float)((r & 3) + 8 * (r >> 2));
            const float a0 = fabsf(base - c), a1 = fabsf(base - (c + 32.f));
            p0[r] = a0 <= 64.f ? nsl * a0 - m : -INFINITY; p1[r] = a1 <= 64.f ? nsl * a1 - m : -INFINITY; }
    }
};
struct PolNat {
    static constexpr int W = 64, KIND = 1;
    int b, h, qb, r0, kr0, tlo, thi;
    __device__ __forceinline__ static int clip(int v, int lo, int hi_) { return v < lo ? lo : (v > hi_ ? hi_ : v); }
    __device__ __forceinline__ void init(int u) {
        qb = u & 15; const int bh = u >> 4; b = bh >> 3; h = bh & 7; r0 = 4 * qb;
        kr0 = clip(r0 - 4, 0, 56); tlo = 0; thi = clip(r0 - 1, 0, 56) + 8 - kr0;
    }
    __device__ __forceinline__ long qtok(int wid, int i) const { return (long)b * T + 256 * qb + 32 * wid + i; }
    __device__ __forceinline__ int qcol(int) const { return 1536 + h * 64; }
    __device__ __forceinline__ int kcol0() const { return 2048 + h * 64; }
    __device__ __forceinline__ int vcol0() const { return 2560 + h * 64; }
    __device__ __forceinline__ int kfrag(int) const { return 0; }
    __device__ __forceinline__ long ktok(int t, int row) const { return (long)b * T + 64 * (kr0 + t) + row; }
    __device__ __forceinline__ bool need(int t, int wid) const { const int r = r0 + (wid >> 1), rs = clip(r - 4, 0, 56), kr = kr0 + t; return kr >= rs && kr < rs + 8; }
    __device__ __forceinline__ void cinit(f32x16& p0, f32x16& p1, int t, int wid, int r32, int hi, const LAS float* tbl, float m) const {
        const int r = r0 + (wid >> 1), kr = kr0 + t, c = 32 * (wid & 1) + r32, wc = clip(c - 8, 0, 48);
        const LAS float* trow = tbl + (kr - r + 7) * 32;
#pragma unroll
        for (int q = 0; q < 16; ++q) { const int k0 = (q & 3) + 8 * (q >> 2) + 4 * hi, k1 = k0 + 32;
            const float v0 = trow[clip(k0 - c + 15, 0, 30)], v1 = trow[clip(k1 - c + 15, 0, 30)];
            p0[q] = ((unsigned)(k0 - wc) < 16u) ? v0 - m : -INFINITY; p1[q] = ((unsigned)(k1 - wc) < 16u) ? v1 - m : -INFINITY; }
    }
};
struct PolDiff {
    static constexpr int W = 128, KIND = 2;
    int b, h, qb, tlo, thi; float nsl;
    __device__ __forceinline__ void init(int u) { const int k = u >> 8, c0 = u & 255, c = (c0 & 7) * 32 + (c0 >> 3)  , r = (k >> 3) * 256 + c; h = k & 7; b = r >> 5; qb = r & 31; tlo = 0; thi = T / 64; nsl = -slope_of(h) * LOG2E; }
    __device__ __forceinline__ long qtok(int wid, int i) const { return (long)b * T + 128 * qb + 32 * (wid & 3) + i; }
    __device__ __forceinline__ int qcol(int wid) const { return h * 128 + 64 * (wid >> 2); }
    __device__ __forceinline__ int kcol0() const { return 1024 + h * 128; }
    __device__ __forceinline__ int vcol0() const { return 2048 + h * 128; }
    __device__ __forceinline__ int kfrag(int wid) const { return 64 * (wid >> 2); }
    __device__ __forceinline__ long ktok(int t, int row) const { return (long)b * T + 64 * t + row; }
    __device__ __forceinline__ bool need(int, int) const { return true; }
    template <int BLK> __device__ __forceinline__ void cinit_off(f32x16& p, int t, int wid, int r32, int hi) const {
        const float base = (float)(128 * qb + 32 * (wid & 3) + r32 - 64 * t - 4 * hi - 32 * BLK);
        const float sn = t < 2 * qb ? nsl : -nsl, A = sn * base, cf = -sn;
#pragma unroll
        for (int r = 0; r < 16; ++r) p[r] = fmaf(cf, (float)((r & 3) + 8 * (r >> 2)), A);
    }
    template <int BLK> __device__ __forceinline__ void cinit_abs(f32x16& p, int t, int wid, int r32, int hi) const {
        const float base = (float)(128 * qb + 32 * (wid & 3) + r32 - 64 * t - 4 * hi - 32 * BLK);
#pragma unroll
        for (int r = 0; r < 16; ++r) p[r] = nsl * fabsf(base - (float)((r & 3) + 8 * (r >> 2)));
    }
    __device__ __forceinline__ void cinit(f32x16& p0, f32x16& p1, int t, int wid, int r32, int hi, const LAS float*, float m) const {
        const int i0 = 128 * qb + 32 * (wid & 3);
        const float base = (float)(i0 + r32 - 64 * t - 4 * hi);
        if (64 * t + 63 < i0) {
            const float A = nsl * base - m, n2 = -nsl;
#pragma unroll
            for (int r = 0; r < 16; ++r) { const float c = (float)((r & 3) + 8 * (r >> 2)); p0[r] = fmaf(n2, c, A); p1[r] = fmaf(n2, c + 32.f, A); }
        } else if (64 * t > i0 + 31) {
            const float A = -nsl * base - m;
#pragma unroll
            for (int r = 0; r < 16; ++r) { const float c = (float)((r & 3) + 8 * (r >> 2)); p0[r] = fmaf(nsl, c, A); p1[r] = fmaf(nsl, c + 32.f, A); }
        } else {
#pragma unroll
            for (int r = 0; r < 16; ++r) { const float c = (float)((r & 3) + 8 * (r >> 2));
                p0[r] = nsl * fabsf(base - c) - m; p1[r] = nsl * fabsf(base - (c + 32.f)) - m; }
        }
    }
};

template <class Pol> __device__ __forceinline__ void attn_unit(const Pol& P, LAS unsigned char* lds, const Ptrs& X, bf16x8& pq0, bf16x8& pq1, bf16x8& pq2, bf16x8& pq3, bf16x8& pk_, bf16x8& pv_, bool have, const Pol& Pn, bool hasn);
template <class Pol>
__device__ __forceinline__ void attn_unit(const Pol& P, LAS unsigned char* lds, const Ptrs& X, bf16x8& pq0, bf16x8& pq1, bf16x8& pq2, bf16x8& pq3, bf16x8& pk_, bf16x8& pv_, bool have, const Pol& Pn, bool hasn) {
    constexpr int W = Pol::W, NB = W / 32, CH = W / 64, KBYTES = 64 * W * 2, VBYTES = KBYTES, CPR = W / 8;
    int tid_ = threadIdx.x; asm volatile("" : "+v"(tid_));
    const int tid = tid_, wid = __builtin_amdgcn_readfirstlane(tid >> 6), lane = tid & 63, r32 = lane & 31, hi = lane >> 5;
    LAS unsigned char* K_lds = lds; LAS unsigned char* V_lds = lds + 2 * KBYTES;
    LAS float* li_l = (LAS float*)(lds + L_SCR) + wid * 64; LAS float* al_l = li_l + 32;
    LAS float* tbl = (LAS float*)(lds + L_TBL);
    const bf16_t* qkv = X.qkv;
    if constexpr (Pol::KIND == 1) { if (tid < 480) { const int row = tid >> 5, col = tid & 31; tbl[tid] = col < 31 ? X.rpb[(P.h * 15 + row) * 31 + col] * LOG2E : 0.f; } }
    bf16x8 qr[4];
    const bool pre_ok = Pol::KIND == 0 && have;
    if (pre_ok) {
        qr[0] = pq0; qr[1] = pq1; qr[2] = pq2; qr[3] = pq3;
    } else { const bf16_t* qp = qkv + P.qtok(wid, r32) * NQKV + P.qcol(wid) + hi * 8;
#pragma unroll
      for (int d0 = 0; d0 < 4; ++d0) qr[d0] = *(const bf16x8*)(qp + d0 * 16); }
    const int kfb = P.kfrag(wid) * 2;
    bf16x8 ks[CH], vs[CH];
#define AT_SLOAD(t) do { _Pragma("unroll") for (int i_ = 0; i_ < CH; ++i_) { const int id_ = tid + 512 * i_, row_ = id_ / CPR, col_ = (id_ % CPR) * 8; \
        const bf16_t* g_ = qkv + P.ktok((t), row_) * NQKV + col_; ks[i_] = *(const bf16x8*)(g_ + P.kcol0()); vs[i_] = *(const bf16x8*)(g_ + P.vcol0()); } } while (0)
#define AT_SWRITE(b) do { _Pragma("unroll") for (int i_ = 0; i_ < CH; ++i_) { const int id_ = tid + 512 * i_, row_ = id_ / CPR, col_ = (id_ % CPR) * 8; \
        *(LAS bf16x8*)(K_lds + (b) * KBYTES + row_ * (W * 2) + ((col_ * 2) ^ ((row_ & 7) << 4))) = ks[i_]; \
        *(LAS bf16x8*)(V_lds + (b) * VBYTES + v_st<NB>(row_, col_)) = vs[i_]; } } while (0)
    float m_reg = 0.f, l_reg = 0.f; f32x16 o[NB];
#pragma unroll
    for (int d = 0; d < NB; ++d) o[d] = f32x16{};
    const int vb0 = (int)(unsigned)(size_t)V_lds + v_rd_base(lane);
    const int tlo = P.tlo, thi = P.thi;
    if (pre_ok) { ks[0] = pk_; vs[0] = pv_; } else AT_SLOAD(tlo);
    AT_SWRITE(tlo & 1); __syncthreads();
    for (int t = tlo; t < thi; ++t) {
        const int buf = t & 1;
        if constexpr (Pol::KIND != 2) { if (t + 1 < thi) AT_SLOAD(t + 1); }
        if constexpr (Pol::KIND == 0) { if (t + 1 == thi && hasn) {
            const bf16_t* qp = qkv + Pn.qtok(wid, r32) * NQKV + Pn.qcol(wid) + hi * 8;
            pq0 = *(const bf16x8*)(qp); pq1 = *(const bf16x8*)(qp + 16); pq2 = *(const bf16x8*)(qp + 32); pq3 = *(const bf16x8*)(qp + 48);
            const int row_ = tid / CPR, col_ = (tid % CPR) * 8; const bf16_t* g_ = qkv + Pn.ktok(Pn.tlo, row_) * NQKV + col_;
            pk_ = *(const bf16x8*)(g_ + Pn.kcol0()); pv_ = *(const bf16x8*)(g_ + Pn.vcol0()); } }
        if (P.need(t, wid)) {
            f32x16 p0, p1;
            P.cinit(p0, p1, t, wid, r32, hi, tbl, m_reg);
            const LAS unsigned char* Kb = K_lds + buf * KBYTES;
#pragma unroll
            for (int d0 = 0; d0 < 4; ++d0) { const int cb = kfb + (d0 * 16 + hi * 8) * 2, sw = cb ^ ((r32 & 7) << 4);
                const bf16x8 b0 = *(const LAS bf16x8*)(Kb + r32 * (W * 2) + sw);
                const bf16x8 b1 = *(const LAS bf16x8*)(Kb + (32 + r32) * (W * 2) + sw);
                p0 = __builtin_amdgcn_mfma_f32_32x32x16_bf16(b0, qr[d0], p0, 0, 0, 0);
                p1 = __builtin_amdgcn_mfma_f32_32x32x16_bf16(b1, qr[d0], p1, 0, 0, 0); }
            float pmax = fmaxf(p0[0], p1[0]);
#pragma unroll
            for (int r = 1; r < 16; ++r) pmax = fmaxf(fmaxf(pmax, p0[r]), p1[r]);
            { auto rr = __builtin_amdgcn_permlane32_swap(__float_as_uint(pmax), __float_as_uint(pmax), false, false);
              pmax = fmaxf(__uint_as_float(rr[0]), __uint_as_float(rr[1])); }
            float alpha = 1.f;
            if (__builtin_expect(!__all(pmax <= THR), 0)) {
                const float dm = fmaxf(pmax, 0.f); alpha = __builtin_amdgcn_exp2f(-dm); m_reg += dm;
#pragma unroll
                for (int r = 0; r < 16; ++r) { p0[r] -= dm; p1[r] -= dm; }
            }
            float ps = 0.f;
#pragma unroll
            for (int r = 0; r < 16; ++r) { p0[r] = __builtin_amdgcn_exp2f(p0[r]); p1[r] = __builtin_amdgcn_exp2f(p1[r]); ps += p0[r] + p1[r]; }
            { auto rr = __builtin_amdgcn_permlane32_swap(__float_as_uint(ps), __float_as_uint(ps), false, false);
              ps = __uint_as_float(rr[0]) + __uint_as_float(rr[1]); }
            l_reg = l_reg * alpha + ps;
            if (__any(alpha < 1.f)) { if (hi == 0) al_l[r32] = alpha; asm volatile("s_waitcnt lgkmcnt(0)" ::: "memory");
#pragma unroll
                for (int r = 0; r < 16; ++r) { const float a = al_l[crow(r, hi)];
#pragma unroll
                    for (int d = 0; d < NB; ++d) o[d][r] *= a; }
                asm volatile("s_waitcnt lgkmcnt(0)" ::: "memory"); }
            bf16x8 pa0, pa1, pa2, pa3;
#define AT_PK4(PP, BASE, OUT) do { unsigned a0 = cvtpk(PP[BASE + 0], PP[BASE + 1]), a1 = cvtpk(PP[BASE + 2], PP[BASE + 3]); \
    unsigned b0_ = cvtpk(PP[BASE + 4], PP[BASE + 5]), b1_ = cvtpk(PP[BASE + 6], PP[BASE + 7]); \
    auto r0_ = __builtin_amdgcn_permlane32_swap(a0, b0_, false, false); auto r1_ = __builtin_amdgcn_permlane32_swap(a1, b1_, false, false); \
    u32x4 w_ = {r0_[0], r1_[0], r0_[1], r1_[1]}; OUT = *reinterpret_cast<bf16x8*>(&w_); } while (0)
            AT_PK4(p0, 0, pa0); AT_PK4(p0, 8, pa1); AT_PK4(p1, 0, pa2); AT_PK4(p1, 8, pa3);
#undef AT_PK4
            const int vb = vb0 + buf * VBYTES;
            pv_one<NB, 0>(o[0], vb, pa0, pa1, pa2, pa3); pv_one<NB, 1>(o[1], vb, pa0, pa1, pa2, pa3);
            if constexpr (NB == 4) { pv_one<NB, 2>(o[2], vb, pa0, pa1, pa2, pa3); pv_one<NB, 3>(o[3], vb, pa0, pa1, pa2, pa3); }
        }
        if (t + 1 < thi) { if constexpr (Pol::KIND == 2) AT_SLOAD(t + 1); AT_SWRITE(buf ^ 1); }
        __syncthreads();
    }
#undef AT_SLOAD
#undef AT_SWRITE
    if (hi == 0) li_l[r32] = l_reg;
    asm volatile("s_waitcnt lgkmcnt(0)" ::: "memory");
    float rli[16];
#pragma unroll
    for (int r = 0; r < 16; ++r) rli[r] = __builtin_amdgcn_rcpf(li_l[crow(r, hi)]);
    if constexpr (Pol::KIND == 0) {
        bf16_t* ob = X.obr + (size_t)P.br * ((size_t)M * 512);
#pragma unroll
        for (int r = 0; r < 16; ++r) { const long tok = P.qtok(wid, crow(r, hi));
#pragma unroll
            for (int d = 0; d < NB; ++d) ob[tok * 512 + P.h * 64 + d * 32 + r32] = (bf16_t)(cvtpk(o[d][r] * rli[r], 0.f) & 0xffffu); }
        if (hi == 0) X.lse[(size_t)P.br * ((size_t)M * 8) + P.qtok(wid, r32) * 8 + P.h] = m_reg + __builtin_amdgcn_logf(l_reg);
    } else if constexpr (Pol::KIND == 1) {
#pragma unroll
        for (int r = 0; r < 16; ++r) { const long tok = P.qtok(wid, crow(r, hi));
#pragma unroll
            for (int d = 0; d < NB; ++d) X.att[tok * D + 512 + P.h * 64 + d * 32 + r32] = (bf16_t)(cvtpk(o[d][r] * rli[r], 0.f) & 0xffffu); }
    } else {
        LAS float* XB = (LAS float*)(lds + L_X);
        if (wid >= 4) {
#pragma unroll
            for (int r = 0; r < 16; ++r) { const int row = 32 * (wid & 3) + crow(r, hi);
#pragma unroll
                for (int d = 0; d < NB; ++d) XB[row * 128 + d * 32 + r32] = X.lam * o[d][r] * rli[r]; }
        }
        __syncthreads();
        if (wid < 4) {
#pragma unroll
            for (int r = 0; r < 16; ++r) { const int row = 32 * wid + crow(r, hi); float s = 0.f;
#pragma unroll
                for (int d = 0; d < NB; ++d) { const float y = o[d][r] * rli[r] - XB[row * 128 + d * 32 + r32]; o[d][r] = y; s += y * y; }
                s += sx(s, 1, lane); s += sx(s, 2, lane); s += sx(s, 4, lane); s += sx(s, 8, lane); s += sx(s, 16, lane);
                const float rs = (1.0f - LAM_INIT) / sqrtf(s * (1.0f / 128.f) + SUBLN_EPS);
                const long tok = P.qtok(wid, crow(r, hi));
#pragma unroll
                for (int d = 0; d < NB; ++d) X.att[tok * D + P.h * 128 + d * 32 + r32] = (bf16_t)(cvtpk(o[d][r] * rs * X.subln[d * 32 + r32], 0.f) & 0xffffu); }
        }
        __syncthreads();
    }
}

template <class Pol> __device__ __forceinline__ void attn_unit(const Pol& P, LAS unsigned char* lds, const Ptrs& X) { bf16x8 z0_ = {}, z1_ = {}, z2_ = {}, z3_ = {}, z4_ = {}, z5_ = {}; attn_unit(P, lds, X, z0_, z1_, z2_, z3_, z4_, z5_, false, P, false); }
typedef __bf16 bf16x2_t __attribute__((ext_vector_type(2)));
typedef float f32x2_t __attribute__((ext_vector_type(2)));
__device__ __forceinline__ unsigned pk2(float lo, float hi) { const f32x2_t v = {lo, hi}; return __builtin_bit_cast(unsigned, __builtin_convertvector(v, bf16x2_t)); }
__device__ __forceinline__ s16x4 trb(const LAS unsigned char* p) { return __builtin_amdgcn_ds_read_tr16_b64_v4i16((LAS s16x4*)p); }
template <int D0> __device__ __forceinline__ void pv_blk(f32x16& od, const LAS unsigned char* vb, bf16x8 pa0, bf16x8 pa1, bf16x8 pa2, bf16x8 pa3) {
    constexpr int NB = 4;
    const s16x4 l0 = trb(vb + v_rd_off<NB>(D0, 0, 0)), h0 = trb(vb + v_rd_off<NB>(D0, 0, 1)), l1 = trb(vb + v_rd_off<NB>(D0, 1, 0)), h1 = trb(vb + v_rd_off<NB>(D0, 1, 1));
    const s16x4 l2 = trb(vb + v_rd_off<NB>(D0, 2, 0)), h2 = trb(vb + v_rd_off<NB>(D0, 2, 1)), l3 = trb(vb + v_rd_off<NB>(D0, 3, 0)), h3 = trb(vb + v_rd_off<NB>(D0, 3, 1));
#define AT_PK(L, H) (bf16x8){L[0], L[1], L[2], L[3], H[0], H[1], H[2], H[3]}
    od = __builtin_amdgcn_mfma_f32_32x32x16_bf16(pa0, AT_PK(l0, h0), od, 0, 0, 0);
    od = __builtin_amdgcn_mfma_f32_32x32x16_bf16(pa1, AT_PK(l1, h1), od, 0, 0, 0);
    od = __builtin_amdgcn_mfma_f32_32x32x16_bf16(pa2, AT_PK(l2, h2), od, 0, 0, 0);
    od = __builtin_amdgcn_mfma_f32_32x32x16_bf16(pa3, AT_PK(l3, h3), od, 0, 0, 0);
#undef AT_PK
}
constexpr int DF_SCR = 98304;
__device__ __forceinline__ void diff_unit(const PolDiff& P, LAS unsigned char* lds, const Ptrs& X) {
    constexpr int W = 128, NB = 4, CH = 2, KBYTES = 64 * W * 2, VBYTES = KBYTES, NT = T / 64;
    int tid_ = threadIdx.x; asm volatile("" : "+v"(tid_));
    const int tid = tid_, wid = __builtin_amdgcn_readfirstlane(tid >> 6), lane = tid & 63, r32 = lane & 31, hi = lane >> 5;
    LAS unsigned char* K_lds = lds; LAS unsigned char* V_lds = lds + 3 * KBYTES;
    LAS float* li_l = (LAS float*)(lds + DF_SCR) + wid * 64;
    LAS unsigned* flag = (LAS unsigned*)(lds + DF_SCR + 8 * 256);
    const bf16_t* qkv = X.qkv;
    bf16x8 qr[4];
    { const bf16_t* qp = qkv + P.qtok(wid, r32) * NQKV + P.qcol(wid) + hi * 8;
#pragma unroll
      for (int d0 = 0; d0 < 4; ++d0) qr[d0] = *(const bf16x8*)(qp + d0 * 16); }
    const int kfb = P.kfrag(wid) * 2;
    int gko, gvo;
    { const int row = 4 * wid + (lane >> 4), c = (lane & 15) ^ (row & 7); gko = row * NQKV + P.kcol0() + 8 * c; }
    { const int sidx = 2 * wid + (lane >> 5), kk = 8 * (sidx >> 2) + ((lane & 31) >> 2), k = (kk & ~0xC) | ((kk & 4) << 1) | ((kk & 8) >> 1), c = 32 * (sidx & 3) + 8 * (lane & 3);
      gvo = k * NQKV + P.vcol0() + c; }
    const bf16_t* gtile = qkv + (long)P.b * T * NQKV;
    const LAS unsigned char* krd = K_lds + r32 * (W * 2);
    const LAS unsigned char* vrd = V_lds + v_rd_base(lane);
    if (tid == 0) flag[0] = 0u;
    int t_lo, n_tiles;
    { float q2 = 0.f;
#pragma unroll
      for (int d0 = 0; d0 < 4; ++d0)
#pragma unroll
          for (int e = 0; e < 8; ++e) { const float f = bf2f((unsigned short)qr[d0][e]); q2 = fmaf(f, f, q2); }
      q2 += sx(q2, 32, lane);
#pragma unroll
      for (int o_ = 1; o_ < 32; o_ <<= 1) q2 = fmaxf(q2, sx(q2, o_, lane));
      if (lane == 0) li_l[0] = q2;
      __syncthreads();
      float qm1 = 0.f, qm2 = 0.f;
#pragma unroll
      for (int w_ = 0; w_ < 4; ++w_) { qm1 = fmaxf(qm1, ((LAS float*)(lds + DF_SCR))[w_ * 64]); qm2 = fmaxf(qm2, ((LAS float*)(lds + DF_SCR))[(w_ + 4) * 64]); }
      qm1 = sqrtf(qm1) * 1.01f; qm2 = sqrtf(qm2) * 1.01f;
      const float* kn = X.kn + ((P.b * 8 + P.h) * 2) * 128;
      const float k1_ = sqrtf(kn[2 * lane] + kn[2 * lane + 1]) * 1.001f, k2_ = sqrtf(kn[128 + 2 * lane] + kn[128 + 2 * lane + 1]) * 1.001f;
      const float sb = fmaxf(qm1 * k1_, qm2 * k2_);
      const int i0u = 128 * P.qb;
      const int dist = lane < 2 * P.qb ? i0u - (64 * lane + 63) : (lane > 2 * P.qb + 1 ? 64 * lane - (i0u + 127) : 0);
      const bool visit = sb + P.nsl * (float)dist > -152.f;
      const unsigned long long mask = __ballot(visit) | (3ull << (2 * P.qb));
      int lo = __builtin_ctzll(mask), hi_t = 63 - __builtin_clzll(mask);
      if (((hi_t - lo + 1) & 1) != 0) { if (lo > 0) --lo; else ++hi_t; }
      if (hi_t - lo + 1 < 4) { if (lo > 1) lo -= 2; else hi_t += 2; }
      t_lo = __builtin_amdgcn_readfirstlane(lo); n_tiles = __builtin_amdgcn_readfirstlane(hi_t - lo + 1);
      __syncthreads();
    }
#define DF_TL(k) ((k) < 2 ? 2 * P.qb + (k) : (t_lo + (k) - 2 < 2 * P.qb ? t_lo + (k) - 2 : t_lo + (k)))
#define DF_GLDS(k, rb) do { const bf16_t* g_ = gtile + (long)(64 * DF_TL(k)) * NQKV; _Pragma("unroll") for (int i_ = 0; i_ < 2; ++i_) { \
        __builtin_amdgcn_global_load_lds((const unsigned*)(g_ + gko + i_ * (32 * NQKV)), (LAS unsigned*)(K_lds + (rb) * KBYTES + (wid + 8 * i_) * 1024), 16, 0, 0); \
        __builtin_amdgcn_global_load_lds((const unsigned*)(g_ + gvo + i_ * (32 * NQKV)), (LAS unsigned*)(V_lds + (rb) * VBYTES + (wid + 8 * i_) * 1024), 16, 0, 0); } } while (0)
#define DF_QK(p0, p1, rb) do { const LAS unsigned char* Kb_ = krd + (rb) * KBYTES; \
        _Pragma("unroll") for (int d0 = 0; d0 < 4; ++d0) { const int sw_ = (kfb + (d0 * 16 + hi * 8) * 2) ^ ((r32 & 7) << 4); \
            const bf16x8 b0_ = *(const LAS bf16x8*)(Kb_ + sw_); const bf16x8 b1_ = *(const LAS bf16x8*)(Kb_ + 32 * (W * 2) + sw_); \
            p0 = __builtin_amdgcn_mfma_f32_32x32x16_bf16(b0_, qr[d0], p0, 0, 0, 0); p1 = __builtin_amdgcn_mfma_f32_32x32x16_bf16(b1_, qr[d0], p1, 0, 0, 0); } } while (0)
#define DF_KRD(b0v, b1v, rb, d0) do { const LAS unsigned char* Kb_ = krd + (rb) * KBYTES; const int sw_ = (kfb + ((d0) * 16 + hi * 8) * 2) ^ ((r32 & 7) << 4); \
        b0v = *(const LAS bf16x8*)(Kb_ + sw_); b1v = *(const LAS bf16x8*)(Kb_ + 32 * (W * 2) + sw_); } while (0)
#define DF_KMM(p0, p1, b0v, b1v, d0) do { p0 = __builtin_amdgcn_mfma_f32_32x32x16_bf16(b0v, qr[d0], p0, 0, 0, 0); p1 = __builtin_amdgcn_mfma_f32_32x32x16_bf16(b1v, qr[d0], p1, 0, 0, 0); } while (0)
#define DF_QK1(p0, p1, rb, d0) do { const LAS unsigned char* Kb_ = krd + (rb) * KBYTES; const int sw_ = (kfb + ((d0) * 16 + hi * 8) * 2) ^ ((r32 & 7) << 4); \
        const bf16x8 b0_ = *(const LAS bf16x8*)(Kb_ + sw_); const bf16x8 b1_ = *(const LAS bf16x8*)(Kb_ + 32 * (W * 2) + sw_); \
        p0 = __builtin_amdgcn_mfma_f32_32x32x16_bf16(b0_, qr[d0], p0, 0, 0, 0); p1 = __builtin_amdgcn_mfma_f32_32x32x16_bf16(b1_, qr[d0], p1, 0, 0, 0); } while (0)
#define DF_SUM16(p) ((((p[0] + p[1]) + (p[2] + p[3])) + ((p[4] + p[5]) + (p[6] + p[7]))) + (((p[8] + p[9]) + (p[10] + p[11])) + ((p[12] + p[13]) + (p[14] + p[15]))))
#define DF_EXP_H(pp, b8) do { _Pragma("unroll") for (int r = 0; r < 8; ++r) pp[(b8) + r] = __builtin_amdgcn_exp2f(pp[(b8) + r]); } while (0)
#define DF_EXP_A(p0, p1) do { _Pragma("unroll") for (int r = 0; r < 16; ++r) p0[r] = __builtin_amdgcn_exp2f(p0[r]); _Pragma("unroll") for (int r = 0; r < 8; ++r) p1[r] = __builtin_amdgcn_exp2f(p1[r]); } while (0)
#define DF_FINISH(p0, p1) do { _Pragma("unroll") for (int r = 8; r < 16; ++r) p1[r] = __builtin_amdgcn_exp2f(p1[r]); \
        float ps_ = 0.f; _Pragma("unroll") for (int r = 0; r < 16; ++r) ps_ += p0[r] + p1[r]; l_reg += ps_; \
        DF_PK4(p0, 0, pa0); DF_PK4(p0, 8, pa1); DF_PK4(p1, 0, pa2); DF_PK4(p1, 8, pa3); } while (0)
#define DF_PK4(PP, BASE, OUT) do { unsigned a0 = pk2(PP[BASE + 0], PP[BASE + 1]), a1 = pk2(PP[BASE + 2], PP[BASE + 3]); \
    unsigned b0_ = pk2(PP[BASE + 4], PP[BASE + 5]), b1_ = pk2(PP[BASE + 6], PP[BASE + 7]); \
    auto r0_ = __builtin_amdgcn_permlane32_swap(a0, b0_, false, false); auto r1_ = __builtin_amdgcn_permlane32_swap(a1, b1_, false, false); \
    u32x4 w_ = {r0_[0], r1_[0], r0_[1], r1_[1]}; OUT = *reinterpret_cast<bf16x8*>(&w_); } while (0)
#define DF_PV(rb) do { const LAS unsigned char* vb_ = vrd + (rb) * VBYTES; pv_blk<0>(o[0], vb_, pa0, pa1, pa2, pa3); pv_blk<1>(o[1], vb_, pa0, pa1, pa2, pa3); \
        pv_blk<2>(o[2], vb_, pa0, pa1, pa2, pa3); pv_blk<3>(o[3], vb_, pa0, pa1, pa2, pa3); } while (0)
#define DF_HALF(c0, c1, q0, q1, j, LOADS) do { \
        DF_KRD(ka0, ka1, rc, 0); if (LOADS) DF_GLDS((j) + 1, rn); __builtin_amdgcn_sched_barrier(0);     \
        { float ps0_ = 0.f, ps1_ = 0.f; \
          DF_KRD(kb0, kb1, rc, 1); DF_KMM(c0, c1, ka0, ka1, 0); DF_EXP_H(q1, 8); __builtin_amdgcn_sched_barrier(0); \
          DF_KRD(ka0, ka1, rc, 2); DF_KMM(c0, c1, kb0, kb1, 1); ps0_ = DF_SUM16(q0); DF_PK4(q0, 0, pa0); __builtin_amdgcn_sched_barrier(0); \
          DF_KRD(kb0, kb1, rc, 3); DF_KMM(c0, c1, ka0, ka1, 2); ps1_ = DF_SUM16(q1); DF_PK4(q0, 8, pa1); __builtin_amdgcn_sched_barrier(0); \
          DF_KMM(c0, c1, kb0, kb1, 3); l_reg += ps0_ + ps1_; DF_PK4(q1, 0, pa2); DF_PK4(q1, 8, pa3); __builtin_amdgcn_sched_barrier(0); } \
        { const LAS unsigned char* vb_ = vrd + rp * VBYTES; \
          pv_blk<0>(o[0], vb_, pa0, pa1, pa2, pa3); DF_EXP_H(c0, 0); __builtin_amdgcn_sched_barrier(0); \
          pv_blk<1>(o[1], vb_, pa0, pa1, pa2, pa3); DF_EXP_H(c0, 8); __builtin_amdgcn_sched_barrier(0); \
          pv_blk<2>(o[2], vb_, pa0, pa1, pa2, pa3); DF_EXP_H(c1, 0); if (LOADS) P.cinit_off<0>(q0, DF_TL((j) + 1), wid, r32, hi); __builtin_amdgcn_sched_barrier(0); \
          pv_blk<3>(o[3], vb_, pa0, pa1, pa2, pa3); if (LOADS) P.cinit_off<1>(q1, DF_TL((j) + 1), wid, r32, hi); __builtin_amdgcn_sched_barrier(0); } \
        __syncthreads(); { const int t_ = rp; rp = rc; rc = rn; rn = t_; } } while (0)
    float l_reg = 0.f; f32x16 o[NB];
#pragma unroll
    for (int d = 0; d < NB; ++d) o[d] = f32x16{};
    f32x16 pA0, pA1, pB0, pB1; bf16x8 pa0, pa1, pa2, pa3, ka0, ka1, kb0, kb1;
    int rp = 2, rc = 0, rn = 1;
    DF_GLDS(0, 0); DF_GLDS(1, 1); __syncthreads();
    P.cinit_abs<0>(pA0, DF_TL(0), wid, r32, hi); P.cinit_abs<1>(pA1, DF_TL(0), wid, r32, hi); DF_QK(pA0, pA1, 0); DF_EXP_A(pA0, pA1);
    P.cinit_abs<0>(pB0, DF_TL(1), wid, r32, hi); P.cinit_abs<1>(pB1, DF_TL(1), wid, r32, hi);
    rp = 0; rc = 1; rn = 2;
    { int j = 1;
      do { DF_HALF(pB0, pB1, pA0, pA1, j, true);
           DF_HALF(pA0, pA1, pB0, pB1, j + 1, true); j += 2; } while (j + 2 < n_tiles); }
    DF_HALF(pB0, pB1, pA0, pA1, n_tiles - 1, false);
    DF_FINISH(pB0, pB1); DF_PV(rp);
#undef DF_GLDS
#undef DF_TL
#undef DF_QK
#undef DF_EXP_A
#undef DF_QK1
#undef DF_KRD
#undef DF_KMM
#undef DF_SUM16
#undef DF_EXP_H
#undef DF_FINISH
#undef DF_PK4
#undef DF_PV
#undef DF_HALF
    int tid2_ = threadIdx.x; asm volatile("" : "+v"(tid2_));
    const int lane2 = tid2_ & 63, r32b = lane2 & 31, hib = lane2 >> 5;
    { auto rr = __builtin_amdgcn_permlane32_swap(__float_as_uint(l_reg), __float_as_uint(l_reg), false, false);
      l_reg = __uint_as_float(rr[0]) + __uint_as_float(rr[1]); }
    const bool bad = !(l_reg > 7.9e-31f && l_reg < 1.2e30f);
    if (__any(bad) && lane2 == 0) flag[0] = 1u;
    __syncthreads();
    const bool redo = __builtin_amdgcn_readfirstlane((int)flag[0]) != 0;
    __syncthreads();
    if (redo) { attn_unit(P, lds, X); return; }
    if (hib == 0) li_l[r32b] = l_reg;
    asm volatile("s_waitcnt lgkmcnt(0)" ::: "memory");
    float rli[16];
#pragma unroll
    for (int r = 0; r < 16; ++r) rli[r] = __builtin_amdgcn_rcpf(li_l[crow(r, hib)]);
    LAS float* XB = (LAS float*)lds;
    if (wid >= 4) {
#pragma unroll
        for (int r = 0; r < 16; ++r) { const int row = 32 * (wid & 3) + crow(r, hib);
#pragma unroll
            for (int d = 0; d < NB; ++d) XB[row * 128 + d * 32 + r32b] = X.lam * o[d][r] * rli[r]; }
    }
    __syncthreads();
    if (wid < 4) {
#pragma unroll
        for (int r = 0; r < 16; ++r) { const int row = 32 * wid + crow(r, hib); float s = 0.f;
#pragma unroll
            for (int d = 0; d < NB; ++d) { const float y = o[d][r] * rli[r] - XB[row * 128 + d * 32 + r32b]; o[d][r] = y; s += y * y; }
            s += sx(s, 1, lane2); s += sx(s, 2, lane2); s += sx(s, 4, lane2); s += sx(s, 8, lane2); s += sx(s, 16, lane2);
            const float rs = (1.0f - LAM_INIT) / sqrtf(s * (1.0f / 128.f) + SUBLN_EPS);
            const long tok = P.qtok(wid, crow(r, hib));
#pragma unroll
            for (int d = 0; d < NB; ++d) X.att[tok * D + P.h * 128 + d * 32 + r32b] = (bf16_t)(pk2(o[d][r] * rs * X.subln[d * 32 + r32b], 0.f) & 0xffffu); }
    }
    __syncthreads();
}
}

#define XB_TMO      128
#define XB_XCNT(j)  (256  + 64 * (j))
#define XB_XSUB(j)  (1280 + 64 * (j))
#define XB_XGEN(j)  (2304 + 64 * (j))
#define XB_TOP      3328
#define XB_TOPGEN   3392
#define XCD_BAR_WORDS 3456
#define XB_SPIN_CAP (1u << 18)

__device__ __forceinline__ unsigned xb_ld(unsigned* p)              { return __hip_atomic_load(p, __ATOMIC_RELAXED, __HIP_MEMORY_SCOPE_AGENT); }
__device__ __forceinline__ unsigned xb_add(unsigned* p, unsigned v) { return __hip_atomic_fetch_add(p, v, __ATOMIC_RELAXED, __HIP_MEMORY_SCOPE_AGENT); }
__device__ __forceinline__ unsigned xb_xcc_id() { return (unsigned)__builtin_amdgcn_s_getreg((3 << 11) | 20) & 0xFu; }
#define XB_SPIN(cond, bar) do { unsigned _sp = 0; while (cond) { __builtin_amdgcn_s_sleep(1); \
    if ((++_sp & 255u) == 0u) { if (xb_ld(&(bar)[XB_TMO])) break; if (_sp > XB_SPIN_CAP) { atomicAdd(&(bar)[XB_TMO], 1u); break; } } } } while (0)

struct XcdBarrier {
    unsigned* bar; unsigned x;
    volatile LAS unsigned* st;
};

__device__ __forceinline__ XcdBarrier xcd_barrier_post(unsigned* bar, volatile LAS unsigned* st) {
    XcdBarrier b; b.bar = bar; b.x = xb_xcc_id(); b.st = st;
    if (threadIdx.x == 0) (void)xb_add(&bar[XB_XCNT(b.x)], 1u);
    return b;
}
__device__ __forceinline__ void xcd_barrier_complete(unsigned* bar, unsigned x, unsigned& nloc, unsigned& nx) {
    const unsigned G = gridDim.x * gridDim.y * gridDim.z;
    unsigned sum, cnt, mine, sp = 0u;
    for (;;) {
        sum = 0u; cnt = 0u; mine = 0u;
#pragma unroll
        for (unsigned j = 0; j < 16; ++j) { const unsigned c = xb_ld(&bar[XB_XCNT(j)]); sum += c; cnt += (c > 0u) ? 1u : 0u; mine = (j == x) ? c : mine; }
        if (sum == G) break;
        __builtin_amdgcn_s_sleep(1);
        if ((++sp & 255u) == 0u) { if (xb_ld(&bar[XB_TMO])) break; if (sp > XB_SPIN_CAP) { atomicAdd(&bar[XB_TMO], 1u); break; } }
    }
    nloc = mine > 0u ? mine : 1u; nx = cnt > 0u ? cnt : 1u;
}

__device__ __forceinline__ void xcd_barrier(const XcdBarrier& b) {
    asm volatile("s_waitcnt vmcnt(0)" ::: "memory");
    __syncthreads();
    if (threadIdx.x == 0) {
        unsigned* bar = b.bar;
        __builtin_amdgcn_s_waitcnt(0);
        unsigned nloc = b.st[0], nx = b.st[1];
        if (nloc == 0u) { xcd_barrier_complete(bar, b.x, nloc, nx); b.st[0] = nloc; b.st[1] = nx; }
        const unsigned old = xb_add(&bar[XB_XSUB(b.x)], 1u);
        const unsigned gen = old / nloc;
        if (old + 1u == (gen + 1u) * nloc) {
            __builtin_amdgcn_fence(__ATOMIC_RELEASE, "agent");
            asm volatile("s_waitcnt vmcnt(0)" ::: "memory");
            const unsigned og = xb_add(&bar[XB_TOP], 1u);
            const unsigned tg = og / nx;
            if (og + 1u == (tg + 1u) * nx) xb_add(&bar[XB_TOPGEN], 1u);
            else XB_SPIN(xb_ld(&bar[XB_TOPGEN]) == tg, bar);
            __builtin_amdgcn_fence(__ATOMIC_ACQUIRE, "agent");
            xb_add(&bar[XB_XGEN(b.x)], 1u);
            asm volatile("s_waitcnt vmcnt(0)" ::: "memory");
        } else {
            XB_SPIN(xb_ld(&bar[XB_XGEN(b.x)]) == gen, bar);
            __builtin_amdgcn_fence(__ATOMIC_ACQUIRE, "agent");
            asm volatile("s_waitcnt vmcnt(0)" ::: "memory");
        }
    }
    __syncthreads();
}

__device__ __forceinline__ void grp_barrier(unsigned* cnt, unsigned& epoch, unsigned nmem) {
    asm volatile("s_waitcnt vmcnt(0)" ::: "memory");
    __syncthreads();
    epoch += 1u;
    if (threadIdx.x == 0) {
        __builtin_amdgcn_fence(__ATOMIC_RELEASE, "agent"); asm volatile("s_waitcnt vmcnt(0)" ::: "memory");
        (void)xb_add(cnt, 1u);
        const unsigned target = nmem * epoch; unsigned sp = 0u;
        while (xb_ld(cnt) < target) { __builtin_amdgcn_s_sleep(1); if (++sp > (1u << 22)) break; }
        __builtin_amdgcn_fence(__ATOMIC_ACQUIRE, "agent"); asm volatile("s_waitcnt vmcnt(0)" ::: "memory");
    }
    __syncthreads();
}

constexpr size_t MiB = 1u << 20;
constexpr size_t WS_W = 2 * MiB, WS_WL = 26 * MiB;
constexpr size_t WO_IN = 0, WO_O = 6 * MiB, WO_GU = 8 * MiB, WO_D = 19 * MiB;
constexpr size_t WS_BAR = 512 * 1024, WS_BAR_BYTES = 32768;
constexpr size_t WS_KN = 0;
constexpr size_t WS_SS = 56 * MiB, WS_LSE = 60 * MiB, WS_XB = 68 * MiB, WS_ATT = 196 * MiB, WS_OBR = 324 * MiB, WS_QKV = 516 * MiB, WS_H = WS_QKV, WS_END = 900 * MiB;
constexpr int LDS_BYTES = 147456;

struct Args { const float* in[22]; float* out; unsigned char* ws; int ph_lo, ph_hi; };
enum { I_X = 0, I_A0N = 1, I_A0IN = 2, I_A0OUT = 3, I_RPB = 4, I_F0N = 5, I_F0G = 6, I_F0U = 7, I_F0D = 8, I_A1N = 9, I_A1QKV = 10, I_A1OUT = 11,
       I_LQ1 = 12, I_LK1 = 13, I_LQ2 = 14, I_LK2 = 15, I_SUBLN = 16, I_F1N = 17, I_F1G = 18, I_F1U = 19, I_F1D = 20, I_FN = 21 };
constexpr int NPH = 14;

__device__ __forceinline__ float wave_sum(float v, int lane) {
#pragma unroll
    for (int o = 1; o < 64; o <<= 1) v += sx(v, o, lane);
    return v;
}
__device__ __forceinline__ void transpose_item(const float* W, const float* gain, int K, int N, bf16_t* WT, int mode, LAS float* scr, int item, int lane) {
    const int nblk = N / 32, kb = item / nblk, nb = item % nblk, k0 = 64 * kb, n0 = 32 * nb;
#pragma unroll 8
    for (int i = 0; i < 32; ++i) { const int kk = 2 * i + (lane >> 5); const float g = gain ? gain[k0 + kk] : 1.0f; scr[kk * 33 + (lane & 31)] = W[(size_t)(k0 + kk) * N + n0 + (lane & 31)] * g; }
    asm volatile("s_waitcnt lgkmcnt(0)" ::: "memory");
    const int c = lane & 7;
    const int ob = mode == 0 ? n0 : 256 * (n0 >> 7) + 128 * (mode - 1) + (n0 & 127);
#pragma unroll
    for (int j = 0; j < 4; ++j) { const int n = (lane >> 3) + 8 * j; const LAS float* s = scr + (8 * c) * 33 + n;
        u32x4 o; o.x = cvtpk(s[0 * 33], s[1 * 33]); o.y = cvtpk(s[2 * 33], s[3 * 33]); o.z = cvtpk(s[4 * 33], s[5 * 33]); o.w = cvtpk(s[6 * 33], s[7 * 33]);
        *(u32x4*)(WT + (size_t)(ob + n) * K + k0 + 8 * c) = o; }
    asm volatile("s_waitcnt lgkmcnt(0)" ::: "memory");
}

__global__ void __launch_bounds__(512, 2) mk_fwd(Args a) {
    extern __shared__ __attribute__((aligned(16))) unsigned char lds_raw[];
    LAS unsigned char* lds = (LAS unsigned char*)lds_raw;
    cg::grid_group grid = cg::this_grid();
    { volatile LAS unsigned* st_ = (volatile LAS unsigned*)(lds + LDS_BYTES - 64); if (threadIdx.x < 2) st_[threadIdx.x] = 0u; }
    __syncthreads();
    const XcdBarrier bar = xcd_barrier_post((unsigned*)(a.ws + WS_BAR), (volatile LAS unsigned*)(lds + LDS_BYTES - 64));
    if (a.ph_lo < 0) grid.sync();
    const int wave = __builtin_amdgcn_readfirstlane((int)threadIdx.x >> 6);
    const int G = gridDim.x, gw = blockIdx.x * 8 + wave, NGW = G * 8;
    const bool grp = (G == M / 256) && (G % 8 == 0) && MK_DUP_MASK == 0;
    unsigned grp_epoch = 0u; unsigned* const grp_cnt = (unsigned*)(a.ws + WS_BAR) + 3520 + 64 * ((int)blockIdx.x & 7);
    unsigned char* ws = a.ws;
    float* ss = (float*)(ws + WS_SS); float* lse = (float*)(ws + WS_LSE);
    bf16_t* xb = (bf16_t*)(ws + WS_XB); bf16_t* att = (bf16_t*)(ws + WS_ATT); bf16_t* obr = (bf16_t*)(ws + WS_OBR);
    bf16_t* qkv = (bf16_t*)(ws + WS_QKV); bf16_t* hb = (bf16_t*)(ws + WS_H);

#ifdef MK_PROBE_SYNCS
    for (int i_ = 0; i_ < MK_PROBE_SYNCS; ++i_) xcd_barrier(bar);
#endif
    for (int ph = a.ph_lo; ph < a.ph_hi; ++ph)
    for (int rep = 0; rep <= ((MK_DUP_MASK >> ph) & 1); ++rep) {
        if (ph == 0) {
            int tq_ = threadIdx.x; asm volatile("" : "+v"(tq_)); const int lane = tq_ & 63;
            LAS float* scr = (LAS float*)(lds + wave * 16384);
            constexpr int I_IN = 16 * 96, I_O = 16 * 32, I_G = 16 * 88, I_D = 44 * 32, I_L = I_IN + I_O + 2 * I_G + I_D;
            for (int it = gw; it < 2 * I_L; it += NGW) {
                const int l = it / I_L; int r = it % I_L; unsigned char* wl = ws + WS_W + (size_t)l * WS_WL;
                const float* an = a.in[l ? I_A1N : I_A0N]; const float* fn = a.in[l ? I_F1N : I_F0N];
                if (r < I_IN) { transpose_item(a.in[l ? I_A1QKV : I_A0IN], an, D, NQKV, (bf16_t*)(wl + WO_IN), 0, scr, r, lane); continue; } r -= I_IN;
                if (r < I_O) { transpose_item(a.in[l ? I_A1OUT : I_A0OUT], nullptr, D, D, (bf16_t*)(wl + WO_O), 0, scr, r, lane); continue; } r -= I_O;
                if (r < I_G) { transpose_item(a.in[l ? I_F1G : I_F0G], fn, D, FF, (bf16_t*)(wl + WO_GU), 1, scr, r, lane); continue; } r -= I_G;
                if (r < I_G) { transpose_item(a.in[l ? I_F1U : I_F0U], fn, D, FF, (bf16_t*)(wl + WO_GU), 2, scr, r, lane); continue; } r -= I_G;
                transpose_item(a.in[l ? I_F1D : I_F0D], nullptr, FF, D, (bf16_t*)(wl + WO_D), 0, scr, r, lane);
            }
            const float* x = a.in[I_X];
            for (int m = gw; m < M; m += 2 * NGW) {
                const f32x4* xr0 = (const f32x4*)(x + (size_t)m * D) + lane; const f32x4* xr1 = (const f32x4*)(x + (size_t)(m + NGW) * D) + lane; f32x4 v0[4], v1[4];
#pragma unroll
                for (int j = 0; j < 4; ++j) { v0[j] = xr0[64 * j]; v1[j] = xr1[64 * j]; }
                float s0 = 0.f, s1 = 0.f;
#pragma unroll
                for (int j = 0; j < 4; ++j) { s0 += (v0[j][0] * v0[j][0] + v0[j][1] * v0[j][1]) + (v0[j][2] * v0[j][2] + v0[j][3] * v0[j][3]);
                                              s1 += (v1[j][0] * v1[j][0] + v1[j][1] * v1[j][1]) + (v1[j][2] * v1[j][2] + v1[j][3] * v1[j][3]); }
                s0 = wave_sum(s0, lane); s1 = wave_sum(s1, lane);
                u32x2* o0 = (u32x2*)(xb + (size_t)m * D) + lane; u32x2* o1 = (u32x2*)(xb + (size_t)(m + NGW) * D) + lane;
#pragma unroll
                for (int j = 0; j < 4; ++j) { u32x2 w; w.x = cvtpk(v0[j][0], v0[j][1]); w.y = cvtpk(v0[j][2], v0[j][3]); o0[64 * j] = w;
                                              u32x2 z; z.x = cvtpk(v1[j][0], v1[j][1]); z.y = cvtpk(v1[j][2], v1[j][3]); o1[64 * j] = z; }
                if (lane < 16) { ss[(size_t)m * 16 + lane] = lane == 0 ? s0 : 0.f; ss[(size_t)(m + NGW) * 16 + lane] = lane == 0 ? s1 : 0.f; }
            }
        } else if (ph == 13) {
            int tq_ = threadIdx.x; asm volatile("" : "+v"(tq_)); const int lane = tq_ & 63;
            const float* g = a.in[I_FN];
            f32x4 gg[4];
#pragma unroll
            for (int j = 0; j < 4; ++j) gg[j] = ((const f32x4*)g)[lane + 64 * j];
            const int pm_ = ((int)blockIdx.x & 7) * 32 + ((int)blockIdx.x >> 3);
            const int m_lo = grp ? pm_ * 256 + wave : gw, m_hi = grp ? pm_ * 256 + 256 : M, m_st = grp ? 8 : NGW;
            for (int m = m_lo; m < m_hi; m += 2 * m_st) {
                f32x4* xr0 = (f32x4*)(a.out + (size_t)m * D) + lane; f32x4* xr1 = (f32x4*)(a.out + (size_t)(m + m_st) * D) + lane; f32x4 v0[4], v1[4];
#pragma unroll
                for (int j = 0; j < 4; ++j) { v0[j] = xr0[64 * j]; v1[j] = xr1[64 * j]; }
                float s0 = 0.f, s1 = 0.f;
#pragma unroll
                for (int j = 0; j < 4; ++j) { s0 += (v0[j][0] * v0[j][0] + v0[j][1] * v0[j][1]) + (v0[j][2] * v0[j][2] + v0[j][3] * v0[j][3]);
                                              s1 += (v1[j][0] * v1[j][0] + v1[j][1] * v1[j][1]) + (v1[j][2] * v1[j][2] + v1[j][3] * v1[j][3]); }
                s0 = wave_sum(s0, lane); s1 = wave_sum(s1, lane);
                const float rs0 = 1.0f / sqrtf(s0 * (1.0f / D) + RMS_EPS), rs1 = 1.0f / sqrtf(s1 * (1.0f / D) + RMS_EPS);
#pragma unroll
                for (int j = 0; j < 4; ++j) { xr0[64 * j] = v0[j] * rs0 * gg[j]; xr1[64 * j] = v1[j] * rs1 * gg[j]; }
            }
        } else {
            const int l = (ph - 1) / 6, s = (ph - 1) % 6;
            unsigned char* wl = ws + WS_W + (size_t)l * WS_WL;
            if (s == 0) {
                pg8::Gemm g{xb, (const bf16_t*)(wl + WO_IN), M, NQKV, D}; pg8::StaticOrder S; S.init(M, NQKV, G, (int)blockIdx.x);
                pg8::EpiScaleBf16 E{qkv, NQKV, ss, l == 0 ? 0xC3u : 0xFu, l == 1 ? (float*)(ws + WS_KN) : nullptr};
#ifndef SKIP_G1
                pg8::gemm_phase<pg8::EpiScaleBf16, pg8::StaticOrder, true, true>(lds, g, S, E);
#endif
            } else if (s == 1) {
                at::Ptrs X{qkv, att, obr, lse, a.in[I_RPB], a.in[I_SUBLN], 0.f, (const float*)(ws + WS_KN)};
                if (l == 0) {
                    if (grp) {
                        const int x_ = (int)blockIdx.x & 7;
                        unsigned* qctr = (unsigned*)(a.ws + WS_BAR) + 4608 + 64 * x_;
                        LAS unsigned* qs = (LAS unsigned*)(lds + LDS_BYTES - 32);
                        if (threadIdx.x == 0) { const unsigned i0_ = xb_add(qctr, 1u), i1_ = xb_add(qctr, 1u); qs[0] = i0_; qs[1] = i1_; }
                        __syncthreads();
                        int sa = 0, sb = 1, sc = 2; bool have = false;
                        bf16x8 pq0 = {}, pq1 = {}, pq2 = {}, pq3 = {}, pk_ = {}, pv_ = {};
                        for (;;) {
                            const unsigned i = (unsigned)__builtin_amdgcn_readfirstlane((int)qs[sa]), in = (unsigned)__builtin_amdgcn_readfirstlane((int)qs[sb]);
                            if (i >= 1024u) break;
                            unsigned nx2 = 0u; if (threadIdx.x == 0) nx2 = xb_add(qctr, 1u);
                            if (i < 256u) { at::PolNat P; P.init(x_ * 256 + (int)i); at::attn_unit(P, lds, X); have = false; }
                            else { const int i2 = (int)i - 256, n2 = (int)in - 256;
                                at::PolDil P, Pn; P.init((i2 >> 8) * 2048 + x_ * 256 + (i2 & 255));
                                const bool hasn = in < 1024u && in >= 256u; if (hasn) Pn.init((n2 >> 8) * 2048 + x_ * 256 + (n2 & 255)); else Pn = P;
                                at::attn_unit(P, lds, X, pq0, pq1, pq2, pq3, pk_, pv_, have, Pn, hasn); have = hasn; }
                            if (threadIdx.x == 0) qs[sc] = nx2;
                            __syncthreads(); { const int t_ = sa; sa = sb; sb = sc; sc = t_; }
                        }
                    } else {
                    const int vc0 = ((int)blockIdx.x & 7) * (G >> 3) + ((int)blockIdx.x >> 3);
#ifndef SKIP_NAT
                    for (int u = vc0; u < 2048; u += G) { at::PolNat P; P.init(u); at::attn_unit(P, lds, X); }
#endif
#ifndef SKIP_DIL
                    { bf16x8 pq0 = {}, pq1 = {}, pq2 = {}, pq3 = {}, pk_ = {}, pv_ = {}; bool have = false;
                      for (int u = 2048 + vc0; u < 8192; u += G) { at::PolDil P, Pn; P.init(u - 2048); const bool hasn = u + G < 8192; if (hasn) Pn.init(u + G - 2048); else Pn = P;
                          at::attn_unit(P, lds, X, pq0, pq1, pq2, pq3, pk_, pv_, have, Pn, hasn); have = hasn; } }
#endif
                    }
                }
            } else if (s == 2) {
                if (l == 0) {
                    int tq_ = threadIdx.x; asm volatile("" : "+v"(tq_)); const int lane = tq_ & 63;
                    const int hd = lane >> 3;
                    for (int m0 = gw; m0 < M; m0 += 2 * NGW) {
                        float L[2][3]; bf16x8 ov[2][3];
#pragma unroll
                        for (int r = 0; r < 2; ++r) { const size_t m = (size_t)m0 + (size_t)r * NGW;
#pragma unroll
                            for (int i = 0; i < 3; ++i) { L[r][i] = lse[(size_t)i * M * 8 + m * 8 + hd]; ov[r][i] = *(const bf16x8*)(obr + (size_t)i * M * 512 + m * 512 + lane * 8); } }
#pragma unroll
                        for (int r = 0; r < 2; ++r) { const size_t m = (size_t)m0 + (size_t)r * NGW;
                            const float mx = fmaxf(L[r][0], fmaxf(L[r][1], L[r][2]));
                            float w0 = __builtin_amdgcn_exp2f(L[r][0] - mx), w1 = __builtin_amdgcn_exp2f(L[r][1] - mx), w2 = __builtin_amdgcn_exp2f(L[r][2] - mx);
                            const float inv = 1.0f / (w0 + w1 + w2); w0 *= inv; w1 *= inv; w2 *= inv;
                            float y[8];
#pragma unroll
                            for (int e = 0; e < 8; ++e) y[e] = w0 * bf2f((unsigned short)ov[r][0][e]) + w1 * bf2f((unsigned short)ov[r][1][e]) + w2 * bf2f((unsigned short)ov[r][2][e]);
                            u32x4 w; w.x = cvtpk(y[0], y[1]); w.y = cvtpk(y[2], y[3]); w.z = cvtpk(y[4], y[5]); w.w = cvtpk(y[6], y[7]);
                            *(u32x4*)(att + m * D + lane * 8) = w; }
                    }
                } else {
                    float d1 = 0.f, d2 = 0.f;
                    for (int i = 0; i < 64; ++i) { d1 += a.in[I_LQ1][i] * a.in[I_LK1][i]; d2 += a.in[I_LQ2][i] * a.in[I_LK2][i]; }
                    at::Ptrs X{qkv, att, obr, lse, a.in[I_RPB], a.in[I_SUBLN], 0.f, (const float*)(ws + WS_KN)};
                    X.lam = __int_as_float(__builtin_amdgcn_readfirstlane(__float_as_int(__expf(d1) - __expf(d2) + LAM_INIT)));
#ifndef SKIP_DIFF
                    if (grp) {
                        unsigned* qctr = (unsigned*)(a.ws + WS_BAR) + 4096 + 64 * ((int)blockIdx.x & 7);
                        LAS unsigned* qs = (LAS unsigned*)(lds + LDS_BYTES - 32);
                        if (threadIdx.x == 0) qs[0] = xb_add(qctr, 1u);
                        __syncthreads();
                        int cur = 0;
                        for (;;) {
                            const unsigned i = (unsigned)__builtin_amdgcn_readfirstlane((int)qs[cur]);
                            if (i >= 512u) break;
                            unsigned nxt = 0u; if (threadIdx.x == 0) nxt = xb_add(qctr, 1u);
                            at::PolDiff P; { const int hq = 7 - (int)(i >> 6), bs = (int)(i >> 5) & 1, x_ = (int)blockIdx.x & 7;
                                P.h = hq; P.b = x_ + 8 * bs; P.qb = (int)(i & 31u); P.tlo = 0; P.thi = T / 64; P.nsl = -at::slope_of(hq) * LOG2E; }
                            at::diff_unit(P, lds, X);
                            if (threadIdx.x == 0) qs[cur ^ 1] = nxt;
                            __syncthreads(); cur ^= 1;
                        }
                    } else
                    for (int u = blockIdx.x; u < 4096; u += G) { at::PolDiff P; P.init(u); at::diff_unit(P, lds, X); }
#endif
                }
            } else if (s == 3 || s == 5) {
                const bool dn = s == 5;
                pg8::Gemm g{dn ? hb : att, (const bf16_t*)(wl + (dn ? WO_D : WO_O)), M, D, dn ? FF : D}; pg8::StaticOrder S; S.init(M, D, G, (int)blockIdx.x);
                pg8::EpiResid E{(l == 0 && !dn) ? a.in[I_X] : nullptr, (l == 1 && dn) ? a.out : nullptr, xb, (bf16_t*)(ws + WS_OBR)  , ss};
#ifndef SKIP_G2
                pg8::gemm_phase<pg8::EpiResid, pg8::StaticOrder, true, true>(lds, g, S, E);
#endif
            } else {
                pg8::Gemm g{xb, (const bf16_t*)(wl + WO_GU), M, NGU, D}; pg8::StaticOrder S; S.init(M, NGU, G, (int)blockIdx.x);
                pg8::EpiSwiGLU E{hb, ss};
#ifndef SKIP_G3
                pg8::gemm_phase<pg8::EpiSwiGLU, pg8::StaticOrder, true, true>(lds, g, S, E);
#endif
            }
        }
        if ((ph + 1 < a.ph_hi || rep < ((MK_DUP_MASK >> ph) & 1)) && ph != 8) {
            if (grp && ((ph >= 4 && ph <= 5) || (ph >= 10 && ph <= 12))) grp_barrier(grp_cnt, grp_epoch, (unsigned)(G >> 3));
            else xcd_barrier(bar); }
    }
}

extern "C" void kernel_launch(void* const* d_in, const int* in_sizes, int n_in, void* d_out, int out_size, void* d_ws, size_t ws_size, hipStream_t stream) {
    static int grid = 0;
    if (grid == 0) {
        if (n_in != 22 || in_sizes[0] != M * D || out_size != M * D || ws_size < WS_END) { fprintf(stderr, "kernel_launch: unexpected shapes (n_in %d, in0 %d, out %d, ws %zu)\n", n_in, n_in > 0 ? in_sizes[0] : -1, out_size, ws_size); grid = -1; return; }
        int dev = 0, cus = 0, per_cu = 0;
        hipGetDevice(&dev); hipDeviceGetAttribute(&cus, hipDeviceAttributeMultiprocessorCount, dev);
        if (hipFuncSetAttribute((const void*)mk_fwd, hipFuncAttributeMaxDynamicSharedMemorySize, LDS_BYTES) != hipSuccess) { fprintf(stderr, "kernel_launch: hipFuncSetAttribute failed\n"); grid = -1; return; }
        hipOccupancyMaxActiveBlocksPerMultiprocessor(&per_cu, (const void*)mk_fwd, 512, LDS_BYTES);
        (void)hipGetLastError();
        if (per_cu < 1) { fprintf(stderr, "kernel_launch: occupancy query says %d blocks/CU\n", per_cu); per_cu = 1; }
        grid = cus * 1;
    }
    if (grid < 0) return;
    Args a{};
    for (int i = 0; i < 22; ++i) a.in[i] = (const float*)d_in[i];
    a.out = (float*)d_out; a.ws = (unsigned char*)d_ws;
#if MK_ONE_LAUNCH
    if (hipMemsetAsync((char*)d_ws + WS_BAR, 0, WS_BAR_BYTES, stream) != hipSuccess) { fprintf(stderr, "kernel_launch: memset of the barrier words failed\n"); return; }
    a.ph_lo = 0; a.ph_hi = NPH;
    void* args[] = {&a};
    hipError_t e = hipLaunchCooperativeKernel((const void*)mk_fwd, dim3(grid), dim3(512), args, LDS_BYTES, stream);
    if (e != hipSuccess) fprintf(stderr, "cooperative launch failed: %s (grid %d)\n", hipGetErrorString(e), grid);
#else
    for (int ph = 0; ph < NPH; ++ph) {
        a.ph_lo = ph; a.ph_hi = ph + 1;
        hipLaunchKernelGGL(mk_fwd, dim3(grid), dim3(512), LDS_BYTES, stream, a);
    }
#endif
}
```

```cpp
#include <hip/hip_runtime.h>
#include <hip/hip_cooperative_groups.h>
#include <cstdio>
#include <cstdint>
namespace cg = cooperative_groups;
#ifndef MK_DUP_MASK
#define MK_DUP_MASK 0x0
#endif
#ifndef MK_ONE_LAUNCH
#define MK_ONE_LAUNCH 1
#endif
namespace pg8 {
#define PG8_LAS __attribute__((address_space(3)))
typedef unsigned short bf16_t;
typedef short bf16x8 __attribute__((ext_vector_type(8)));
typedef float f32x4 __attribute__((ext_vector_type(4)));
typedef unsigned u32x4 __attribute__((ext_vector_type(4)));
constexpr int BM = 256, BK = 64, HALF = 128, HTB = HALF * BK * 2  , STAGE_BYTES = 8 * HTB, NXCD = 8, WGM = 8;

__host__ __device__ __forceinline__ int lds_byte(int r, int c) { const int st = (r >> 4) * 2 + (c >> 5), rr = r & 15, cc = c & 31, ob = rr * 64 + cc * 2; return st * 1024 + (ob ^ (((ob >> 9) & 1) << 5)); }
__host__ __device__ __forceinline__ void stage_rc(int b, int& R, int& C) { const int st = b / 1024, sb = b % 1024, swz = sb ^ (((sb >> 9) & 1) << 5); R = (st >> 1) * 16 + swz / 64; C = (st & 1) * 32 + (swz % 64) / 2; }
__host__ __device__ __forceinline__ int perm32(int rho) { const int n = rho >> 4, i = rho & 15; return 8 * (i >> 2) + 4 * n + (i & 3); }

struct Unit { int pm, pn; };
struct Gemm { const bf16_t* A; const bf16_t* Bt; int M, N, K; };

struct StaticOrder {
    int nM, nN, nwg, G, c;
    __host__ __device__ void init(int M, int N, int G_, int c_) { nM = M / BM; nN = N / BM; nwg = nM * nN; G = G_; c = c_; }
    __host__ __device__ bool next(int i, Unit& u) const {
        const long L = (long)i * G + c; if (L >= nwg) return false;
        int wgid = (int)L; { const int q = nwg / NXCD, r = nwg % NXCD, xcd = wgid % NXCD, off = wgid / NXCD; wgid = (xcd < r ? xcd * (q + 1) : r * (q + 1) + (xcd - r) * q) + off; }
        const int nig = WGM * nN, gid = wgid / nig, fm = gid * WGM, gsz = (nM - fm) < WGM ? (nM - fm) : WGM;
        u.pm = fm + ((wgid % nig) % gsz); u.pn = (wgid % nig) / gsz; return true;
    }
    __device__ __forceinline__ void a_ready(const Unit&) const {}
    __device__ __forceinline__ void done(const Unit&) const {}
};

__device__ __forceinline__ unsigned cvt_pk_bf16(float lo, float hi) { unsigned r; asm volatile("v_cvt_pk_bf16_f32 %0, %1, %2" : "=v"(r) : "v"(lo), "v"(hi)); return r; }
typedef float f32x2 __attribute__((ext_vector_type(2)));
template <class Epi, class Sched, bool ALIGN_EPI = false, bool SP2 = false>
__device__ __forceinline__ void gemm_phase(PG8_LAS unsigned char* lds, const Gemm g, const Sched& S, const Epi& E) {
    int tid_ = threadIdx.x; asm volatile("" : "+v"(tid_));
    const int tid = tid_, wid = __builtin_amdgcn_readfirstlane(tid >> 6), lane = tid & 63, wr = wid >> 2, wc = wid & 3, fr = lane & 15, fq = lane >> 4;
    const int K = g.K, nt = K / BK;
    unsigned voffA[2], voffB[2];
#pragma unroll
    for (int i = 0; i < 2; ++i) { int R, C; stage_rc(tid * 16 + i * 8192, R, C); const int Rb = Epi::PERM ? ((R & ~31) + perm32(R & 31)) : R;
        voffA[i] = (unsigned)(R * K + C) * 2u; voffB[i] = (unsigned)(Rb * K + C) * 2u; }
    const size_t kstep = (size_t)(BK * 2);
    const size_t hstep = (size_t)HALF * K * 2;
    const size_t tstep = 2 * hstep;
    const unsigned ldsw = (unsigned)wid * 1024u;
    const int aoff = lds_byte(wr * 64 + fr, fq * 8), boff = lds_byte(wc * 32 + fr, fq * 8);
#define PG8_SA(b, h) (((b) * 2 + (h)) * HTB)
#define PG8_SB(b, h) ((4 + (b) * 2 + (h)) * HTB)
#define PG8_STAGE(bufoff, gbase, voff) do { _Pragma("unroll") for (int _i = 0; _i < 2; ++_i) \
        __builtin_amdgcn_global_load_lds((const unsigned*)((const char*)(gbase) + (voff)[_i]), (PG8_LAS unsigned*)(lds + (bufoff) + ldsw + _i * 8192), 16, 0, 0); } while (0)
#define PG8_LDA(dst, b, h) do { _Pragma("unroll") for (int m = 0; m < 4; ++m) _Pragma("unroll") for (int k = 0; k < 2; ++k) dst[m][k] = *(const PG8_LAS bf16x8*)(lds + PG8_SA(b, h) + aoff + m * 2048 + k * 1024); } while (0)
#define PG8_LDB(dst, b, h) do { _Pragma("unroll") for (int n = 0; n < 2; ++n) _Pragma("unroll") for (int k = 0; k < 2; ++k) dst[n][k] = *(const PG8_LAS bf16x8*)(lds + PG8_SB(b, h) + boff + n * 2048 + k * 1024); } while (0)
#define PG8_MMA(ai, bj, At, Bt) do { __builtin_amdgcn_s_setprio(1); _Pragma("unroll") for (int m = 0; m < 4; ++m) _Pragma("unroll") for (int n = 0; n < 2; ++n) _Pragma("unroll") for (int k = 0; k < 2; ++k) \
        acc[ai][bj][m][n] = __builtin_amdgcn_mfma_f32_16x16x32_bf16(Bt[n][k], At[m][k], acc[ai][bj][m][n], 0, 0, 0); __builtin_amdgcn_s_setprio(0); } while (0)
#define PG8_WAIT_V(n) asm volatile("s_waitcnt vmcnt(" #n ")" ::: "memory")
#define PG8_WAIT_L(n) asm volatile("s_waitcnt lgkmcnt(" #n ")" ::: "memory")
#define PG8_BAR __builtin_amdgcn_s_barrier()
#define PG8_SCHED __builtin_amdgcn_sched_barrier(0)
    Unit cur, nxt; int ui = 0;
    if (!S.next(0, cur)) return;
    f32x4 acc[2][2][4][2];
#pragma unroll
    for (int a = 0; a < 2; ++a)
#pragma unroll
        for (int b = 0; b < 2; ++b)
#pragma unroll
            for (int m = 0; m < 4; ++m)
#pragma unroll
                for (int n = 0; n < 2; ++n) acc[a][b][m][n] = (f32x4){0.f, 0.f, 0.f, 0.f};
    bf16x8 At[4][2], B0[2][2], B1[2][2];
    const char* cA = (const char*)g.A + (size_t)cur.pm * tstep; const char* cB = (const char*)g.Bt + (size_t)cur.pn * tstep;
    S.a_ready(cur);
    if constexpr (SP2) {
        PG8_STAGE(PG8_SB(0, 0), cB, voffB); PG8_STAGE(PG8_SB(0, 1), cB + hstep, voffB); PG8_STAGE(PG8_SA(0, 0), cA, voffA); PG8_STAGE(PG8_SA(0, 1), cA + hstep, voffA);
        if (wr == 1) PG8_BAR;
        PG8_WAIT_V(2); PG8_BAR;
        PG8_STAGE(PG8_SB(1, 0), cB + kstep, voffB); PG8_STAGE(PG8_SA(1, 0), cA + kstep, voffA); PG8_STAGE(PG8_SB(1, 1), cB + hstep + kstep, voffB);
        PG8_WAIT_V(6); PG8_BAR;
    } else {
        PG8_STAGE(PG8_SB(0, 0), cB, voffB); PG8_STAGE(PG8_SA(0, 0), cA, voffA); PG8_STAGE(PG8_SB(0, 1), cB + hstep, voffB); PG8_STAGE(PG8_SA(0, 1), cA + hstep, voffA);
        if (wr == 1) PG8_BAR;
        PG8_WAIT_V(4); PG8_BAR;
        PG8_STAGE(PG8_SB(1, 0), cB + kstep, voffB); PG8_STAGE(PG8_SA(1, 0), cA + kstep, voffA); PG8_STAGE(PG8_SB(1, 1), cB + hstep + kstep, voffB);
        PG8_WAIT_V(6); PG8_BAR;
    }
    for (;;) {
        const bool has_next = S.next(ui + 1, nxt);
        const char* nA = has_next ? (const char*)g.A + (size_t)nxt.pm * tstep : cA; const char* nB = has_next ? (const char*)g.Bt + (size_t)nxt.pn * tstep : cB;
        for (int t = 0; t < nt; t += 2) {
            const bool last = (t == nt - 2);
            const char* a1 = cA + (size_t)(t + 1) * kstep;
            const char* a2 = last ? nA : cA + (size_t)(t + 2) * kstep; const char* b2 = last ? nB : cB + (size_t)(t + 2) * kstep;
            const char* a3 = a2 + kstep; const char* b3 = b2 + kstep;
            if (last && has_next) S.a_ready(nxt);
            if constexpr (SP2) {
            PG8_LDB(B0, 0, 0); PG8_LDB(B1, 0, 1); PG8_SCHED; PG8_LDA(At, 0, 0); PG8_STAGE(PG8_SA(1, 1), a1 + hstep, voffA);
            PG8_WAIT_V(8); PG8_WAIT_L(0); PG8_BAR; PG8_MMA(0, 0, At, B0); PG8_MMA(0, 1, At, B1); PG8_BAR; PG8_SCHED;
            PG8_LDA(At, 0, 1); PG8_STAGE(PG8_SB(0, 0), b2, voffB); PG8_STAGE(PG8_SB(0, 1), b2 + hstep, voffB); PG8_STAGE(PG8_SA(0, 0), a2, voffA);
            PG8_WAIT_V(8); PG8_WAIT_L(0); PG8_BAR; PG8_MMA(1, 0, At, B0); PG8_MMA(1, 1, At, B1); PG8_BAR; PG8_SCHED;
            PG8_LDB(B0, 1, 0); PG8_LDB(B1, 1, 1); PG8_SCHED; PG8_LDA(At, 1, 0); PG8_STAGE(PG8_SA(0, 1), a2 + hstep, voffA);
            PG8_WAIT_V(8); PG8_WAIT_L(0); PG8_BAR; PG8_MMA(0, 0, At, B0); PG8_MMA(0, 1, At, B1); PG8_BAR; PG8_SCHED;
            PG8_LDA(At, 1, 1); PG8_STAGE(PG8_SB(1, 0), b3, voffB); PG8_STAGE(PG8_SB(1, 1), b3 + hstep, voffB); PG8_STAGE(PG8_SA(1, 0), a3, voffA);
            PG8_WAIT_V(8); PG8_WAIT_L(0); PG8_BAR; PG8_MMA(1, 0, At, B0); PG8_MMA(1, 1, At, B1); PG8_BAR; PG8_SCHED;
            } else {
            PG8_LDB(B0, 0, 0); PG8_SCHED; PG8_LDA(At, 0, 0); PG8_STAGE(PG8_SA(1, 1), a1 + hstep, voffA);
            PG8_WAIT_L(8); PG8_BAR; PG8_WAIT_L(0); PG8_MMA(0, 0, At, B0); PG8_BAR; PG8_SCHED;
            PG8_LDB(B1, 0, 1); PG8_STAGE(PG8_SB(0, 0), b2, voffB);
            PG8_BAR; PG8_WAIT_L(0); PG8_MMA(0, 1, At, B1); PG8_BAR;
            PG8_LDA(At, 0, 1); PG8_STAGE(PG8_SA(0, 0), a2, voffA);
            PG8_BAR; PG8_WAIT_L(0); PG8_MMA(1, 0, At, B0); PG8_BAR; PG8_SCHED;
            PG8_STAGE(PG8_SB(0, 1), b2 + hstep, voffB);
            PG8_WAIT_V(6); PG8_BAR; PG8_MMA(1, 1, At, B1); PG8_BAR;
            PG8_LDB(B0, 1, 0); PG8_SCHED; PG8_LDA(At, 1, 0); PG8_STAGE(PG8_SA(0, 1), a2 + hstep, voffA);
            PG8_WAIT_L(8); PG8_BAR; PG8_WAIT_L(0); PG8_MMA(0, 0, At, B0); PG8_BAR; PG8_SCHED;
            PG8_LDB(B1, 1, 1); PG8_STAGE(PG8_SB(1, 0), b3, voffB);
            PG8_BAR; PG8_WAIT_L(0); PG8_MMA(0, 1, At, B1); PG8_BAR;
            PG8_LDA(At, 1, 1); PG8_STAGE(PG8_SA(1, 0), a3, voffA);
            PG8_BAR; PG8_WAIT_L(0); PG8_MMA(1, 0, At, B0); PG8_BAR; PG8_SCHED;
            PG8_STAGE(PG8_SB(1, 1), b3 + hstep, voffB);
            PG8_WAIT_V(6); PG8_BAR; PG8_MMA(1, 1, At, B1); PG8_BAR;
            }
        }
        if constexpr (ALIGN_EPI) { if (wr == 0) PG8_BAR; }
        if constexpr (!Epi::AFTER_DRAIN) { E(acc, cur, wr, wc, fr, fq); S.done(cur); }
        if (!has_next) break;
#pragma unroll
        for (int a = 0; a < 2; ++a)
#pragma unroll
            for (int b = 0; b < 2; ++b)
#pragma unroll
                for (int m = 0; m < 4; ++m)
#pragma unroll
                    for (int n = 0; n < 2; ++n) acc[a][b][m][n] = (f32x4){0.f, 0.f, 0.f, 0.f};
        cur = nxt; cA = nA; cB = nB; ++ui;
        if constexpr (ALIGN_EPI) { if (wr == 1) PG8_BAR; }
    }
    PG8_WAIT_V(0);
    if constexpr (!ALIGN_EPI) { if (wr == 0) PG8_BAR; }
    PG8_BAR;
    if constexpr (Epi::AFTER_DRAIN) { E.fused(acc, cur, wr, wc, fr, fq, lds, wid, lane); S.done(cur); }
#undef PG8_SA
#undef PG8_SB
#undef PG8_STAGE
#undef PG8_LDA
#undef PG8_LDB
#undef PG8_MMA
#undef PG8_WAIT_V
#undef PG8_WAIT_L
#undef PG8_BAR
#undef PG8_SCHED
}
}

constexpr int BATCH = 16, T = 4096, D = 1024, M = BATCH * T, NQKV = 3072, FF = 2816, NGU = 2 * FF;
constexpr float RMS_EPS = 1e-6f, SUBLN_EPS = 1e-5f;
constexpr float LOG2E = 1.4426950408889634f;
constexpr float QSCALE = 0.125f * LOG2E;
constexpr float LAM_INIT = 0.35550906f;

#define LAS __attribute__((address_space(3)))
typedef unsigned short bf16_t;
typedef short bf16x8 __attribute__((ext_vector_type(8)));
typedef short s16x4 __attribute__((ext_vector_type(4)));
typedef float f32x4 __attribute__((ext_vector_type(4)));
typedef float f32x16 __attribute__((ext_vector_type(16)));
typedef unsigned u32x4 __attribute__((ext_vector_type(4)));
typedef unsigned u32x2 __attribute__((ext_vector_type(2)));

__device__ __forceinline__ unsigned cvtpk(float lo, float hi) { unsigned r; asm volatile("v_cvt_pk_bf16_f32 %0, %1, %2" : "=v"(r) : "v"(lo), "v"(hi)); return r; }
__device__ __forceinline__ float sx(float v, int mask, int lane) { return __int_as_float(__builtin_amdgcn_ds_bpermute((lane ^ mask) << 2, __float_as_int(v))); }
__device__ __forceinline__ float bf2f(unsigned short u) { return __uint_as_float((unsigned)u << 16); }

namespace pg8 {
__device__ __forceinline__ float row_rs(const float* ss, int row, int fq, int fr) {
#ifdef TRIV_EPI
    return 1.0f;
#endif
    const f32x4 a = *(const f32x4*)(ss + (size_t)row * 16 + 4 * fq);
    float s = (a[0] + a[1]) + (a[2] + a[3]);
    const int ln = fq * 16 + fr; s += sx(s, 16, ln); s += sx(s, 32, ln);
    return 1.0f / sqrtf(s * (1.0f / D) + RMS_EPS);
}
struct EpiScaleBf16 {
    static constexpr bool PERM = true, AFTER_DRAIN = false;
    bf16_t* O; int ldc; const float* ss; unsigned qmask;
    float* kn2;
    __device__ __forceinline__ void operator()(const f32x4 (&acc)[2][2][4][2], const Unit& u, int wr, int wc, int fr, int fq) const {
        const int row0 = u.pm * BM + wr * 64 + fr, col0 = u.pn * BM + wc * 32 + 8 * fq;
        const float qs = ((qmask >> u.pn) & 1u) ? QSCALE : 1.0f;
        const bool kt = kn2 != nullptr && u.pn >= 4 && u.pn < 8;
        const int ln = fq * 16 + fr;
        float km[2][2] = {{0.f, 0.f}, {0.f, 0.f}};
#pragma unroll
        for (int ai = 0; ai < 2; ++ai)
#pragma unroll
            for (int m = 0; m < 4; ++m) { const int row = row0 + ai * HALF + m * 16; const float rs = row_rs(ss, row, fq, fr) * qs;
                bf16_t* rowp = O + (size_t)row * ldc + col0;
#pragma unroll
                for (int bj = 0; bj < 2; ++bj) { const f32x4 v0 = acc[ai][bj][m][0] * rs, v1 = acc[ai][bj][m][1] * rs;
                    u32x4 w; w.x = cvt_pk_bf16(v0[0], v0[1]); w.y = cvt_pk_bf16(v0[2], v0[3]); w.z = cvt_pk_bf16(v1[0], v1[1]); w.w = cvt_pk_bf16(v1[2], v1[3]);
                    *(u32x4*)(rowp + bj * HALF) = w;
                    if (kt) { float s8 = 0.f;
#pragma unroll
                        for (int e = 0; e < 4; ++e) { const unsigned ww = e == 0 ? w.x : (e == 1 ? w.y : (e == 2 ? w.z : w.w)); const float lo_ = __uint_as_float(ww << 16), hi_ = __uint_as_float(ww & 0xffff0000u);
                            s8 = fmaf(lo_, lo_, s8); s8 = fmaf(hi_, hi_, s8); }
                        s8 += sx(s8, 16, ln); s8 += sx(s8, 32, ln);
                        km[ai][bj] = fmaxf(km[ai][bj], s8); } }
                if (m & 1) asm volatile("" ::: "memory"); }
        if (kt) {
#pragma unroll
            for (int ai = 0; ai < 2; ++ai)
#pragma unroll
                for (int bj = 0; bj < 2; ++bj) { float v = km[ai][bj];
                    v = fmaxf(v, sx(v, 1, ln)); v = fmaxf(v, sx(v, 2, ln)); v = fmaxf(v, sx(v, 4, ln)); v = fmaxf(v, sx(v, 8, ln));
                    const int rt = u.pm * BM + ai * HALF + wr * 64, bb = rt >> 12, tile = (rt & 4095) >> 6, head = (u.pn - 4) * 2 + bj;
                    if (ln == 0) kn2[((((bb * 8 + head) * 2 + (wc >> 1)) * 64 + tile) << 1) + (wc & 1)] = v; }
        }
    }
};
struct EpiSwiGLU {
    static constexpr bool PERM = true, AFTER_DRAIN = false;
    bf16_t* H; const float* ss;
    __device__ __forceinline__ void operator()(const f32x4 (&acc)[2][2][4][2], const Unit& u, int wr, int wc, int fr, int fq) const {
        const int row0 = u.pm * BM + wr * 64 + fr, col0 = u.pn * HALF + wc * 32 + 8 * fq;
#pragma unroll
        for (int ai = 0; ai < 2; ++ai)
#pragma unroll
            for (int m = 0; m < 4; ++m) { const int row = row0 + ai * HALF + m * 16; const float rs = row_rs(ss, row, fq, fr);
                float o[8];
#pragma unroll
                for (int n = 0; n < 2; ++n)
#pragma unroll
                    for (int e = 0; e < 4; ++e) { const float g = acc[ai][0][m][n][e] * rs, up = acc[ai][1][m][n][e] * rs;
                        o[n * 4 + e] = g * __builtin_amdgcn_rcpf(1.0f + __builtin_amdgcn_exp2f(-g * LOG2E)) * up; }
                u32x4 w; w.x = cvt_pk_bf16(o[0], o[1]); w.y = cvt_pk_bf16(o[2], o[3]); w.z = cvt_pk_bf16(o[4], o[5]); w.w = cvt_pk_bf16(o[6], o[7]);
                *(u32x4*)(H + (size_t)row * FF + col0) = w;
                if (m & 1) asm volatile("" ::: "memory"); }
    }
};
struct EpiResid {
    static constexpr bool PERM = true, AFTER_DRAIN = false;
    const float* bf; float* of; bf16_t* hi; bf16_t* lo; float* ss;
    __device__ __forceinline__ void operator()(const f32x4 (&acc)[2][2][4][2], const Unit& u, int wr, int wc, int fr, int fq) const {
        const int row0 = u.pm * BM + wr * 64 + fr, col0 = u.pn * BM + wc * 32 + 8 * fq;
#pragma unroll
        for (int ai = 0; ai < 2; ++ai)
#pragma unroll
            for (int m = 0; m < 4; ++m) { const int row = row0 + ai * HALF + m * 16; const size_t off = (size_t)row * D + col0; float sq = 0.f;
#pragma unroll
                for (int bj = 0; bj < 2; ++bj) { const size_t o2 = off + bj * HALF; f32x4 v0, v1;
                    if (bf) { v0 = *(const f32x4*)(bf + o2); v1 = *(const f32x4*)(bf + o2 + 4); }
                    else { const u32x4 h = *(const u32x4*)(hi + o2), l = *(const u32x4*)(lo + o2);
                        v0[0] = __uint_as_float(h.x << 16) + __uint_as_float(l.x << 16); v0[1] = __uint_as_float(h.x & 0xffff0000u) + __uint_as_float(l.x & 0xffff0000u);
                        v0[2] = __uint_as_float(h.y << 16) + __uint_as_float(l.y << 16); v0[3] = __uint_as_float(h.y & 0xffff0000u) + __uint_as_float(l.y & 0xffff0000u);
                        v1[0] = __uint_as_float(h.z << 16) + __uint_as_float(l.z << 16); v1[1] = __uint_as_float(h.z & 0xffff0000u) + __uint_as_float(l.z & 0xffff0000u);
                        v1[2] = __uint_as_float(h.w << 16) + __uint_as_float(l.w << 16); v1[3] = __uint_as_float(h.w & 0xffff0000u) + __uint_as_float(l.w & 0xffff0000u); }
                    v0 = v0 + acc[ai][bj][m][0]; v1 = v1 + acc[ai][bj][m][1];
                    if (of) { *(f32x4*)(of + o2) = v0; *(f32x4*)(of + o2 + 4) = v1; }
                    else { u32x4 w; w.x = cvt_pk_bf16(v0[0], v0[1]); w.y = cvt_pk_bf16(v0[2], v0[3]); w.z = cvt_pk_bf16(v1[0], v1[1]); w.w = cvt_pk_bf16(v1[2], v1[3]);
                        u32x4 r; r.x = cvt_pk_bf16(v0[0] - __uint_as_float(w.x << 16), v0[1] - __uint_as_float(w.x & 0xffff0000u)); r.y = cvt_pk_bf16(v0[2] - __uint_as_float(w.y << 16), v0[3] - __uint_as_float(w.y & 0xffff0000u));
                        r.z = cvt_pk_bf16(v1[0] - __uint_as_float(w.z << 16), v1[1] - __uint_as_float(w.z & 0xffff0000u)); r.w = cvt_pk_bf16(v1[2] - __uint_as_float(w.w << 16), v1[3] - __uint_as_float(w.w & 0xffff0000u));
                        *(u32x4*)(hi + o2) = w; *(u32x4*)(lo + o2) = r; }
                    sq += ((v0[0] * v0[0] + v0[1] * v0[1]) + (v0[2] * v0[2] + v0[3] * v0[3])) + ((v1[0] * v1[0] + v1[1] * v1[1]) + (v1[2] * v1[2] + v1[3] * v1[3])); }
                { const int ln = fq * 16 + fr; sq += sx(sq, 16, ln); sq += sx(sq, 32, ln); }
                if (fq == 0) ss[(size_t)row * 16 + u.pn * 4 + wc] = sq;
                asm volatile("" ::: "memory"); }
    }
};
}

namespace at {
constexpr float THR = 8.0f;
__device__ __forceinline__ int crow(int r, int hi) { return (r & 3) + 8 * (r >> 2) + 4 * hi; }
template <int NB> __device__ __forceinline__ int v_st(int k, int c) { const int kk = (k & ~0xC) | ((k & 4) << 1) | ((k & 8) >> 1); return ((kk >> 3) * NB + (c >> 5)) * 512 + ((kk & 7) * 32 + (c & 31)) * 2; }
__device__ __forceinline__ int v_rd_base(int lane) { return ((lane & 3) << 3) | (((lane >> 2) & 3) << 6) | (((lane >> 4) & 1) << 5) | (((lane >> 5) & 1) << 8); }
template <int NB> constexpr int v_rd_off(int d0, int ks, int half) { return d0 * 512 + ks * (NB * 1024) + half * (NB * 512); }
template <int OFF> __device__ __forceinline__ s16x4 tr_read(int vb) { s16x4 r; asm volatile("ds_read_b64_tr_b16 %0, %1 offset:%2" : "=&v"(r) : "v"(vb), "i"(OFF) : "memory"); return r; }
template <int NB, int D0> __device__ __forceinline__ void pv_one(f32x16& od, int vb, bf16x8 pa0, bf16x8 pa1, bf16x8 pa2, bf16x8 pa3) {
    const s16x4 l0 = tr_read<v_rd_off<NB>(D0, 0, 0)>(vb), h0 = tr_read<v_rd_off<NB>(D0, 0, 1)>(vb), l1 = tr_read<v_rd_off<NB>(D0, 1, 0)>(vb), h1 = tr_read<v_rd_off<NB>(D0, 1, 1)>(vb);
    const s16x4 l2 = tr_read<v_rd_off<NB>(D0, 2, 0)>(vb), h2 = tr_read<v_rd_off<NB>(D0, 2, 1)>(vb), l3 = tr_read<v_rd_off<NB>(D0, 3, 0)>(vb), h3 = tr_read<v_rd_off<NB>(D0, 3, 1)>(vb);
    asm volatile("s_waitcnt lgkmcnt(0)" ::: "memory"); __builtin_amdgcn_sched_barrier(0);
#define AT_PK(L, H) (bf16x8){L[0], L[1], L[2], L[3], H[0], H[1], H[2], H[3]}
    od = __builtin_amdgcn_mfma_f32_32x32x16_bf16(pa0, AT_PK(l0, h0), od, 0, 0, 0);
    od = __builtin_amdgcn_mfma_f32_32x32x16_bf16(pa1, AT_PK(l1, h1), od, 0, 0, 0);
    od = __builtin_amdgcn_mfma_f32_32x32x16_bf16(pa2, AT_PK(l2, h2), od, 0, 0, 0);
    od = __builtin_amdgcn_mfma_f32_32x32x16_bf16(pa3, AT_PK(l3, h3), od, 0, 0, 0);
#undef AT_PK
}
__device__ __forceinline__ float slope_of(int h) { return __builtin_amdgcn_exp2f(-(float)(h + 1)); }

constexpr int L_SCR = 65536, L_TBL = 67584, L_X = 69632;

struct Ptrs { const bf16_t* qkv; bf16_t* att; bf16_t* obr; float* lse; const float* rpb; const float* subln; float lam; const float* kn; };

struct PolDil {
    static constexpr int W = 64, KIND = 0;
    int b, h, br, dil, res, qs0, tlo, thi; float nsl;
    __device__ __forceinline__ void init(int u) {
        br = u >> 11; const int v = u & 2047, sub = v & 15, bh = v >> 4; b = bh >> 3; h = bh & 7;
        dil = br == 0 ? 1 : (br == 1 ? 4 : 16); const int L = T / dil, nqb = L / 256;
        res = sub / nqb; qs0 = (sub % nqb) * 256;
        tlo = qs0 > 0 ? 0 : 1; thi = (qs0 + 256 < L) ? 6 : 5;
        nsl = -slope_of(h) * (float)dil * LOG2E;
    }
    __device__ __forceinline__ long qtok(int wid, int i) const { return (long)b * T + res + dil * (qs0 + 32 * wid + i); }
    __device__ __forceinline__ int qcol(int) const { return h * 64; }
    __device__ __forceinline__ int kcol0() const { return 512 + h * 64; }
    __device__ __forceinline__ int vcol0() const { return 1024 + h * 64; }
    __device__ __forceinline__ int kfrag(int) const { return 0; }
    __device__ __forceinline__ long ktok(int t, int row) const { return (long)b * T + res + dil * (qs0 - 64 + 64 * t + row); }
    __device__ __forceinline__ bool need(int t, int wid) const { return (64 * t - 64 <= 32 * wid + 95) && (64 * t - 1 >= 32 * wid - 64); }
    __device__ __forceinline__ void cinit(f32x16& p0, f32x16& p1, int t, int wid, int r32, int hi, const LAS float*, float m) const {
        const float base = (float)(32 * wid + r32 + 64 - 64 * t - 4 * hi);
#pragma unroll
        for (int r = 0; r < 16; ++r) { const float c = (float)((r & 3) + 8 * (r >> 2));
            const float a0 = fabsf(base - c), a1 = fabsf(base - (c + 32.f));
            p0[r] = a0 <= 64.f ? nsl * a0 - m : -INFINITY; p1[r] = a1 <= 64.f ? nsl * a1 - m : -INFINITY; }
    }
};
struct PolNat {
    static constexpr int W = 64, KIND = 1;
    int b, h, qb, r0, kr0, tlo, thi;
    __device__ __forceinline__ static int clip(int v, int lo, int hi_) { return v < lo ? lo : (v > hi_ ? hi_ : v); }
    __device__ __forceinline__ void init(int u) {
        qb = u & 15; const int bh = u >> 4; b = bh >> 3; h = bh & 7; r0 = 4 * qb;
        kr0 = clip(r0 - 4, 0, 56); tlo = 0; thi = clip(r0 - 1, 0, 56) + 8 - kr0;
    }
    __device__ __forceinline__ long qtok(int wid, int i) const { return (long)b * T + 256 * qb + 32 * wid + i; }
    __device__ __forceinline__ int qcol(int) const { return 1536 + h * 64; }
    __device__ __forceinline__ int kcol0() const { return 2048 + h * 64; }
    __device__ __forceinline__ int vcol0() const { return 2560 + h * 64; }
    __device__ __forceinline__ int kfrag(int) const { return 0; }
    __device__ __forceinline__ long ktok(int t, int row) const { return (long)b * T + 64 * (kr0 + t) + row; }
    __device__ __forceinline__ bool need(int t, int wid) const { const int r = r0 + (wid >> 1), rs = clip(r - 4, 0, 56), kr = kr0 + t; return kr >= rs && kr < rs + 8; }
    __device__ __forceinline__ void cinit(f32x16& p0, f32x16& p1, int t, int wid, int r32, int hi, const LAS float* tbl, float m) const {
        const int r = r0 + (wid >> 1), kr = kr0 + t, c = 32 * (wid & 1) + r32, wc = clip(c - 8, 0, 48);
        const LAS float* tp = tbl + 64 + (kr - r + 7) * 32 + (15 - c + 4 * hi);
        const int f = 4 * hi - wc;
#pragma unroll
        for (int q = 0; q < 16; ++q) { const int cq = (q & 3) + 8 * (q >> 2);
            const float v0 = tp[cq], v1 = tp[cq + 32];
            p0[q] = ((unsigned)(cq + f) < 16u) ? v0 - m : -INFINITY; p1[q] = ((unsigned)(cq + 32 + f) < 16u) ? v1 - m : -INFINITY; }
    }
};
struct PolDiff {
    static constexpr int W = 128, KIND = 2;
    int b, h, qb, tlo, thi; float nsl;
    __device__ __forceinline__ void init(int u) { const int k = u >> 8, c0 = u & 255, c = (c0 & 7) * 32 + (c0 >> 3)  , r = (k >> 3) * 256 + c; h = k & 7; b = r >> 5; qb = r & 31; tlo = 0; thi = T / 64; nsl = -slope_of(h) * LOG2E; }
    __device__ __forceinline__ long qtok(int wid, int i) const { return (long)b * T + 128 * qb + 32 * (wid & 3) + i; }
    __device__ __forceinline__ int qcol(int wid) const { return h * 128 + 64 * (wid >> 2); }
    __device__ __forceinline__ int kcol0() const { return 1024 + h * 128; }
    __device__ __forceinline__ int vcol0() const { return 2048 + h * 128; }
    __device__ __forceinline__ int kfrag(int wid) const { return 64 * (wid >> 2); }
    __device__ __forceinline__ long ktok(int t, int row) const { return (long)b * T + 64 * t + row; }
    __device__ __forceinline__ bool need(int, int) const { return true; }
    template <int BLK> __device__ __forceinline__ void cinit_off(f32x16& p, int t, int wid, int r32, int hi) const {
        const float base = (float)(128 * qb + 32 * (wid & 3) + r32 - 64 * t - 4 * hi - 32 * BLK);
        const float sn = t < 2 * qb ? nsl : -nsl, A = sn * base, cf = -sn;
#pragma unroll
        for (int r = 0; r < 16; ++r) p[r] = fmaf(cf, (float)((r & 3) + 8 * (r >> 2)), A);
    }
    template <int BLK> __device__ __forceinline__ void cinit_abs(f32x16& p, int t, int wid, int r32, int hi) const {
        const float base = (float)(128 * qb + 32 * (wid & 3) + r32 - 64 * t - 4 * hi - 32 * BLK);
#pragma unroll
        for (int r = 0; r < 16; ++r) p[r] = nsl * fabsf(base - (float)((r & 3) + 8 * (r >> 2)));
    }
    __device__ __forceinline__ void cinit(f32x16& p0, f32x16& p1, int t, int wid, int r32, int hi, const LAS float*, float m) const {
        const int i0 = 128 * qb + 32 * (wid & 3);
        const float base = (float)(i0 + r32 - 64 * t - 4 * hi);
        if (64 * t + 63 < i0) {
            const float A = nsl * base - m, n2 = -nsl;
#pragma unroll
            for (int r = 0; r < 16; ++r) { const float c = (float)((r & 3) + 8 * (r >> 2)); p0[r] = fmaf(n2, c, A); p1[r] = fmaf(n2, c + 32.f, A); }
        } else if (64 * t > i0 + 31) {
            const float A = -nsl * base - m;
#pragma unroll
            for (int r = 0; r < 16; ++r) { const float c = (float)((r & 3) + 8 * (r >> 2)); p0[r] = fmaf(nsl, c, A); p1[r] = fmaf(nsl, c + 32.f, A); }
        } else {
#pragma unroll
            for (int r = 0; r < 16; ++r) { const float c = (float)((r & 3) + 8 * (r >> 2));
                p0[r] = nsl * fabsf(base - c) - m; p1[r] = nsl * fabsf(base - (c + 32.f)) - m; }
        }
    }
};

template <class Pol> __device__ __forceinline__ void attn_unit(const Pol& P, LAS unsigned char* lds, const Ptrs& X, bf16x8& pq0, bf16x8& pq1, bf16x8& pq2, bf16x8& pq3, bf16x8& pk_, bf16x8& pv_, bool have, const Pol& Pn, bool hasn);
template <class Pol>
__device__ __forceinline__ void attn_unit(const Pol& P, LAS unsigned char* lds, const Ptrs& X, bf16x8& pq0, bf16x8& pq1, bf16x8& pq2, bf16x8& pq3, bf16x8& pk_, bf16x8& pv_, bool have, const Pol& Pn, bool hasn) {
    constexpr int W = Pol::W, NB = W / 32, CH = W / 64, KBYTES = 64 * W * 2, VBYTES = KBYTES, CPR = W / 8;
    int tid_ = threadIdx.x; asm volatile("" : "+v"(tid_));
    const int tid = tid_, wid = __builtin_amdgcn_readfirstlane(tid >> 6), lane = tid & 63, r32 = lane & 31, hi = lane >> 5;
    LAS unsigned char* K_lds = lds; LAS unsigned char* V_lds = lds + 2 * KBYTES;
    LAS float* li_l = (LAS float*)(lds + L_SCR) + wid * 64; LAS float* al_l = li_l + 32;
    LAS float* tbl = (LAS float*)(lds + L_TBL);
    const bf16_t* qkv = X.qkv;
    if constexpr (Pol::KIND == 1) { if (tid < 480) { const int row = tid >> 5, col = tid & 31; tbl[64 + tid] = col < 31 ? X.rpb[(P.h * 15 + row) * 31 + col] * LOG2E : 0.f; } }
    bf16x8 qr[4];
    const bool pre_ok = Pol::KIND != 2 && have;
    if (pre_ok) {
        qr[0] = pq0; qr[1] = pq1; qr[2] = pq2; qr[3] = pq3;
    } else { const bf16_t* qp = qkv + P.qtok(wid, r32) * NQKV + P.qcol(wid) + hi * 8;
#pragma unroll
      for (int d0 = 0; d0 < 4; ++d0) qr[d0] = *(const bf16x8*)(qp + d0 * 16); }
    const int kfb = P.kfrag(wid) * 2;
    bf16x8 ks[CH], vs[CH];
#define AT_SLOAD(t) do { _Pragma("unroll") for (int i_ = 0; i_ < CH; ++i_) { const int id_ = tid + 512 * i_, row_ = id_ / CPR, col_ = (id_ % CPR) * 8; \
        const bf16_t* g_ = qkv + P.ktok((t), row_) * NQKV + col_; ks[i_] = *(const bf16x8*)(g_ + P.kcol0()); vs[i_] = *(const bf16x8*)(g_ + P.vcol0()); } } while (0)
#define AT_SWRITE(b) do { _Pragma("unroll") for (int i_ = 0; i_ < CH; ++i_) { const int id_ = tid + 512 * i_, row_ = id_ / CPR, col_ = (id_ % CPR) * 8; \
        *(LAS bf16x8*)(K_lds + (b) * KBYTES + row_ * (W * 2) + ((col_ * 2) ^ ((row_ & 7) << 4))) = ks[i_]; \
        *(LAS bf16x8*)(V_lds + (b) * VBYTES + v_st<NB>(row_, col_)) = vs[i_]; } } while (0)
    float m_reg = 0.f, l_reg = 0.f; f32x16 o[NB];
#pragma unroll
    for (int d = 0; d < NB; ++d) o[d] = f32x16{};
    const int vb0 = (int)(unsigned)(size_t)V_lds + v_rd_base(lane);
    const int tlo = P.tlo, thi = P.thi;
    if (pre_ok) { ks[0] = pk_; vs[0] = pv_; } else AT_SLOAD(tlo);
    AT_SWRITE(tlo & 1); __syncthreads();
    for (int t = tlo; t < thi; ++t) {
        const int buf = t & 1;
        if constexpr (Pol::KIND != 2) { if (t + 1 < thi) AT_SLOAD(t + 1); }
        if constexpr (Pol::KIND != 2) { if (t + 1 == thi && hasn) {
            const bf16_t* qp = qkv + Pn.qtok(wid, r32) * NQKV + Pn.qcol(wid) + hi * 8;
            pq0 = *(const bf16x8*)(qp); pq1 = *(const bf16x8*)(qp + 16); pq2 = *(const bf16x8*)(qp + 32); pq3 = *(const bf16x8*)(qp + 48);
            const int row_ = tid / CPR, col_ = (tid % CPR) * 8; const bf16_t* g_ = qkv + Pn.ktok(Pn.tlo, row_) * NQKV + col_;
            pk_ = *(const bf16x8*)(g_ + Pn.kcol0()); pv_ = *(const bf16x8*)(g_ + Pn.vcol0()); } }
        if (P.need(t, wid)) {
            f32x16 p0, p1;
            P.cinit(p0, p1, t, wid, r32, hi, tbl, m_reg);
            const LAS unsigned char* Kb = K_lds + buf * KBYTES;
#pragma unroll
            for (int d0 = 0; d0 < 4; ++d0) { const int cb = kfb + (d0 * 16 + hi * 8) * 2, sw = cb ^ ((r32 & 7) << 4);
                const bf16x8 b0 = *(const LAS bf16x8*)(Kb + r32 * (W * 2) + sw);
                const bf16x8 b1 = *(const LAS bf16x8*)(Kb + (32 + r32) * (W * 2) + sw);
                p0 = __builtin_amdgcn_mfma_f32_32x32x16_bf16(b0, qr[d0], p0, 0, 0, 0);
                p1 = __builtin_amdgcn_mfma_f32_32x32x16_bf16(b1, qr[d0], p1, 0, 0, 0); }
            float pmax = fmaxf(p0[0], p1[0]);
#pragma unroll
            for (int r = 1; r < 16; ++r) pmax = fmaxf(fmaxf(pmax, p0[r]), p1[r]);
            { auto rr = __builtin_amdgcn_permlane32_swap(__float_as_uint(pmax), __float_as_uint(pmax), false, false);
              pmax = fmaxf(__uint_as_float(rr[0]), __uint_as_float(rr[1])); }
            float alpha = 1.f;
            if (__builtin_expect(!__all(pmax <= THR), 0)) {
                const float dm = fmaxf(pmax, 0.f); alpha = __builtin_amdgcn_exp2f(-dm); m_reg += dm;
#pragma unroll
                for (int r = 0; r < 16; ++r) { p0[r] -= dm; p1[r] -= dm; }
            }
            float ps = 0.f;
#pragma unroll
            for (int r = 0; r < 16; ++r) { p0[r] = __builtin_amdgcn_exp2f(p0[r]); p1[r] = __builtin_amdgcn_exp2f(p1[r]); ps += p0[r] + p1[r]; }
            { auto rr = __builtin_amdgcn_permlane32_swap(__float_as_uint(ps), __float_as_uint(ps), false, false);
              ps = __uint_as_float(rr[0]) + __uint_as_float(rr[1]); }
            l_reg = l_reg * alpha + ps;
            if (__any(alpha < 1.f)) { if (hi == 0) al_l[r32] = alpha; asm volatile("s_waitcnt lgkmcnt(0)" ::: "memory");
#pragma unroll
                for (int r = 0; r < 16; ++r) { const float a = al_l[crow(r, hi)];
#pragma unroll
                    for (int d = 0; d < NB; ++d) o[d][r] *= a; }
                asm volatile("s_waitcnt lgkmcnt(0)" ::: "memory"); }
            bf16x8 pa0, pa1, pa2, pa3;
#define AT_PK4(PP, BASE, OUT) do { unsigned a0 = cvtpk(PP[BASE + 0], PP[BASE + 1]), a1 = cvtpk(PP[BASE + 2], PP[BASE + 3]); \
    unsigned b0_ = cvtpk(PP[BASE + 4], PP[BASE + 5]), b1_ = cvtpk(PP[BASE + 6], PP[BASE + 7]); \
    auto r0_ = __builtin_amdgcn_permlane32_swap(a0, b0_, false, false); auto r1_ = __builtin_amdgcn_permlane32_swap(a1, b1_, false, false); \
    u32x4 w_ = {r0_[0], r1_[0], r0_[1], r1_[1]}; OUT = *reinterpret_cast<bf16x8*>(&w_); } while (0)
            AT_PK4(p0, 0, pa0); AT_PK4(p0, 8, pa1); AT_PK4(p1, 0, pa2); AT_PK4(p1, 8, pa3);
#undef AT_PK4
            const int vb = vb0 + buf * VBYTES;
            pv_one<NB, 0>(o[0], vb, pa0, pa1, pa2, pa3); pv_one<NB, 1>(o[1], vb, pa0, pa1, pa2, pa3);
            if constexpr (NB == 4) { pv_one<NB, 2>(o[2], vb, pa0, pa1, pa2, pa3); pv_one<NB, 3>(o[3], vb, pa0, pa1, pa2, pa3); }
        }
        if (t + 1 < thi) { if constexpr (Pol::KIND == 2) AT_SLOAD(t + 1); AT_SWRITE(buf ^ 1); }
        __syncthreads();
    }
#undef AT_SLOAD
#undef AT_SWRITE
    if (hi == 0) li_l[r32] = l_reg;
    asm volatile("s_waitcnt lgkmcnt(0)" ::: "memory");
    float rli[16];
#pragma unroll
    for (int r = 0; r < 16; ++r) rli[r] = __builtin_amdgcn_rcpf(li_l[crow(r, hi)]);
    if constexpr (Pol::KIND == 0) {
        bf16_t* ob = X.obr + (size_t)P.br * ((size_t)M * 512);
#pragma unroll
        for (int r = 0; r < 16; ++r) { const long tok = P.qtok(wid, crow(r, hi));
#pragma unroll
            for (int d = 0; d < NB; ++d) ob[tok * 512 + P.h * 64 + d * 32 + r32] = (bf16_t)(cvtpk(o[d][r] * rli[r], 0.f) & 0xffffu); }
        if (hi == 0) X.lse[(size_t)P.br * ((size_t)M * 8) + P.qtok(wid, r32) * 8 + P.h] = m_reg + __builtin_amdgcn_logf(l_reg);
    } else if constexpr (Pol::KIND == 1) {
#pragma unroll
        for (int r = 0; r < 16; ++r) { const long tok = P.qtok(wid, crow(r, hi));
#pragma unroll
            for (int d = 0; d < NB; ++d) X.att[tok * D + 512 + P.h * 64 + d * 32 + r32] = (bf16_t)(cvtpk(o[d][r] * rli[r], 0.f) & 0xffffu); }
    } else {
        LAS float* XB = (LAS float*)(lds + L_X);
        if (wid >= 4) {
#pragma unroll
            for (int r = 0; r < 16; ++r) { const int row = 32 * (wid & 3) + crow(r, hi);
#pragma unroll
                for (int d = 0; d < NB; ++d) XB[row * 128 + d * 32 + r32] = X.lam * o[d][r] * rli[r]; }
        }
        __syncthreads();
        if (wid < 4) {
#pragma unroll
            for (int r = 0; r < 16; ++r) { const int row = 32 * wid + crow(r, hi); float s = 0.f;
#pragma unroll
                for (int d = 0; d < NB; ++d) { const float y = o[d][r] * rli[r] - XB[row * 128 + d * 32 + r32]; o[d][r] = y; s += y * y; }
                s += sx(s, 1, lane); s += sx(s, 2, lane); s += sx(s, 4, lane); s += sx(s, 8, lane); s += sx(s, 16, lane);
                const float rs = (1.0f - LAM_INIT) / sqrtf(s * (1.0f / 128.f) + SUBLN_EPS);
                const long tok = P.qtok(wid, crow(r, hi));
#pragma unroll
                for (int d = 0; d < NB; ++d) X.att[tok * D + P.h * 128 + d * 32 + r32] = (bf16_t)(cvtpk(o[d][r] * rs * X.subln[d * 32 + r32], 0.f) & 0xffffu); }
        }
        __syncthreads();
    }
}

template <class Pol> __device__ __forceinline__ void attn_unit(const Pol& P, LAS unsigned char* lds, const Ptrs& X) { bf16x8 z0_ = {}, z1_ = {}, z2_ = {}, z3_ = {}, z4_ = {}, z5_ = {}; attn_unit(P, lds, X, z0_, z1_, z2_, z3_, z4_, z5_, false, P, false); }
typedef __bf16 bf16x2_t __attribute__((ext_vector_type(2)));
typedef float f32x2_t __attribute__((ext_vector_type(2)));
__device__ __forceinline__ unsigned pk2(float lo, float hi) { const f32x2_t v = {lo, hi}; return __builtin_bit_cast(unsigned, __builtin_convertvector(v, bf16x2_t)); }
__device__ __forceinline__ s16x4 trb(const LAS unsigned char* p) { return __builtin_amdgcn_ds_read_tr16_b64_v4i16((LAS s16x4*)p); }
template <int D0> __device__ __forceinline__ void pv_blk(f32x16& od, const LAS unsigned char* vb, bf16x8 pa0, bf16x8 pa1, bf16x8 pa2, bf16x8 pa3) {
    constexpr int NB = 4;
    const s16x4 l0 = trb(vb + v_rd_off<NB>(D0, 0, 0)), h0 = trb(vb + v_rd_off<NB>(D0, 0, 1)), l1 = trb(vb + v_rd_off<NB>(D0, 1, 0)), h1 = trb(vb + v_rd_off<NB>(D0, 1, 1));
    const s16x4 l2 = trb(vb + v_rd_off<NB>(D0, 2, 0)), h2 = trb(vb + v_rd_off<NB>(D0, 2, 1)), l3 = trb(vb + v_rd_off<NB>(D0, 3, 0)), h3 = trb(vb + v_rd_off<NB>(D0, 3, 1));
#define AT_PK(L, H) (bf16x8){L[0], L[1], L[2], L[3], H[0], H[1], H[2], H[3]}
    od = __builtin_amdgcn_mfma_f32_32x32x16_bf16(pa0, AT_PK(l0, h0), od, 0, 0, 0);
    od = __builtin_amdgcn_mfma_f32_32x32x16_bf16(pa1, AT_PK(l1, h1), od, 0, 0, 0);
    od = __builtin_amdgcn_mfma_f32_32x32x16_bf16(pa2, AT_PK(l2, h2), od, 0, 0, 0);
    od = __builtin_amdgcn_mfma_f32_32x32x16_bf16(pa3, AT_PK(l3, h3), od, 0, 0, 0);
#undef AT_PK
}
constexpr int DF_SCR = 98304;
__device__ __forceinline__ void diff_unit(const PolDiff& P, LAS unsigned char* lds, const Ptrs& X) {
    constexpr int W = 128, NB = 4, CH = 2, KBYTES = 64 * W * 2, VBYTES = KBYTES, NT = T / 64;
    int tid_ = threadIdx.x; asm volatile("" : "+v"(tid_));
    const int tid = tid_, wid = __builtin_amdgcn_readfirstlane(tid >> 6), lane = tid & 63, r32 = lane & 31, hi = lane >> 5;
    LAS unsigned char* K_lds = lds; LAS unsigned char* V_lds = lds + 3 * KBYTES;
    LAS float* li_l = (LAS float*)(lds + DF_SCR) + wid * 64;
    LAS unsigned* flag = (LAS unsigned*)(lds + DF_SCR + 8 * 256);
    const bf16_t* qkv = X.qkv;
    bf16x8 qr[4];
    { const bf16_t* qp = qkv + P.qtok(wid, r32) * NQKV + P.qcol(wid) + hi * 8;
#pragma unroll
      for (int d0 = 0; d0 < 4; ++d0) qr[d0] = *(const bf16x8*)(qp + d0 * 16); }
    const int kfb = P.kfrag(wid) * 2;
    int gko, gvo;
    { const int row = 4 * wid + (lane >> 4), c = (lane & 15) ^ (row & 7); gko = row * NQKV + P.kcol0() + 8 * c; }
    { const int sidx = 2 * wid + (lane >> 5), kk = 8 * (sidx >> 2) + ((lane & 31) >> 2), k = (kk & ~0xC) | ((kk & 4) << 1) | ((kk & 8) >> 1), c = 32 * (sidx & 3) + 8 * (lane & 3);
      gvo = k * NQKV + P.vcol0() + c; }
    const bf16_t* gtile = qkv + (long)P.b * T * NQKV;
    const LAS unsigned char* krd = K_lds + r32 * (W * 2);
    const LAS unsigned char* vrd = V_lds + v_rd_base(lane);
    if (tid == 0) flag[0] = 0u;
    int t_lo, n_tiles;
    { float q2 = 0.f;
#pragma unroll
      for (int d0 = 0; d0 < 4; ++d0)
#pragma unroll
          for (int e = 0; e < 8; ++e) { const float f = bf2f((unsigned short)qr[d0][e]); q2 = fmaf(f, f, q2); }
      q2 += sx(q2, 32, lane);
#pragma unroll
      for (int o_ = 1; o_ < 32; o_ <<= 1) q2 = fmaxf(q2, sx(q2, o_, lane));
      if (lane == 0) li_l[0] = q2;
      __syncthreads();
      float qm1 = 0.f, qm2 = 0.f;
#pragma unroll
      for (int w_ = 0; w_ < 4; ++w_) { qm1 = fmaxf(qm1, ((LAS float*)(lds + DF_SCR))[w_ * 64]); qm2 = fmaxf(qm2, ((LAS float*)(lds + DF_SCR))[(w_ + 4) * 64]); }
      qm1 = sqrtf(qm1) * 1.01f; qm2 = sqrtf(qm2) * 1.01f;
      const float* kn = X.kn + ((P.b * 8 + P.h) * 2) * 128;
      const float k1_ = sqrtf(kn[2 * lane] + kn[2 * lane + 1]) * 1.001f, k2_ = sqrtf(kn[128 + 2 * lane] + kn[128 + 2 * lane + 1]) * 1.001f;
      const float sb = fmaxf(qm1 * k1_, qm2 * k2_);
      const int i0u = 128 * P.qb;
      const int dist = lane < 2 * P.qb ? i0u - (64 * lane + 63) : (lane > 2 * P.qb + 1 ? 64 * lane - (i0u + 127) : 0);
      const bool visit = sb + P.nsl * (float)dist > -152.f;
      const unsigned long long mask = __ballot(visit) | (3ull << (2 * P.qb));
      int lo = __builtin_ctzll(mask), hi_t = 63 - __builtin_clzll(mask);
      if (((hi_t - lo + 1) & 1) != 0) { if (lo > 0) --lo; else ++hi_t; }
      if (hi_t - lo + 1 < 4) { if (lo > 1) lo -= 2; else hi_t += 2; }
      t_lo = __builtin_amdgcn_readfirstlane(lo); n_tiles = __builtin_amdgcn_readfirstlane(hi_t - lo + 1);
      __syncthreads();
    }
#define DF_TL(k) ((k) < 2 ? 2 * P.qb + (k) : (t_lo + (k) - 2 < 2 * P.qb ? t_lo + (k) - 2 : t_lo + (k)))
#define DF_GLDS(k, rb) do { const bf16_t* g_ = gtile + (long)(64 * DF_TL(k)) * NQKV; _Pragma("unroll") for (int i_ = 0; i_ < 2; ++i_) { \
        __builtin_amdgcn_global_load_lds((const unsigned*)(g_ + gko + i_ * (32 * NQKV)), (LAS unsigned*)(K_lds + (rb) * KBYTES + (wid + 8 * i_) * 1024), 16, 0, 0); \
        __builtin_amdgcn_global_load_lds((const unsigned*)(g_ + gvo + i_ * (32 * NQKV)), (LAS unsigned*)(V_lds + (rb) * VBYTES + (wid + 8 * i_) * 1024), 16, 0, 0); } } while (0)
#define DF_QK(p0, p1, rb) do { const LAS unsigned char* Kb_ = krd + (rb) * KBYTES; \
        _Pragma("unroll") for (int d0 = 0; d0 < 4; ++d0) { const int sw_ = (kfb + (d0 * 16 + hi * 8) * 2) ^ ((r32 & 7) << 4); \
            const bf16x8 b0_ = *(const LAS bf16x8*)(Kb_ + sw_); const bf16x8 b1_ = *(const LAS bf16x8*)(Kb_ + 32 * (W * 2) + sw_); \
            p0 = __builtin_amdgcn_mfma_f32_32x32x16_bf16(b0_, qr[d0], p0, 0, 0, 0); p1 = __builtin_amdgcn_mfma_f32_32x32x16_bf16(b1_, qr[d0], p1, 0, 0, 0); } } while (0)
#define DF_KRD(b0v, b1v, rb, d0) do { const LAS unsigned char* Kb_ = krd + (rb) * KBYTES; const int sw_ = (kfb + ((d0) * 16 + hi * 8) * 2) ^ ((r32 & 7) << 4); \
        b0v = *(const LAS bf16x8*)(Kb_ + sw_); b1v = *(const LAS bf16x8*)(Kb_ + 32 * (W * 2) + sw_); } while (0)
#define DF_KMM(p0, p1, b0v, b1v, d0) do { p0 = __builtin_amdgcn_mfma_f32_32x32x16_bf16(b0v, qr[d0], p0, 0, 0, 0); p1 = __builtin_amdgcn_mfma_f32_32x32x16_bf16(b1v, qr[d0], p1, 0, 0, 0); } while (0)
#define DF_QK1(p0, p1, rb, d0) do { const LAS unsigned char* Kb_ = krd + (rb) * KBYTES; const int sw_ = (kfb + ((d0) * 16 + hi * 8) * 2) ^ ((r32 & 7) << 4); \
        const bf16x8 b0_ = *(const LAS bf16x8*)(Kb_ + sw_); const bf16x8 b1_ = *(const LAS bf16x8*)(Kb_ + 32 * (W * 2) + sw_); \
        p0 = __builtin_amdgcn_mfma_f32_32x32x16_bf16(b0_, qr[d0], p0, 0, 0, 0); p1 = __builtin_amdgcn_mfma_f32_32x32x16_bf16(b1_, qr[d0], p1, 0, 0, 0); } while (0)
#define DF_SUM16(p) ((((p[0] + p[1]) + (p[2] + p[3])) + ((p[4] + p[5]) + (p[6] + p[7]))) + (((p[8] + p[9]) + (p[10] + p[11])) + ((p[12] + p[13]) + (p[14] + p[15]))))
#define DF_EXP_H(pp, b8) do { _Pragma("unroll") for (int r = 0; r < 8; ++r) pp[(b8) + r] = __builtin_amdgcn_exp2f(pp[(b8) + r]); } while (0)
#define DF_EXP_A(p0, p1) do { _Pragma("unroll") for (int r = 0; r < 16; ++r) p0[r] = __builtin_amdgcn_exp2f(p0[r]); _Pragma("unroll") for (int r = 0; r < 8; ++r) p1[r] = __builtin_amdgcn_exp2f(p1[r]); } while (0)
#define DF_FINISH(p0, p1) do { _Pragma("unroll") for (int r = 8; r < 16; ++r) p1[r] = __builtin_amdgcn_exp2f(p1[r]); \
        float ps_ = 0.f; _Pragma("unroll") for (int r = 0; r < 16; ++r) ps_ += p0[r] + p1[r]; l_reg += ps_; \
        DF_PK4(p0, 0, pa0); DF_PK4(p0, 8, pa1); DF_PK4(p1, 0, pa2); DF_PK4(p1, 8, pa3); } while (0)
#define DF_PK4(PP, BASE, OUT) do { unsigned a0 = pk2(PP[BASE + 0], PP[BASE + 1]), a1 = pk2(PP[BASE + 2], PP[BASE + 3]); \
    unsigned b0_ = pk2(PP[BASE + 4], PP[BASE + 5]), b1_ = pk2(PP[BASE + 6], PP[BASE + 7]); \
    auto r0_ = __builtin_amdgcn_permlane32_swap(a0, b0_, false, false); auto r1_ = __builtin_amdgcn_permlane32_swap(a1, b1_, false, false); \
    u32x4 w_ = {r0_[0], r1_[0], r0_[1], r1_[1]}; OUT = *reinterpret_cast<bf16x8*>(&w_); } while (0)
#define DF_PV(rb) do { const LAS unsigned char* vb_ = vrd + (rb) * VBYTES; pv_blk<0>(o[0], vb_, pa0, pa1, pa2, pa3); pv_blk<1>(o[1], vb_, pa0, pa1, pa2, pa3); \
        pv_blk<2>(o[2], vb_, pa0, pa1, pa2, pa3); pv_blk<3>(o[3], vb_, pa0, pa1, pa2, pa3); } while (0)
#define DF_HALF(c0, c1, q0, q1, j, LOADS) do { \
        DF_KRD(ka0, ka1, rc, 0); if (LOADS) DF_GLDS((j) + 1, rn); __builtin_amdgcn_sched_barrier(0);     \
        { float ps0_ = 0.f, ps1_ = 0.f; \
          DF_KRD(kb0, kb1, rc, 1); DF_KMM(c0, c1, ka0, ka1, 0); DF_EXP_H(q1, 8); __builtin_amdgcn_sched_barrier(0); \
          DF_KRD(ka0, ka1, rc, 2); DF_KMM(c0, c1, kb0, kb1, 1); ps0_ = DF_SUM16(q0); DF_PK4(q0, 0, pa0); __builtin_amdgcn_sched_barrier(0); \
          DF_KRD(kb0, kb1, rc, 3); DF_KMM(c0, c1, ka0, ka1, 2); ps1_ = DF_SUM16(q1); DF_PK4(q0, 8, pa1); __builtin_amdgcn_sched_barrier(0); \
          DF_KMM(c0, c1, kb0, kb1, 3); l_reg += ps0_ + ps1_; DF_PK4(q1, 0, pa2); DF_PK4(q1, 8, pa3); __builtin_amdgcn_sched_barrier(0); } \
        { const LAS unsigned char* vb_ = vrd + rp * VBYTES; \
          pv_blk<0>(o[0], vb_, pa0, pa1, pa2, pa3); DF_EXP_H(c0, 0); __builtin_amdgcn_sched_barrier(0); \
          pv_blk<1>(o[1], vb_, pa0, pa1, pa2, pa3); DF_EXP_H(c0, 8); __builtin_amdgcn_sched_barrier(0); \
          pv_blk<2>(o[2], vb_, pa0, pa1, pa2, pa3); DF_EXP_H(c1, 0); if (LOADS) P.cinit_off<0>(q0, DF_TL((j) + 1), wid, r32, hi); __builtin_amdgcn_sched_barrier(0); \
          pv_blk<3>(o[3], vb_, pa0, pa1, pa2, pa3); if (LOADS) P.cinit_off<1>(q1, DF_TL((j) + 1), wid, r32, hi); __builtin_amdgcn_sched_barrier(0); } \
        __syncthreads(); { const int t_ = rp; rp = rc; rc = rn; rn = t_; } } while (0)
    float l_reg = 0.f; f32x16 o[NB];
#pragma unroll
    for (int d = 0; d < NB; ++d) o[d] = f32x16{};
    f32x16 pA0, pA1, pB0, pB1; bf16x8 pa0, pa1, pa2, pa3, ka0, ka1, kb0, kb1;
    int rp = 2, rc = 0, rn = 1;
    DF_GLDS(0, 0); DF_GLDS(1, 1); __syncthreads();
    P.cinit_abs<0>(pA0, DF_TL(0), wid, r32, hi); P.cinit_abs<1>(pA1, DF_TL(0), wid, r32, hi); DF_QK(pA0, pA1, 0); DF_EXP_A(pA0, pA1);
    P.cinit_abs<0>(pB0, DF_TL(1), wid, r32, hi); P.cinit_abs<1>(pB1, DF_TL(1), wid, r32, hi);
    rp = 0; rc = 1; rn = 2;
    { int j = 1;
      do { DF_HALF(pB0, pB1, pA0, pA1, j, true);
           DF_HALF(pA0, pA1, pB0, pB1, j + 1, true); j += 2; } while (j + 2 < n_tiles); }
    DF_HALF(pB0, pB1, pA0, pA1, n_tiles - 1, false);
    DF_FINISH(pB0, pB1); DF_PV(rp);
#undef DF_GLDS
#undef DF_TL
#undef DF_QK
#undef DF_EXP_A
#undef DF_QK1
#undef DF_KRD
#undef DF_KMM
#undef DF_SUM16
#undef DF_EXP_H
#undef DF_FINISH
#undef DF_PK4
#undef DF_PV
#undef DF_HALF
    int tid2_ = threadIdx.x; asm volatile("" : "+v"(tid2_));
    const int lane2 = tid2_ & 63, r32b = lane2 & 31, hib = lane2 >> 5;
    { auto rr = __builtin_amdgcn_permlane32_swap(__float_as_uint(l_reg), __float_as_uint(l_reg), false, false);
      l_reg = __uint_as_float(rr[0]) + __uint_as_float(rr[1]); }
    const bool bad = !(l_reg > 7.9e-31f && l_reg < 1.2e30f);
    if (__any(bad) && lane2 == 0) flag[0] = 1u;
    __syncthreads();
    const bool redo = __builtin_amdgcn_readfirstlane((int)flag[0]) != 0;
    __syncthreads();
    if (redo) { attn_unit(P, lds, X); return; }
    if (hib == 0) li_l[r32b] = l_reg;
    asm volatile("s_waitcnt lgkmcnt(0)" ::: "memory");
    float rli[16];
#pragma unroll
    for (int r = 0; r < 16; ++r) rli[r] = __builtin_amdgcn_rcpf(li_l[crow(r, hib)]);
    LAS float* XB = (LAS float*)lds;
    if (wid >= 4) {
#pragma unroll
        for (int r = 0; r < 16; ++r) { const int row = 32 * (wid & 3) + crow(r, hib);
#pragma unroll
            for (int d = 0; d < NB; ++d) XB[row * 128 + d * 32 + r32b] = X.lam * o[d][r] * rli[r]; }
    }
    __syncthreads();
    if (wid < 4) {
#pragma unroll
        for (int r = 0; r < 16; ++r) { const int row = 32 * wid + crow(r, hib); float s = 0.f;
#pragma unroll
            for (int d = 0; d < NB; ++d) { const float y = o[d][r] * rli[r] - XB[row * 128 + d * 32 + r32b]; o[d][r] = y; s += y * y; }
            s += sx(s, 1, lane2); s += sx(s, 2, lane2); s += sx(s, 4, lane2); s += sx(s, 8, lane2); s += sx(s, 16, lane2);
            const float rs = (1.0f - LAM_INIT) / sqrtf(s * (1.0f / 128.f) + SUBLN_EPS);
            const long tok = P.qtok(wid, crow(r, hib));
#pragma unroll
            for (int d = 0; d < NB; ++d) X.att[tok * D + P.h * 128 + d * 32 + r32b] = (bf16_t)(pk2(o[d][r] * rs * X.subln[d * 32 + r32b], 0.f) & 0xffffu); }
    }
    __syncthreads();
}
}

#define XB_TMO      128
#define XB_XCNT(j)  (256  + 64 * (j))
#define XB_XSUB(j)  (1280 + 64 * (j))
#define XB_XGEN(j)  (2304 + 64 * (j))
#define XB_TOP      3328
#define XB_TOPGEN   3392
#define XCD_BAR_WORDS 3456
#define XB_SPIN_CAP (1u << 18)

__device__ __forceinline__ unsigned xb_ld(unsigned* p)              { return __hip_atomic_load(p, __ATOMIC_RELAXED, __HIP_MEMORY_SCOPE_AGENT); }
__device__ __forceinline__ unsigned xb_add(unsigned* p, unsigned v) { return __hip_atomic_fetch_add(p, v, __ATOMIC_RELAXED, __HIP_MEMORY_SCOPE_AGENT); }
__device__ __forceinline__ unsigned xb_xcc_id() { return (unsigned)__builtin_amdgcn_s_getreg((3 << 11) | 20) & 0xFu; }
#define XB_SPIN(cond, bar) do { unsigned _sp = 0; while (cond) { __builtin_amdgcn_s_sleep(1); \
    if ((++_sp & 255u) == 0u) { if (xb_ld(&(bar)[XB_TMO])) break; if (_sp > XB_SPIN_CAP) { atomicAdd(&(bar)[XB_TMO], 1u); break; } } } } while (0)

struct XcdBarrier {
    unsigned* bar; unsigned x;
    volatile LAS unsigned* st;
};

__device__ __forceinline__ XcdBarrier xcd_barrier_post(unsigned* bar, volatile LAS unsigned* st) {
    XcdBarrier b; b.bar = bar; b.x = xb_xcc_id(); b.st = st;
    if (threadIdx.x == 0) (void)xb_add(&bar[XB_XCNT(b.x)], 1u);
    return b;
}
__device__ __forceinline__ void xcd_barrier_complete(unsigned* bar, unsigned x, unsigned& nloc, unsigned& nx) {
    const unsigned G = gridDim.x * gridDim.y * gridDim.z;
    unsigned sum, cnt, mine, sp = 0u;
    for (;;) {
        sum = 0u; cnt = 0u; mine = 0u;
#pragma unroll
        for (unsigned j = 0; j < 16; ++j) { const unsigned c = xb_ld(&bar[XB_XCNT(j)]); sum += c; cnt += (c > 0u) ? 1u : 0u; mine = (j == x) ? c : mine; }
        if (sum == G) break;
        __builtin_amdgcn_s_sleep(1);
        if ((++sp & 255u) == 0u) { if (xb_ld(&bar[XB_TMO])) break; if (sp > XB_SPIN_CAP) { atomicAdd(&bar[XB_TMO], 1u); break; } }
    }
    nloc = mine > 0u ? mine : 1u; nx = cnt > 0u ? cnt : 1u;
}

__device__ __forceinline__ void xcd_barrier(const XcdBarrier& b) {
    asm volatile("s_waitcnt vmcnt(0)" ::: "memory");
    __syncthreads();
    if (threadIdx.x == 0) {
        unsigned* bar = b.bar;
        __builtin_amdgcn_s_waitcnt(0);
        unsigned nloc = b.st[0], nx = b.st[1];
        if (nloc == 0u) { xcd_barrier_complete(bar, b.x, nloc, nx); b.st[0] = nloc; b.st[1] = nx; }
        const unsigned old = xb_add(&bar[XB_XSUB(b.x)], 1u);
        const unsigned gen = old / nloc;
        if (old + 1u == (gen + 1u) * nloc) {
            __builtin_amdgcn_fence(__ATOMIC_RELEASE, "agent");
            asm volatile("s_waitcnt vmcnt(0)" ::: "memory");
            const unsigned og = xb_add(&bar[XB_TOP], 1u);
            const unsigned tg = og / nx;
            if (og + 1u == (tg + 1u) * nx) xb_add(&bar[XB_TOPGEN], 1u);
            else XB_SPIN(xb_ld(&bar[XB_TOPGEN]) == tg, bar);
            __builtin_amdgcn_fence(__ATOMIC_ACQUIRE, "agent");
            xb_add(&bar[XB_XGEN(b.x)], 1u);
            asm volatile("s_waitcnt vmcnt(0)" ::: "memory");
        } else {
            XB_SPIN(xb_ld(&bar[XB_XGEN(b.x)]) == gen, bar);
            __builtin_amdgcn_fence(__ATOMIC_ACQUIRE, "agent");
            asm volatile("s_waitcnt vmcnt(0)" ::: "memory");
        }
    }
    __syncthreads();
}

__device__ __forceinline__ void grp_barrier(unsigned* cnt, unsigned& epoch, unsigned nmem) {
    asm volatile("s_waitcnt vmcnt(0)" ::: "memory");
    __syncthreads();
    epoch += 1u;
    if (threadIdx.x == 0) {
        __builtin_amdgcn_fence(__ATOMIC_RELEASE, "agent"); asm volatile("s_waitcnt vmcnt(0)" ::: "memory");
        (void)xb_add(cnt, 1u);
        const unsigned target = nmem * epoch; unsigned sp = 0u;
        while (xb_ld(cnt) < target) { __builtin_amdgcn_s_sleep(1); if (++sp > (1u << 22)) break; }
        __builtin_amdgcn_fence(__ATOMIC_ACQUIRE, "agent"); asm volatile("s_waitcnt vmcnt(0)" ::: "memory");
    }
    __syncthreads();
}

constexpr size_t MiB = 1u << 20;
constexpr size_t WS_W = 2 * MiB, WS_WL = 26 * MiB;
constexpr size_t WO_IN = 0, WO_O = 6 * MiB, WO_GU = 8 * MiB, WO_D = 19 * MiB;
constexpr size_t WS_BAR = 512 * 1024, WS_BAR_BYTES = 32768;
constexpr size_t WS_KN = 0;
constexpr size_t WS_SS = 56 * MiB, WS_LSE = 60 * MiB, WS_XB = 68 * MiB, WS_ATT = 196 * MiB, WS_OBR = 324 * MiB, WS_QKV = 516 * MiB, WS_H = WS_QKV, WS_END = 900 * MiB;
constexpr int LDS_BYTES = 147456;

struct Args { const float* in[22]; float* out; unsigned char* ws; int ph_lo, ph_hi; };
enum { I_X = 0, I_A0N = 1, I_A0IN = 2, I_A0OUT = 3, I_RPB = 4, I_F0N = 5, I_F0G = 6, I_F0U = 7, I_F0D = 8, I_A1N = 9, I_A1QKV = 10, I_A1OUT = 11,
       I_LQ1 = 12, I_LK1 = 13, I_LQ2 = 14, I_LK2 = 15, I_SUBLN = 16, I_F1N = 17, I_F1G = 18, I_F1U = 19, I_F1D = 20, I_FN = 21 };
constexpr int NPH = 14;

__device__ __forceinline__ float wave_sum(float v, int lane) {
#pragma unroll
    for (int o = 1; o < 64; o <<= 1) v += sx(v, o, lane);
    return v;
}
__device__ __forceinline__ void transpose_item(const float* W, const float* gain, int K, int N, bf16_t* WT, int mode, LAS float* scr, int item, int lane) {
    const int nblk = N / 32, kb = item / nblk, nb = item % nblk, k0 = 64 * kb, n0 = 32 * nb;
#pragma unroll 8
    for (int i = 0; i < 32; ++i) { const int kk = 2 * i + (lane >> 5); const float g = gain ? gain[k0 + kk] : 1.0f; scr[kk * 33 + (lane & 31)] = W[(size_t)(k0 + kk) * N + n0 + (lane & 31)] * g; }
    asm volatile("s_waitcnt lgkmcnt(0)" ::: "memory");
    const int c = lane & 7;
    const int ob = mode == 0 ? n0 : 256 * (n0 >> 7) + 128 * (mode - 1) + (n0 & 127);
#pragma unroll
    for (int j = 0; j < 4; ++j) { const int n = (lane >> 3) + 8 * j; const LAS float* s = scr + (8 * c) * 33 + n;
        u32x4 o; o.x = cvtpk(s[0 * 33], s[1 * 33]); o.y = cvtpk(s[2 * 33], s[3 * 33]); o.z = cvtpk(s[4 * 33], s[5 * 33]); o.w = cvtpk(s[6 * 33], s[7 * 33]);
        *(u32x4*)(WT + (size_t)(ob + n) * K + k0 + 8 * c) = o; }
    asm volatile("s_waitcnt lgkmcnt(0)" ::: "memory");
}

__global__ void __launch_bounds__(512, 2) mk_fwd(Args a) {
    extern __shared__ __attribute__((aligned(16))) unsigned char lds_raw[];
    LAS unsigned char* lds = (LAS unsigned char*)lds_raw;
    cg::grid_group grid = cg::this_grid();
    { volatile LAS unsigned* st_ = (volatile LAS unsigned*)(lds + LDS_BYTES - 64); if (threadIdx.x < 2) st_[threadIdx.x] = 0u; }
    __syncthreads();
    const XcdBarrier bar = xcd_barrier_post((unsigned*)(a.ws + WS_BAR), (volatile LAS unsigned*)(lds + LDS_BYTES - 64));
    if (a.ph_lo < 0) grid.sync();
    const int wave = __builtin_amdgcn_readfirstlane((int)threadIdx.x >> 6);
    const int G = gridDim.x, gw = blockIdx.x * 8 + wave, NGW = G * 8;
    const bool grp = (G == M / 256) && (G % 8 == 0) && MK_DUP_MASK == 0;
    unsigned grp_epoch = 0u; unsigned* const grp_cnt = (unsigned*)(a.ws + WS_BAR) + 3520 + 64 * ((int)blockIdx.x & 7);
    unsigned char* ws = a.ws;
    float* ss = (float*)(ws + WS_SS); float* lse = (float*)(ws + WS_LSE);
    bf16_t* xb = (bf16_t*)(ws + WS_XB); bf16_t* att = (bf16_t*)(ws + WS_ATT); bf16_t* obr = (bf16_t*)(ws + WS_OBR);
    bf16_t* qkv = (bf16_t*)(ws + WS_QKV); bf16_t* hb = (bf16_t*)(ws + WS_H);

#ifdef MK_PROBE_SYNCS
    for (int i_ = 0; i_ < MK_PROBE_SYNCS; ++i_) xcd_barrier(bar);
#endif
    for (int ph = a.ph_lo; ph < a.ph_hi; ++ph)
    for (int rep = 0; rep <= ((MK_DUP_MASK >> ph) & 1); ++rep) {
        if (ph == 0) {
            int tq_ = threadIdx.x; asm volatile("" : "+v"(tq_)); const int lane = tq_ & 63;
            LAS float* scr = (LAS float*)(lds + wave * 16384);
            constexpr int I_IN = 16 * 96, I_O = 16 * 32, I_G = 16 * 88, I_D = 44 * 32, I_L = I_IN + I_O + 2 * I_G + I_D;
            for (int it = gw; it < 2 * I_L; it += NGW) {
                const int l = it / I_L; int r = it % I_L; unsigned char* wl = ws + WS_W + (size_t)l * WS_WL;
                const float* an = a.in[l ? I_A1N : I_A0N]; const float* fn = a.in[l ? I_F1N : I_F0N];
                if (r < I_IN) { transpose_item(a.in[l ? I_A1QKV : I_A0IN], an, D, NQKV, (bf16_t*)(wl + WO_IN), 0, scr, r, lane); continue; } r -= I_IN;
                if (r < I_O) { transpose_item(a.in[l ? I_A1OUT : I_A0OUT], nullptr, D, D, (bf16_t*)(wl + WO_O), 0, scr, r, lane); continue; } r -= I_O;
                if (r < I_G) { transpose_item(a.in[l ? I_F1G : I_F0G], fn, D, FF, (bf16_t*)(wl + WO_GU), 1, scr, r, lane); continue; } r -= I_G;
                if (r < I_G) { transpose_item(a.in[l ? I_F1U : I_F0U], fn, D, FF, (bf16_t*)(wl + WO_GU), 2, scr, r, lane); continue; } r -= I_G;
                transpose_item(a.in[l ? I_F1D : I_F0D], nullptr, FF, D, (bf16_t*)(wl + WO_D), 0, scr, r, lane);
            }
            const float* x = a.in[I_X];
            for (int m = gw; m < M; m += 2 * NGW) {
                const f32x4* xr0 = (const f32x4*)(x + (size_t)m * D) + lane; const f32x4* xr1 = (const f32x4*)(x + (size_t)(m + NGW) * D) + lane; f32x4 v0[4], v1[4];
#pragma unroll
                for (int j = 0; j < 4; ++j) { v0[j] = xr0[64 * j]; v1[j] = xr1[64 * j]; }
                float s0 = 0.f, s1 = 0.f;
#pragma unroll
                for (int j = 0; j < 4; ++j) { s0 += (v0[j][0] * v0[j][0] + v0[j][1] * v0[j][1]) + (v0[j][2] * v0[j][2] + v0[j][3] * v0[j][3]);
                                              s1 += (v1[j][0] * v1[j][0] + v1[j][1] * v1[j][1]) + (v1[j][2] * v1[j][2] + v1[j][3] * v1[j][3]); }
                s0 = wave_sum(s0, lane); s1 = wave_sum(s1, lane);
                u32x2* o0 = (u32x2*)(xb + (size_t)m * D) + lane; u32x2* o1 = (u32x2*)(xb + (size_t)(m + NGW) * D) + lane;
#pragma unroll
                for (int j = 0; j < 4; ++j) { u32x2 w; w.x = cvtpk(v0[j][0], v0[j][1]); w.y = cvtpk(v0[j][2], v0[j][3]); o0[64 * j] = w;
                                              u32x2 z; z.x = cvtpk(v1[j][0], v1[j][1]); z.y = cvtpk(v1[j][2], v1[j][3]); o1[64 * j] = z; }
                if (lane < 16) { ss[(size_t)m * 16 + lane] = lane == 0 ? s0 : 0.f; ss[(size_t)(m + NGW) * 16 + lane] = lane == 0 ? s1 : 0.f; }
            }
        } else if (ph == 13) {
            int tq_ = threadIdx.x; asm volatile("" : "+v"(tq_)); const int lane = tq_ & 63;
            const float* g = a.in[I_FN];
            f32x4 gg[4];
#pragma unroll
            for (int j = 0; j < 4; ++j) gg[j] = ((const f32x4*)g)[lane + 64 * j];
            const int pm_ = ((int)blockIdx.x & 7) * 32 + ((int)blockIdx.x >> 3);
            const int m_lo = grp ? pm_ * 256 + wave : gw, m_hi = grp ? pm_ * 256 + 256 : M, m_st = grp ? 8 : NGW;
            for (int m = m_lo; m < m_hi; m += 2 * m_st) {
                f32x4* xr0 = (f32x4*)(a.out + (size_t)m * D) + lane; f32x4* xr1 = (f32x4*)(a.out + (size_t)(m + m_st) * D) + lane; f32x4 v0[4], v1[4];
#pragma unroll
                for (int j = 0; j < 4; ++j) { v0[j] = xr0[64 * j]; v1[j] = xr1[64 * j]; }
                float s0 = 0.f, s1 = 0.f;
#pragma unroll
                for (int j = 0; j < 4; ++j) { s0 += (v0[j][0] * v0[j][0] + v0[j][1] * v0[j][1]) + (v0[j][2] * v0[j][2] + v0[j][3] * v0[j][3]);
                                              s1 += (v1[j][0] * v1[j][0] + v1[j][1] * v1[j][1]) + (v1[j][2] * v1[j][2] + v1[j][3] * v1[j][3]); }
                s0 = wave_sum(s0, lane); s1 = wave_sum(s1, lane);
                const float rs0 = 1.0f / sqrtf(s0 * (1.0f / D) + RMS_EPS), rs1 = 1.0f / sqrtf(s1 * (1.0f / D) + RMS_EPS);
#pragma unroll
                for (int j = 0; j < 4; ++j) { xr0[64 * j] = v0[j] * rs0 * gg[j]; xr1[64 * j] = v1[j] * rs1 * gg[j]; }
            }
        } else {
            const int l = (ph - 1) / 6, s = (ph - 1) % 6;
            unsigned char* wl = ws + WS_W + (size_t)l * WS_WL;
            if (s == 0) {
                pg8::Gemm g{xb, (const bf16_t*)(wl + WO_IN), M, NQKV, D}; pg8::StaticOrder S; S.init(M, NQKV, G, (int)blockIdx.x);
                pg8::EpiScaleBf16 E{qkv, NQKV, ss, l == 0 ? 0xC3u : 0xFu, l == 1 ? (float*)(ws + WS_KN) : nullptr};
#ifndef SKIP_G1
                pg8::gemm_phase<pg8::EpiScaleBf16, pg8::StaticOrder, true, true>(lds, g, S, E);
#endif
            } else if (s == 1) {
                at::Ptrs X{qkv, att, obr, lse, a.in[I_RPB], a.in[I_SUBLN], 0.f, (const float*)(ws + WS_KN)};
                if (l == 0) {
                    if (grp) {
                        const int x_ = (int)blockIdx.x & 7;
                        unsigned* qctr = (unsigned*)(a.ws + WS_BAR) + 4608 + 64 * x_;
                        LAS unsigned* qs = (LAS unsigned*)(lds + LDS_BYTES - 32);
                        if (threadIdx.x == 0) { const unsigned i0_ = xb_add(qctr, 1u), i1_ = xb_add(qctr, 1u); qs[0] = i0_; qs[1] = i1_; }
                        __syncthreads();
                        int sa = 0, sb = 1, sc = 2; bool have = false;
                        bf16x8 pq0 = {}, pq1 = {}, pq2 = {}, pq3 = {}, pk_ = {}, pv_ = {};
                        for (;;) {
                            const unsigned i = (unsigned)__builtin_amdgcn_readfirstlane((int)qs[sa]), in = (unsigned)__builtin_amdgcn_readfirstlane((int)qs[sb]);
                            if (i >= 1024u) break;
                            unsigned nx2 = 0u; if (threadIdx.x == 0) nx2 = xb_add(qctr, 1u);
                            if (i < 256u) { at::PolNat P, Pn; P.init(x_ * 256 + (int)i); const bool hasn = in < 256u; if (hasn) Pn.init(x_ * 256 + (int)in); else Pn = P;
                                at::attn_unit(P, lds, X, pq0, pq1, pq2, pq3, pk_, pv_, have, Pn, hasn); have = hasn; }
                            else { const int i2 = (int)i - 256, n2 = (int)in - 256;
                                at::PolDil P, Pn; P.init((i2 >> 8) * 2048 + x_ * 256 + (i2 & 255));
                                const bool hasn = in < 1024u && in >= 256u; if (hasn) Pn.init((n2 >> 8) * 2048 + x_ * 256 + (n2 & 255)); else Pn = P;
                                at::attn_unit(P, lds, X, pq0, pq1, pq2, pq3, pk_, pv_, have, Pn, hasn); have = hasn; }
                            if (threadIdx.x == 0) qs[sc] = nx2;
                            __syncthreads(); { const int t_ = sa; sa = sb; sb = sc; sc = t_; }
                        }
                    } else {
                    const int vc0 = ((int)blockIdx.x & 7) * (G >> 3) + ((int)blockIdx.x >> 3);
#ifndef SKIP_NAT
                    for (int u = vc0; u < 2048; u += G) { at::PolNat P; P.init(u); at::attn_unit(P, lds, X); }
#endif
#ifndef SKIP_DIL
                    { bf16x8 pq0 = {}, pq1 = {}, pq2 = {}, pq3 = {}, pk_ = {}, pv_ = {}; bool have = false;
                      for (int u = 2048 + vc0; u < 8192; u += G) { at::PolDil P, Pn; P.init(u - 2048); const bool hasn = u + G < 8192; if (hasn) Pn.init(u + G - 2048); else Pn = P;
                          at::attn_unit(P, lds, X, pq0, pq1, pq2, pq3, pk_, pv_, have, Pn, hasn); have = hasn; } }
#endif
                    }
                }
            } else if (s == 2) {
                if (l == 0) {
                    int tq_ = threadIdx.x; asm volatile("" : "+v"(tq_)); const int lane = tq_ & 63;
                    const int hd = lane >> 3;
                    for (int m0 = gw; m0 < M; m0 += 2 * NGW) {
                        float L[2][3]; bf16x8 ov[2][3];
#pragma unroll
                        for (int r = 0; r < 2; ++r) { const size_t m = (size_t)m0 + (size_t)r * NGW;
#pragma unroll
                            for (int i = 0; i < 3; ++i) { L[r][i] = lse[(size_t)i * M * 8 + m * 8 + hd]; ov[r][i] = *(const bf16x8*)(obr + (size_t)i * M * 512 + m * 512 + lane * 8); } }
#pragma unroll
                        for (int r = 0; r < 2; ++r) { const size_t m = (size_t)m0 + (size_t)r * NGW;
                            const float mx = fmaxf(L[r][0], fmaxf(L[r][1], L[r][2]));
                            float w0 = __builtin_amdgcn_exp2f(L[r][0] - mx), w1 = __builtin_amdgcn_exp2f(L[r][1] - mx), w2 = __builtin_amdgcn_exp2f(L[r][2] - mx);
                            const float inv = 1.0f / (w0 + w1 + w2); w0 *= inv; w1 *= inv; w2 *= inv;
                            float y[8];
#pragma unroll
                            for (int e = 0; e < 8; ++e) y[e] = w0 * bf2f((unsigned short)ov[r][0][e]) + w1 * bf2f((unsigned short)ov[r][1][e]) + w2 * bf2f((unsigned short)ov[r][2][e]);
                            u32x4 w; w.x = cvtpk(y[0], y[1]); w.y = cvtpk(y[2], y[3]); w.z = cvtpk(y[4], y[5]); w.w = cvtpk(y[6], y[7]);
                            *(u32x4*)(att + m * D + lane * 8) = w; }
                    }
                } else {
                    float d1 = 0.f, d2 = 0.f;
                    for (int i = 0; i < 64; ++i) { d1 += a.in[I_LQ1][i] * a.in[I_LK1][i]; d2 += a.in[I_LQ2][i] * a.in[I_LK2][i]; }
                    at::Ptrs X{qkv, att, obr, lse, a.in[I_RPB], a.in[I_SUBLN], 0.f, (const float*)(ws + WS_KN)};
                    X.lam = __int_as_float(__builtin_amdgcn_readfirstlane(__float_as_int(__expf(d1) - __expf(d2) + LAM_INIT)));
#ifndef SKIP_DIFF
                    if (grp) {
                        unsigned* qctr = (unsigned*)(a.ws + WS_BAR) + 4096 + 64 * ((int)blockIdx.x & 7);
                        LAS unsigned* qs = (LAS unsigned*)(lds + LDS_BYTES - 32);
                        if (threadIdx.x == 0) qs[0] = xb_add(qctr, 1u);
                        __syncthreads();
                        int cur = 0;
                        for (;;) {
                            const unsigned i = (unsigned)__builtin_amdgcn_readfirstlane((int)qs[cur]);
                            if (i >= 512u) break;
                            unsigned nxt = 0u; if (threadIdx.x == 0) nxt = xb_add(qctr, 1u);
                            at::PolDiff P; { const int hq = 7 - (int)(i >> 6), bs = (int)(i >> 5) & 1, x_ = (int)blockIdx.x & 7;
                                P.h = hq; P.b = x_ + 8 * bs; P.qb = (int)(i & 31u); P.tlo = 0; P.thi = T / 64; P.nsl = -at::slope_of(hq) * LOG2E; }
                            at::diff_unit(P, lds, X);
                            if (threadIdx.x == 0) qs[cur ^ 1] = nxt;
                            __syncthreads(); cur ^= 1;
                        }
                    } else
                    for (int u = blockIdx.x; u < 4096; u += G) { at::PolDiff P; P.init(u); at::diff_unit(P, lds, X); }
#endif
                }
            } else if (s == 3 || s == 5) {
                const bool dn = s == 5;
                pg8::Gemm g{dn ? hb : att, (const bf16_t*)(wl + (dn ? WO_D : WO_O)), M, D, dn ? FF : D}; pg8::StaticOrder S; S.init(M, D, G, (int)blockIdx.x);
                pg8::EpiResid E{(l == 0 && !dn) ? a.in[I_X] : nullptr, (l == 1 && dn) ? a.out : nullptr, xb, (bf16_t*)(ws + WS_OBR)  , ss};
#ifndef SKIP_G2
                pg8::gemm_phase<pg8::EpiResid, pg8::StaticOrder, true, true>(lds, g, S, E);
#endif
            } else {
                pg8::Gemm g{xb, (const bf16_t*)(wl + WO_GU), M, NGU, D}; pg8::StaticOrder S; S.init(M, NGU, G, (int)blockIdx.x);
                pg8::EpiSwiGLU E{hb, ss};
#ifndef SKIP_G3
                pg8::gemm_phase<pg8::EpiSwiGLU, pg8::StaticOrder, true, true>(lds, g, S, E);
#endif
            }
        }
        if ((ph + 1 < a.ph_hi || rep < ((MK_DUP_MASK >> ph) & 1)) && ph != 8) {
            if (grp && ((ph >= 4 && ph <= 5) || (ph >= 10 && ph <= 12))) grp_barrier(grp_cnt, grp_epoch, (unsigned)(G >> 3));
            else xcd_barrier(bar); }
    }
}

extern "C" void kernel_launch(void* const* d_in, const int* in_sizes, int n_in, void* d_out, int out_size, void* d_ws, size_t ws_size, hipStream_t stream) {
    static int grid = 0;
    if (grid == 0) {
        if (n_in != 22 || in_sizes[0] != M * D || out_size != M * D || ws_size < WS_END) { fprintf(stderr, "kernel_launch: unexpected shapes (n_in %d, in0 %d, out %d, ws %zu)\n", n_in, n_in > 0 ? in_sizes[0] : -1, out_size, ws_size); grid = -1; return; }
        int dev = 0, cus = 0, per_cu = 0;
        hipGetDevice(&dev); hipDeviceGetAttribute(&cus, hipDeviceAttributeMultiprocessorCount, dev);
        if (hipFuncSetAttribute((const void*)mk_fwd, hipFuncAttributeMaxDynamicSharedMemorySize, LDS_BYTES) != hipSuccess) { fprintf(stderr, "kernel_launch: hipFuncSetAttribute failed\n"); grid = -1; return; }
        hipOccupancyMaxActiveBlocksPerMultiprocessor(&per_cu, (const void*)mk_fwd, 512, LDS_BYTES);
        (void)hipGetLastError();
        if (per_cu < 1) { fprintf(stderr, "kernel_launch: occupancy query says %d blocks/CU\n", per_cu); per_cu = 1; }
        grid = cus * 1;
    }
    if (grid < 0) return;
    Args a{};
    for (int i = 0; i < 22; ++i) a.in[i] = (const float*)d_in[i];
    a.out = (float*)d_out; a.ws = (unsigned char*)d_ws;
#if MK_ONE_LAUNCH
    if (hipMemsetAsync((char*)d_ws + WS_BAR, 0, WS_BAR_BYTES, stream) != hipSuccess) { fprintf(stderr, "kernel_launch: memset of the barrier words failed\n"); return; }
    a.ph_lo = 0; a.ph_hi = NPH;
    void* args[] = {&a};
    hipError_t e = hipLaunchCooperativeKernel((const void*)mk_fwd, dim3(grid), dim3(512), args, LDS_BYTES, stream);
    if (e != hipSuccess) fprintf(stderr, "cooperative launch failed: %s (grid %d)\n", hipGetErrorString(e), grid);
#else
    for (int ph = 0; ph < NPH; ++ph) {
        a.ph_lo = ph; a.ph_hi = ph + 1;
        hipLaunchKernelGGL(mk_fwd, dim3(grid), dim3(512), LDS_BYTES, stream, a);
    }
#endif
}
```

```cpp
#include <hip/hip_runtime.h>
#include <hip/hip_cooperative_groups.h>
#include <cstdio>
#include <cstdint>
namespace cg = cooperative_groups;
#ifndef MK_DUP_MASK
#define MK_DUP_MASK 0x0
#endif
#ifndef MK_ONE_LAUNCH
#define MK_ONE_LAUNCH 1
#endif
namespace pg8 {
#define PG8_LAS __attribute__((address_space(3)))
typedef unsigned short bf16_t;
typedef short bf16x8 __attribute__((ext_vector_type(8)));
typedef float f32x4 __attribute__((ext_vector_type(4)));
typedef unsigned u32x4 __attribute__((ext_vector_type(4)));
constexpr int BM = 256, BK = 64, HALF = 128, HTB = HALF * BK * 2  , STAGE_BYTES = 8 * HTB, NXCD = 8, WGM = 8;

__host__ __device__ __forceinline__ int lds_byte(int r, int c) { const int st = (r >> 4) * 2 + (c >> 5), rr = r & 15, cc = c & 31, ob = rr * 64 + cc * 2; return st * 1024 + (ob ^ (((ob >> 9) & 1) << 5)); }
__host__ __device__ __forceinline__ void stage_rc(int b, int& R, int& C) { const int st = b / 1024, sb = b % 1024, swz = sb ^ (((sb >> 9) & 1) << 5); R = (st >> 1) * 16 + swz / 64; C = (st & 1) * 32 + (swz % 64) / 2; }
__host__ __device__ __forceinline__ int perm32(int rho) { const int n = rho >> 4, i = rho & 15; return 8 * (i >> 2) + 4 * n + (i & 3); }

struct Unit { int pm, pn; };
struct Gemm { const bf16_t* A; const bf16_t* Bt; int M, N, K; };

struct StaticOrder {
    int nM, nN, nwg, G, c;
    __host__ __device__ void init(int M, int N, int G_, int c_) { nM = M / BM; nN = N / BM; nwg = nM * nN; G = G_; c = c_; }
    __host__ __device__ bool next(int i, Unit& u) const {
        const long L = (long)i * G + c; if (L >= nwg) return false;
        int wgid = (int)L; { const int q = nwg / NXCD, r = nwg % NXCD, xcd = wgid % NXCD, off = wgid / NXCD; wgid = (xcd < r ? xcd * (q + 1) : r * (q + 1) + (xcd - r) * q) + off; }
        const int nig = WGM * nN, gid = wgid / nig, fm = gid * WGM, gsz = (nM - fm) < WGM ? (nM - fm) : WGM;
        u.pm = fm + ((wgid % nig) % gsz); u.pn = (wgid % nig) / gsz; return true;
    }
    __device__ __forceinline__ void a_ready(const Unit&) const {}
    __device__ __forceinline__ void done(const Unit&) const {}
};

__device__ __forceinline__ unsigned cvt_pk_bf16(float lo, float hi) { unsigned r; asm volatile("v_cvt_pk_bf16_f32 %0, %1, %2" : "=v"(r) : "v"(lo), "v"(hi)); return r; }
typedef float f32x2 __attribute__((ext_vector_type(2)));
template <class Epi, class Sched, bool ALIGN_EPI = false, bool SP2 = false>
__device__ __forceinline__ void gemm_phase(PG8_LAS unsigned char* lds, const Gemm g, const Sched& S, const Epi& E) {
    int tid_ = threadIdx.x; asm volatile("" : "+v"(tid_));
    const int tid = tid_, wid = __builtin_amdgcn_readfirstlane(tid >> 6), lane = tid & 63, wr = wid >> 2, wc = wid & 3, fr = lane & 15, fq = lane >> 4;
    const int K = g.K, nt = K / BK;
    unsigned voffA[2], voffB[2];
#pragma unroll
    for (int i = 0; i < 2; ++i) { int R, C; stage_rc(tid * 16 + i * 8192, R, C); const int Rb = Epi::PERM ? ((R & ~31) + perm32(R & 31)) : R;
        voffA[i] = (unsigned)(R * K + C) * 2u; voffB[i] = (unsigned)(Rb * K + C) * 2u; }
    const size_t kstep = (size_t)(BK * 2);
    const size_t hstep = (size_t)HALF * K * 2;
    const size_t tstep = 2 * hstep;
    const unsigned ldsw = (unsigned)wid * 1024u;
    const int aoff = lds_byte(wr * 64 + fr, fq * 8), boff = lds_byte(wc * 32 + fr, fq * 8);
#define PG8_SA(b, h) (((b) * 2 + (h)) * HTB)
#define PG8_SB(b, h) ((4 + (b) * 2 + (h)) * HTB)
#define PG8_STAGE(bufoff, gbase, voff) do { _Pragma("unroll") for (int _i = 0; _i < 2; ++_i) \
        __builtin_amdgcn_global_load_lds((const unsigned*)((const char*)(gbase) + (voff)[_i]), (PG8_LAS unsigned*)(lds + (bufoff) + ldsw + _i * 8192), 16, 0, 0); } while (0)
#define PG8_LDA(dst, b, h) do { _Pragma("unroll") for (int m = 0; m < 4; ++m) _Pragma("unroll") for (int k = 0; k < 2; ++k) dst[m][k] = *(const PG8_LAS bf16x8*)(lds + PG8_SA(b, h) + aoff + m * 2048 + k * 1024); } while (0)
#define PG8_LDB(dst, b, h) do { _Pragma("unroll") for (int n = 0; n < 2; ++n) _Pragma("unroll") for (int k = 0; k < 2; ++k) dst[n][k] = *(const PG8_LAS bf16x8*)(lds + PG8_SB(b, h) + boff + n * 2048 + k * 1024); } while (0)
#define PG8_MMA(ai, bj, At, Bt) do { __builtin_amdgcn_s_setprio(1); _Pragma("unroll") for (int m = 0; m < 4; ++m) _Pragma("unroll") for (int n = 0; n < 2; ++n) _Pragma("unroll") for (int k = 0; k < 2; ++k) \
        acc[ai][bj][m][n] = __builtin_amdgcn_mfma_f32_16x16x32_bf16(Bt[n][k], At[m][k], acc[ai][bj][m][n], 0, 0, 0); __builtin_amdgcn_s_setprio(0); } while (0)
#define PG8_WAIT_V(n) asm volatile("s_waitcnt vmcnt(" #n ")" ::: "memory")
#define PG8_WAIT_L(n) asm volatile("s_waitcnt lgkmcnt(" #n ")" ::: "memory")
#define PG8_BAR __builtin_amdgcn_s_barrier()
#define PG8_SCHED __builtin_amdgcn_sched_barrier(0)
    Unit cur, nxt; int ui = 0;
    if (!S.next(0, cur)) return;
    f32x4 acc[2][2][4][2];
#pragma unroll
    for (int a = 0; a < 2; ++a)
#pragma unroll
        for (int b = 0; b < 2; ++b)
#pragma unroll
            for (int m = 0; m < 4; ++m)
#pragma unroll
                for (int n = 0; n < 2; ++n) acc[a][b][m][n] = (f32x4){0.f, 0.f, 0.f, 0.f};
    bf16x8 At[4][2], B0[2][2], B1[2][2];
    const char* cA = (const char*)g.A + (size_t)cur.pm * tstep; const char* cB = (const char*)g.Bt + (size_t)cur.pn * tstep;
    S.a_ready(cur);
    if constexpr (SP2) {
        PG8_STAGE(PG8_SB(0, 0), cB, voffB); PG8_STAGE(PG8_SB(0, 1), cB + hstep, voffB); PG8_STAGE(PG8_SA(0, 0), cA, voffA); PG8_STAGE(PG8_SA(0, 1), cA + hstep, voffA);
        if (wr == 1) PG8_BAR;
        PG8_WAIT_V(2); PG8_BAR;
        PG8_STAGE(PG8_SB(1, 0), cB + kstep, voffB); PG8_STAGE(PG8_SA(1, 0), cA + kstep, voffA); PG8_STAGE(PG8_SB(1, 1), cB + hstep + kstep, voffB);
        PG8_WAIT_V(6); PG8_BAR;
    } else {
        PG8_STAGE(PG8_SB(0, 0), cB, voffB); PG8_STAGE(PG8_SA(0, 0), cA, voffA); PG8_STAGE(PG8_SB(0, 1), cB + hstep, voffB); PG8_STAGE(PG8_SA(0, 1), cA + hstep, voffA);
        if (wr == 1) PG8_BAR;
        PG8_WAIT_V(4); PG8_BAR;
        PG8_STAGE(PG8_SB(1, 0), cB + kstep, voffB); PG8_STAGE(PG8_SA(1, 0), cA + kstep, voffA); PG8_STAGE(PG8_SB(1, 1), cB + hstep + kstep, voffB);
        PG8_WAIT_V(6); PG8_BAR;
    }
    for (;;) {
        const bool has_next = S.next(ui + 1, nxt);
        const char* nA = has_next ? (const char*)g.A + (size_t)nxt.pm * tstep : cA; const char* nB = has_next ? (const char*)g.Bt + (size_t)nxt.pn * tstep : cB;
        for (int t = 0; t < nt; t += 2) {
            const bool last = (t == nt - 2);
            const char* a1 = cA + (size_t)(t + 1) * kstep;
            const char* a2 = last ? nA : cA + (size_t)(t + 2) * kstep; const char* b2 = last ? nB : cB + (size_t)(t + 2) * kstep;
            const char* a3 = a2 + kstep; const char* b3 = b2 + kstep;
            if (last && has_next) S.a_ready(nxt);
            if constexpr (SP2) {
            PG8_LDB(B0, 0, 0); PG8_LDB(B1, 0, 1); PG8_SCHED; PG8_LDA(At, 0, 0); PG8_STAGE(PG8_SA(1, 1), a1 + hstep, voffA);
            PG8_WAIT_V(8); PG8_WAIT_L(0); PG8_BAR; PG8_MMA(0, 0, At, B0); PG8_MMA(0, 1, At, B1); PG8_BAR; PG8_SCHED;
            PG8_LDA(At, 0, 1); PG8_STAGE(PG8_SB(0, 0), b2, voffB); PG8_STAGE(PG8_SB(0, 1), b2 + hstep, voffB); PG8_STAGE(PG8_SA(0, 0), a2, voffA);
            PG8_WAIT_V(8); PG8_WAIT_L(0); PG8_BAR; PG8_MMA(1, 0, At, B0); PG8_MMA(1, 1, At, B1); PG8_BAR; PG8_SCHED;
            PG8_LDB(B0, 1, 0); PG8_LDB(B1, 1, 1); PG8_SCHED; PG8_LDA(At, 1, 0); PG8_STAGE(PG8_SA(0, 1), a2 + hstep, voffA);
            PG8_WAIT_V(8); PG8_WAIT_L(0); PG8_BAR; PG8_MMA(0, 0, At, B0); PG8_MMA(0, 1, At, B1); PG8_BAR; PG8_SCHED;
            PG8_LDA(At, 1, 1); PG8_STAGE(PG8_SB(1, 0), b3, voffB); PG8_STAGE(PG8_SB(1, 1), b3 + hstep, voffB); PG8_STAGE(PG8_SA(1, 0), a3, voffA);
            PG8_WAIT_V(8); PG8_WAIT_L(0); PG8_BAR; PG8_MMA(1, 0, At, B0); PG8_MMA(1, 1, At, B1); PG8_BAR; PG8_SCHED;
            } else {
            PG8_LDB(B0, 0, 0); PG8_SCHED; PG8_LDA(At, 0, 0); PG8_STAGE(PG8_SA(1, 1), a1 + hstep, voffA);
            PG8_WAIT_L(8); PG8_BAR; PG8_WAIT_L(0); PG8_MMA(0, 0, At, B0); PG8_BAR; PG8_SCHED;
            PG8_LDB(B1, 0, 1); PG8_STAGE(PG8_SB(0, 0), b2, voffB);
            PG8_BAR; PG8_WAIT_L(0); PG8_MMA(0, 1, At, B1); PG8_BAR;
            PG8_LDA(At, 0, 1); PG8_STAGE(PG8_SA(0, 0), a2, voffA);
            PG8_BAR; PG8_WAIT_L(0); PG8_MMA(1, 0, At, B0); PG8_BAR; PG8_SCHED;
            PG8_STAGE(PG8_SB(0, 1), b2 + hstep, voffB);
            PG8_WAIT_V(6); PG8_BAR; PG8_MMA(1, 1, At, B1); PG8_BAR;
            PG8_LDB(B0, 1, 0); PG8_SCHED; PG8_LDA(At, 1, 0); PG8_STAGE(PG8_SA(0, 1), a2 + hstep, voffA);
            PG8_WAIT_L(8); PG8_BAR; PG8_WAIT_L(0); PG8_MMA(0, 0, At, B0); PG8_BAR; PG8_SCHED;
            PG8_LDB(B1, 1, 1); PG8_STAGE(PG8_SB(1, 0), b3, voffB);
            PG8_BAR; PG8_WAIT_L(0); PG8_MMA(0, 1, At, B1); PG8_BAR;
            PG8_LDA(At, 1, 1); PG8_STAGE(PG8_SA(1, 0), a3, voffA);
            PG8_BAR; PG8_WAIT_L(0); PG8_MMA(1, 0, At, B0); PG8_BAR; PG8_SCHED;
            PG8_STAGE(PG8_SB(1, 1), b3 + hstep, voffB);
            PG8_WAIT_V(6); PG8_BAR; PG8_MMA(1, 1, At, B1); PG8_BAR;
            }
        }
        if constexpr (ALIGN_EPI) { if (wr == 0) PG8_BAR; }
        if constexpr (!Epi::AFTER_DRAIN) { E(acc, cur, wr, wc, fr, fq); S.done(cur); }
        if (!has_next) break;
#pragma unroll
        for (int a = 0; a < 2; ++a)
#pragma unroll
            for (int b = 0; b < 2; ++b)
#pragma unroll
                for (int m = 0; m < 4; ++m)
#pragma unroll
                    for (int n = 0; n < 2; ++n) acc[a][b][m][n] = (f32x4){0.f, 0.f, 0.f, 0.f};
        cur = nxt; cA = nA; cB = nB; ++ui;
        if constexpr (ALIGN_EPI) { if (wr == 1) PG8_BAR; }
    }
    PG8_WAIT_V(0);
    if constexpr (!ALIGN_EPI) { if (wr == 0) PG8_BAR; }
    PG8_BAR;
    if constexpr (Epi::AFTER_DRAIN) { E.fused(acc, cur, wr, wc, fr, fq, lds, wid, lane); S.done(cur); }
#undef PG8_SA
#undef PG8_SB
#undef PG8_STAGE
#undef PG8_LDA
#undef PG8_LDB
#undef PG8_MMA
#undef PG8_WAIT_V
#undef PG8_WAIT_L
#undef PG8_BAR
#undef PG8_SCHED
}
}

constexpr int BATCH = 16, T = 4096, D = 1024, M = BATCH * T, NQKV = 3072, FF = 2816, NGU = 2 * FF;
constexpr float RMS_EPS = 1e-6f, SUBLN_EPS = 1e-5f;
constexpr float LOG2E = 1.4426950408889634f;
constexpr float QSCALE = 0.125f * LOG2E;
constexpr float LAM_INIT = 0.35550906f;

#define LAS __attribute__((address_space(3)))
typedef unsigned short bf16_t;
typedef short bf16x8 __attribute__((ext_vector_type(8)));
typedef short s16x4 __attribute__((ext_vector_type(4)));
typedef float f32x4 __attribute__((ext_vector_type(4)));
typedef float f32x16 __attribute__((ext_vector_type(16)));
typedef unsigned u32x4 __attribute__((ext_vector_type(4)));
typedef unsigned u32x2 __attribute__((ext_vector_type(2)));

__device__ __forceinline__ unsigned cvtpk(float lo, float hi) { unsigned r; asm volatile("v_cvt_pk_bf16_f32 %0, %1, %2" : "=v"(r) : "v"(lo), "v"(hi)); return r; }
__device__ __forceinline__ float sx(float v, int mask, int lane) { return __int_as_float(__builtin_amdgcn_ds_bpermute((lane ^ mask) << 2, __float_as_int(v))); }
__device__ __forceinline__ float bf2f(unsigned short u) { return __uint_as_float((unsigned)u << 16); }

namespace pg8 {
__device__ __forceinline__ float row_rs(const float* ss, int row, int fq, int fr) {
#ifdef TRIV_EPI
    return 1.0f;
#endif
    const f32x4 a = *(const f32x4*)(ss + (size_t)row * 16 + 4 * fq);
    float s = (a[0] + a[1]) + (a[2] + a[3]);
    const int ln = fq * 16 + fr; s += sx(s, 16, ln); s += sx(s, 32, ln);
    return 1.0f / sqrtf(s * (1.0f / D) + RMS_EPS);
}
struct EpiScaleBf16 {
    static constexpr bool PERM = true, AFTER_DRAIN = false;
    bf16_t* O; int ldc; const float* ss; unsigned qmask;
    float* kn2;
    __device__ __forceinline__ void operator()(const f32x4 (&acc)[2][2][4][2], const Unit& u, int wr, int wc, int fr, int fq) const {
        const int row0 = u.pm * BM + wr * 64 + fr, col0 = u.pn * BM + wc * 32 + 8 * fq;
        const float qs = ((qmask >> u.pn) & 1u) ? QSCALE : 1.0f;
        const bool kt = kn2 != nullptr && u.pn >= 4 && u.pn < 8;
        const int ln = fq * 16 + fr;
        float km[2][2] = {{0.f, 0.f}, {0.f, 0.f}};
#pragma unroll
        for (int ai = 0; ai < 2; ++ai)
#pragma unroll
            for (int m = 0; m < 4; ++m) { const int row = row0 + ai * HALF + m * 16; const float rs = row_rs(ss, row, fq, fr) * qs;
                bf16_t* rowp = O + (size_t)row * ldc + col0;
#pragma unroll
                for (int bj = 0; bj < 2; ++bj) { const f32x4 v0 = acc[ai][bj][m][0] * rs, v1 = acc[ai][bj][m][1] * rs;
                    u32x4 w; w.x = cvt_pk_bf16(v0[0], v0[1]); w.y = cvt_pk_bf16(v0[2], v0[3]); w.z = cvt_pk_bf16(v1[0], v1[1]); w.w = cvt_pk_bf16(v1[2], v1[3]);
                    *(u32x4*)(rowp + bj * HALF) = w;
                    if (kt) { float s8 = 0.f;
#pragma unroll
                        for (int e = 0; e < 4; ++e) { const unsigned ww = e == 0 ? w.x : (e == 1 ? w.y : (e == 2 ? w.z : w.w)); const float lo_ = __uint_as_float(ww << 16), hi_ = __uint_as_float(ww & 0xffff0000u);
                            s8 = fmaf(lo_, lo_, s8); s8 = fmaf(hi_, hi_, s8); }
                        s8 += sx(s8, 16, ln); s8 += sx(s8, 32, ln);
                        km[ai][bj] = fmaxf(km[ai][bj], s8); } }
                if (m & 1) asm volatile("" ::: "memory"); }
        if (kt) {
#pragma unroll
            for (int ai = 0; ai < 2; ++ai)
#pragma unroll
                for (int bj = 0; bj < 2; ++bj) { float v = km[ai][bj];
                    v = fmaxf(v, sx(v, 1, ln)); v = fmaxf(v, sx(v, 2, ln)); v = fmaxf(v, sx(v, 4, ln)); v = fmaxf(v, sx(v, 8, ln));
                    const int rt = u.pm * BM + ai * HALF + wr * 64, bb = rt >> 12, tile = (rt & 4095) >> 6, head = (u.pn - 4) * 2 + bj;
                    if (ln == 0) kn2[((((bb * 8 + head) * 2 + (wc >> 1)) * 64 + tile) << 1) + (wc & 1)] = v; }
        }
    }
};
struct EpiSwiGLU {
    static constexpr bool PERM = true, AFTER_DRAIN = false;
    bf16_t* H; const float* ss;
    __device__ __forceinline__ void operator()(const f32x4 (&acc)[2][2][4][2], const Unit& u, int wr, int wc, int fr, int fq) const {
        const int row0 = u.pm * BM + wr * 64 + fr, col0 = u.pn * HALF + wc * 32 + 8 * fq;
#pragma unroll
        for (int ai = 0; ai < 2; ++ai)
#pragma unroll
            for (int m = 0; m < 4; ++m) { const int row = row0 + ai * HALF + m * 16; const float rs = row_rs(ss, row, fq, fr);
                float o[8];
#pragma unroll
                for (int n = 0; n < 2; ++n)
#pragma unroll
                    for (int e = 0; e < 4; ++e) { const float g = acc[ai][0][m][n][e] * rs, up = acc[ai][1][m][n][e] * rs;
                        o[n * 4 + e] = g * __builtin_amdgcn_rcpf(1.0f + __builtin_amdgcn_exp2f(-g * LOG2E)) * up; }
                u32x4 w; w.x = cvt_pk_bf16(o[0], o[1]); w.y = cvt_pk_bf16(o[2], o[3]); w.z = cvt_pk_bf16(o[4], o[5]); w.w = cvt_pk_bf16(o[6], o[7]);
                *(u32x4*)(H + (size_t)row * FF + col0) = w;
                if (m & 1) asm volatile("" ::: "memory"); }
    }
};
struct EpiResid {
    static constexpr bool PERM = true, AFTER_DRAIN = false;
    const float* bf; float* of; bf16_t* hi; bf16_t* lo; float* ss;
    __device__ __forceinline__ void operator()(const f32x4 (&acc)[2][2][4][2], const Unit& u, int wr, int wc, int fr, int fq) const {
        const int row0 = u.pm * BM + wr * 64 + fr, col0 = u.pn * BM + wc * 32 + 8 * fq;
#pragma unroll
        for (int ai = 0; ai < 2; ++ai)
#pragma unroll
            for (int m = 0; m < 4; ++m) { const int row = row0 + ai * HALF + m * 16; const size_t off = (size_t)row * D + col0; float sq = 0.f;
#pragma unroll
                for (int bj = 0; bj < 2; ++bj) { const size_t o2 = off + bj * HALF; f32x4 v0, v1;
                    if (bf) { v0 = *(const f32x4*)(bf + o2); v1 = *(const f32x4*)(bf + o2 + 4); }
                    else { const u32x4 h = *(const u32x4*)(hi + o2), l = *(const u32x4*)(lo + o2);
                        v0[0] = __uint_as_float(h.x << 16) + __uint_as_float(l.x << 16); v0[1] = __uint_as_float(h.x & 0xffff0000u) + __uint_as_float(l.x & 0xffff0000u);
                        v0[2] = __uint_as_float(h.y << 16) + __uint_as_float(l.y << 16); v0[3] = __uint_as_float(h.y & 0xffff0000u) + __uint_as_float(l.y & 0xffff0000u);
                        v1[0] = __uint_as_float(h.z << 16) + __uint_as_float(l.z << 16); v1[1] = __uint_as_float(h.z & 0xffff0000u) + __uint_as_float(l.z & 0xffff0000u);
                        v1[2] = __uint_as_float(h.w << 16) + __uint_as_float(l.w << 16); v1[3] = __uint_as_float(h.w & 0xffff0000u) + __uint_as_float(l.w & 0xffff0000u); }
                    v0 = v0 + acc[ai][bj][m][0]; v1 = v1 + acc[ai][bj][m][1];
                    if (of) { *(f32x4*)(of + o2) = v0; *(f32x4*)(of + o2 + 4) = v1; }
                    else { u32x4 w; w.x = cvt_pk_bf16(v0[0], v0[1]); w.y = cvt_pk_bf16(v0[2], v0[3]); w.z = cvt_pk_bf16(v1[0], v1[1]); w.w = cvt_pk_bf16(v1[2], v1[3]);
                        u32x4 r; r.x = cvt_pk_bf16(v0[0] - __uint_as_float(w.x << 16), v0[1] - __uint_as_float(w.x & 0xffff0000u)); r.y = cvt_pk_bf16(v0[2] - __uint_as_float(w.y << 16), v0[3] - __uint_as_float(w.y & 0xffff0000u));
                        r.z = cvt_pk_bf16(v1[0] - __uint_as_float(w.z << 16), v1[1] - __uint_as_float(w.z & 0xffff0000u)); r.w = cvt_pk_bf16(v1[2] - __uint_as_float(w.w << 16), v1[3] - __uint_as_float(w.w & 0xffff0000u));
                        *(u32x4*)(hi + o2) = w; *(u32x4*)(lo + o2) = r; }
                    sq += ((v0[0] * v0[0] + v0[1] * v0[1]) + (v0[2] * v0[2] + v0[3] * v0[3])) + ((v1[0] * v1[0] + v1[1] * v1[1]) + (v1[2] * v1[2] + v1[3] * v1[3])); }
                { const int ln = fq * 16 + fr; sq += sx(sq, 16, ln); sq += sx(sq, 32, ln); }
                if (fq == 0) ss[(size_t)row * 16 + u.pn * 4 + wc] = sq;
                asm volatile("" ::: "memory"); }
    }
};
}

namespace at {
constexpr float THR = 8.0f;
__device__ __forceinline__ int crow(int r, int hi) { return (r & 3) + 8 * (r >> 2) + 4 * hi; }
template <int NB> __device__ __forceinline__ int v_st(int k, int c) { const int kk = (k & ~0xC) | ((k & 4) << 1) | ((k & 8) >> 1); return ((kk >> 3) * NB + (c >> 5)) * 512 + ((kk & 7) * 32 + (c & 31)) * 2; }
__device__ __forceinline__ int v_rd_base(int lane) { return ((lane & 3) << 3) | (((lane >> 2) & 3) << 6) | (((lane >> 4) & 1) << 5) | (((lane >> 5) & 1) << 8); }
template <int NB> constexpr int v_rd_off(int d0, int ks, int half) { return d0 * 512 + ks * (NB * 1024) + half * (NB * 512); }
template <int OFF> __device__ __forceinline__ s16x4 tr_read(int vb) { s16x4 r; asm volatile("ds_read_b64_tr_b16 %0, %1 offset:%2" : "=&v"(r) : "v"(vb), "i"(OFF) : "memory"); return r; }
template <int NB, int D0> __device__ __forceinline__ void pv_one(f32x16& od, int vb, bf16x8 pa0, bf16x8 pa1, bf16x8 pa2, bf16x8 pa3) {
    const s16x4 l0 = tr_read<v_rd_off<NB>(D0, 0, 0)>(vb), h0 = tr_read<v_rd_off<NB>(D0, 0, 1)>(vb), l1 = tr_read<v_rd_off<NB>(D0, 1, 0)>(vb), h1 = tr_read<v_rd_off<NB>(D0, 1, 1)>(vb);
    const s16x4 l2 = tr_read<v_rd_off<NB>(D0, 2, 0)>(vb), h2 = tr_read<v_rd_off<NB>(D0, 2, 1)>(vb), l3 = tr_read<v_rd_off<NB>(D0, 3, 0)>(vb), h3 = tr_read<v_rd_off<NB>(D0, 3, 1)>(vb);
    asm volatile("s_waitcnt lgkmcnt(0)" ::: "memory"); __builtin_amdgcn_sched_barrier(0);
#define AT_PK(L, H) (bf16x8){L[0], L[1], L[2], L[3], H[0], H[1], H[2], H[3]}
    od = __builtin_amdgcn_mfma_f32_32x32x16_bf16(pa0, AT_PK(l0, h0), od, 0, 0, 0);
    od = __builtin_amdgcn_mfma_f32_32x32x16_bf16(pa1, AT_PK(l1, h1), od, 0, 0, 0);
    od = __builtin_amdgcn_mfma_f32_32x32x16_bf16(pa2, AT_PK(l2, h2), od, 0, 0, 0);
    od = __builtin_amdgcn_mfma_f32_32x32x16_bf16(pa3, AT_PK(l3, h3), od, 0, 0, 0);
#undef AT_PK
}
__device__ __forceinline__ float slope_of(int h) { return __builtin_amdgcn_exp2f(-(float)(h + 1)); }

constexpr int L_SCR = 65536, L_TBL = 67584, L_X = 69632;

struct Ptrs { const bf16_t* qkv; bf16_t* att; bf16_t* obr; float* lse; const float* rpb; const float* subln; float lam; const float* kn; };

struct PolDil {
    static constexpr int W = 64, KIND = 0;
    int b, h, br, dil, res, qs0, tlo, thi; float nsl;
    __device__ __forceinline__ void init(int u) {
        br = u >> 11; const int v = u & 2047, sub = v & 15, bh = v >> 4; b = bh >> 3; h = bh & 7;
        dil = br == 0 ? 1 : (br == 1 ? 4 : 16); const int L = T / dil, nqb = L / 256;
        res = sub / nqb; qs0 = (sub % nqb) * 256;
        tlo = qs0 > 0 ? 0 : 1; thi = (qs0 + 256 < L) ? 6 : 5;
        nsl = -slope_of(h) * (float)dil * LOG2E;
    }
    __device__ __forceinline__ long qtok(int wid, int i) const { return (long)b * T + res + dil * (qs0 + 32 * wid + i); }
    __device__ __forceinline__ int qcol(int) const { return h * 64; }
    __device__ __forceinline__ int kcol0() const { return 512 + h * 64; }
    __device__ __forceinline__ int vcol0() const { return 1024 + h * 64; }
    __device__ __forceinline__ int kfrag(int) const { return 0; }
    __device__ __forceinline__ long ktok(int t, int row) const { return (long)b * T + res + dil * (qs0 - 64 + 64 * t + row); }
    __device__ __forceinline__ bool need(int t, int wid) const { return (64 * t - 64 <= 32 * wid + 95) && (64 * t - 1 >= 32 * wid - 64); }
    __device__ __forceinline__ void cinit(f32x16& p0, f32x16& p1, int t, int wid, int r32, int hi, const LAS float*, float m) const {
        const float base = (float)(32 * wid + r32 + 64 - 64 * t - 4 * hi);
#pragma unroll
        for (int r = 0; r < 16; ++r) { const float c = (float)((r & 3) + 8 * (r >> 2));
            const float a0 = fabsf(base - c), a1 = fabsf(base - (c + 32.f));
            p0[r] = a0 <= 64.f ? nsl * a0 - m : -INFINITY; p1[r] = a1 <= 64.f ? nsl * a1 - m : -INFINITY; }
    }
};
struct PolNat {
    static constexpr int W = 64, KIND = 1;
    int b, h, qb, r0, kr0, tlo, thi;
    __device__ __forceinline__ static int clip(int v, int lo, int hi_) { return v < lo ? lo : (v > hi_ ? hi_ : v); }
    __device__ __forceinline__ void init(int u) {
        qb = u & 15; const int bh = u >> 4; b = bh >> 3; h = bh & 7; r0 = 4 * qb;
        kr0 = clip(r0 - 4, 0, 56); tlo = 0; thi = clip(r0 - 1, 0, 56) + 8 - kr0;
    }
    __device__ __forceinline__ long qtok(int wid, int i) const { return (long)b * T + 256 * qb + 32 * wid + i; }
    __device__ __forceinline__ int qcol(int) const { return 1536 + h * 64; }
    __device__ __forceinline__ int kcol0() const { return 2048 + h * 64; }
    __device__ __forceinline__ int vcol0() const { return 2560 + h * 64; }
    __device__ __forceinline__ int kfrag(int) const { return 0; }
    __device__ __forceinline__ long ktok(int t, int row) const { return (long)b * T + 64 * (kr0 + t) + row; }
    __device__ __forceinline__ bool need(int t, int wid) const { const int r = r0 + (wid >> 1), rs = clip(r - 4, 0, 56), kr = kr0 + t; return kr >= rs && kr < rs + 8; }
    __device__ __forceinline__ void cinit(f32x16& p0, f32x16& p1, int t, int wid, int r32, int hi, const LAS float* tbl, float m) const {
        const int r = r0 + (wid >> 1), kr = kr0 + t, c = 32 * (wid & 1) + r32, wc = clip(c - 8, 0, 48);
        const LAS float* tp = tbl + 64 + (kr - r + 7) * 32 + (15 - c + 4 * hi);
        const int f = 4 * hi - wc;
#pragma unroll
        for (int q = 0; q < 16; ++q) { const int cq = (q & 3) + 8 * (q >> 2);
            const float v0 = tp[cq], v1 = tp[cq + 32];
            p0[q] = ((unsigned)(cq + f) < 16u) ? v0 - m : -INFINITY; p1[q] = ((unsigned)(cq + 32 + f) < 16u) ? v1 - m : -INFINITY; }
    }
};
struct PolDiff {
    static constexpr int W = 128, KIND = 2;
    int b, h, qb, tlo, thi; float nsl;
    __device__ __forceinline__ void init(int u) { const int k = u >> 8, c0 = u & 255, c = (c0 & 7) * 32 + (c0 >> 3)  , r = (k >> 3) * 256 + c; h = k & 7; b = r >> 5; qb = r & 31; tlo = 0; thi = T / 64; nsl = -slope_of(h) * LOG2E; }
    __device__ __forceinline__ long qtok(int wid, int i) const { return (long)b * T + 128 * qb + 32 * (wid & 3) + i; }
    __device__ __forceinline__ int qcol(int wid) const { return h * 128 + 64 * (wid >> 2); }
    __device__ __forceinline__ int kcol0() const { return 1024 + h * 128; }
    __device__ __forceinline__ int vcol0() const { return 2048 + h * 128; }
    __device__ __forceinline__ int kfrag(int wid) const { return 64 * (wid >> 2); }
    __device__ __forceinline__ long ktok(int t, int row) const { return (long)b * T + 64 * t + row; }
    __device__ __forceinline__ bool need(int, int) const { return true; }
    template <int BLK> __device__ __forceinline__ void cinit_off(f32x16& p, int t, int wid, int r32, int hi) const {
        const float base = (float)(128 * qb + 32 * (wid & 3) + r32 - 64 * t - 4 * hi - 32 * BLK);
        const float sn = t < 2 * qb ? nsl : -nsl, A = sn * base, cf = -sn;
#pragma unroll
        for (int r = 0; r < 16; ++r) p[r] = fmaf(cf, (float)((r & 3) + 8 * (r >> 2)), A);
    }
    template <int BLK> __device__ __forceinline__ void cinit_abs(f32x16& p, int t, int wid, int r32, int hi) const {
        const float base = (float)(128 * qb + 32 * (wid & 3) + r32 - 64 * t - 4 * hi - 32 * BLK);
#pragma unroll
        for (int r = 0; r < 16; ++r) p[r] = nsl * fabsf(base - (float)((r & 3) + 8 * (r >> 2)));
    }
    __device__ __forceinline__ void cinit(f32x16& p0, f32x16& p1, int t, int wid, int r32, int hi, const LAS float*, float m) const {
        const int i0 = 128 * qb + 32 * (wid & 3);
        const float base = (float)(i0 + r32 - 64 * t - 4 * hi);
        if (64 * t + 63 < i0) {
            const float A = nsl * base - m, n2 = -nsl;
#pragma unroll
            for (int r = 0; r < 16; ++r) { const float c = (float)((r & 3) + 8 * (r >> 2)); p0[r] = fmaf(n2, c, A); p1[r] = fmaf(n2, c + 32.f, A); }
        } else if (64 * t > i0 + 31) {
            const float A = -nsl * base - m;
#pragma unroll
            for (int r = 0; r < 16; ++r) { const float c = (float)((r & 3) + 8 * (r >> 2)); p0[r] = fmaf(nsl, c, A); p1[r] = fmaf(nsl, c + 32.f, A); }
        } else {
#pragma unroll
            for (int r = 0; r < 16; ++r) { const float c = (float)((r & 3) + 8 * (r >> 2));
                p0[r] = nsl * fabsf(base - c) - m; p1[r] = nsl * fabsf(base - (c + 32.f)) - m; }
        }
    }
};

template <class Pol> __device__ __forceinline__ void attn_unit(const Pol& P, LAS unsigned char* lds, const Ptrs& X, bf16x8& pq0, bf16x8& pq1, bf16x8& pq2, bf16x8& pq3, bf16x8& pk_, bf16x8& pv_, bool have, const Pol& Pn, bool hasn);
template <class Pol>
__device__ __forceinline__ void attn_unit(const Pol& P, LAS unsigned char* lds, const Ptrs& X, bf16x8& pq0, bf16x8& pq1, bf16x8& pq2, bf16x8& pq3, bf16x8& pk_, bf16x8& pv_, bool have, const Pol& Pn, bool hasn) {
    constexpr int W = Pol::W, NB = W / 32, CH = W / 64, KBYTES = 64 * W * 2, VBYTES = KBYTES, CPR = W / 8;
    int tid_ = threadIdx.x; asm volatile("" : "+v"(tid_));
    const int tid = tid_, wid = __builtin_amdgcn_readfirstlane(tid >> 6), lane = tid & 63, r32 = lane & 31, hi = lane >> 5;
    LAS unsigned char* K_lds = lds; LAS unsigned char* V_lds = lds + 2 * KBYTES;
    LAS float* li_l = (LAS float*)(lds + L_SCR) + wid * 64; LAS float* al_l = li_l + 32;
    LAS float* tbl = (LAS float*)(lds + L_TBL);
    const bf16_t* qkv = X.qkv;
    if constexpr (Pol::KIND == 1) { if (tid < 480) { const int row = tid >> 5, col = tid & 31; tbl[64 + tid] = col < 31 ? X.rpb[(P.h * 15 + row) * 31 + col] * LOG2E : 0.f; } }
    bf16x8 qr[4];
    const bool pre_ok = Pol::KIND != 2 && have;
    if (pre_ok) {
        qr[0] = pq0; qr[1] = pq1; qr[2] = pq2; qr[3] = pq3;
    } else { const bf16_t* qp = qkv + P.qtok(wid, r32) * NQKV + P.qcol(wid) + hi * 8;
#pragma unroll
      for (int d0 = 0; d0 < 4; ++d0) qr[d0] = *(const bf16x8*)(qp + d0 * 16); }
    const int kfb = P.kfrag(wid) * 2;
    bf16x8 ks[CH], vs[CH];
#define AT_SLOAD(t) do { _Pragma("unroll") for (int i_ = 0; i_ < CH; ++i_) { const int id_ = tid + 512 * i_, row_ = id_ / CPR, col_ = (id_ % CPR) * 8; \
        const bf16_t* g_ = qkv + P.ktok((t), row_) * NQKV + col_; ks[i_] = *(const bf16x8*)(g_ + P.kcol0()); vs[i_] = *(const bf16x8*)(g_ + P.vcol0()); } } while (0)
#define AT_SWRITE(b) do { _Pragma("unroll") for (int i_ = 0; i_ < CH; ++i_) { const int id_ = tid + 512 * i_, row_ = id_ / CPR, col_ = (id_ % CPR) * 8; \
        *(LAS bf16x8*)(K_lds + (b) * KBYTES + row_ * (W * 2) + ((col_ * 2) ^ ((row_ & 7) << 4))) = ks[i_]; \
        *(LAS bf16x8*)(V_lds + (b) * VBYTES + v_st<NB>(row_, col_)) = vs[i_]; } } while (0)
    float m_reg = 0.f, l_reg = 0.f; f32x16 o[NB];
#pragma unroll
    for (int d = 0; d < NB; ++d) o[d] = f32x16{};
    const int vb0 = (int)(unsigned)(size_t)V_lds + v_rd_base(lane);
    const int tlo = P.tlo, thi = P.thi;
    if (pre_ok) { ks[0] = pk_; vs[0] = pv_; } else AT_SLOAD(tlo);
    AT_SWRITE(tlo & 1); __syncthreads();
    for (int t = tlo; t < thi; ++t) {
        const int buf = t & 1;
        if constexpr (Pol::KIND != 2) { if (t + 1 < thi) AT_SLOAD(t + 1); }
        if constexpr (Pol::KIND != 2) { if (t + 1 == thi && hasn) {
            const bf16_t* qp = qkv + Pn.qtok(wid, r32) * NQKV + Pn.qcol(wid) + hi * 8;
            pq0 = *(const bf16x8*)(qp); pq1 = *(const bf16x8*)(qp + 16); pq2 = *(const bf16x8*)(qp + 32); pq3 = *(const bf16x8*)(qp + 48);
            const int row_ = tid / CPR, col_ = (tid % CPR) * 8; const bf16_t* g_ = qkv + Pn.ktok(Pn.tlo, row_) * NQKV + col_;
            pk_ = *(const bf16x8*)(g_ + Pn.kcol0()); pv_ = *(const bf16x8*)(g_ + Pn.vcol0()); } }
        if (P.need(t, wid)) {
            f32x16 p0, p1;
            P.cinit(p0, p1, t, wid, r32, hi, tbl, m_reg);
            const LAS unsigned char* Kb = K_lds + buf * KBYTES;
#pragma unroll
            for (int d0 = 0; d0 < 4; ++d0) { const int cb = kfb + (d0 * 16 + hi * 8) * 2, sw = cb ^ ((r32 & 7) << 4);
                const bf16x8 b0 = *(const LAS bf16x8*)(Kb + r32 * (W * 2) + sw);
                const bf16x8 b1 = *(const LAS bf16x8*)(Kb + (32 + r32) * (W * 2) + sw);
                p0 = __builtin_amdgcn_mfma_f32_32x32x16_bf16(b0, qr[d0], p0, 0, 0, 0);
                p1 = __builtin_amdgcn_mfma_f32_32x32x16_bf16(b1, qr[d0], p1, 0, 0, 0); }
            float pmax = fmaxf(p0[0], p1[0]);
#pragma unroll
            for (int r = 1; r < 16; ++r) pmax = fmaxf(fmaxf(pmax, p0[r]), p1[r]);
            { auto rr = __builtin_amdgcn_permlane32_swap(__float_as_uint(pmax), __float_as_uint(pmax), false, false);
              pmax = fmaxf(__uint_as_float(rr[0]), __uint_as_float(rr[1])); }
            float alpha = 1.f;
            if (__builtin_expect(!__all(pmax <= THR), 0)) {
                const float dm = fmaxf(pmax, 0.f); alpha = __builtin_amdgcn_exp2f(-dm); m_reg += dm;
#pragma unroll
                for (int r = 0; r < 16; ++r) { p0[r] -= dm; p1[r] -= dm; }
            }
            float ps = 0.f;
#pragma unroll
            for (int r = 0; r < 16; ++r) { p0[r] = __builtin_amdgcn_exp2f(p0[r]); p1[r] = __builtin_amdgcn_exp2f(p1[r]); ps += p0[r] + p1[r]; }
            { auto rr = __builtin_amdgcn_permlane32_swap(__float_as_uint(ps), __float_as_uint(ps), false, false);
              ps = __uint_as_float(rr[0]) + __uint_as_float(rr[1]); }
            l_reg = l_reg * alpha + ps;
            if (__any(alpha < 1.f)) { if (hi == 0) al_l[r32] = alpha; asm volatile("s_waitcnt lgkmcnt(0)" ::: "memory");
#pragma unroll
                for (int r = 0; r < 16; ++r) { const float a = al_l[crow(r, hi)];
#pragma unroll
                    for (int d = 0; d < NB; ++d) o[d][r] *= a; }
                asm volatile("s_waitcnt lgkmcnt(0)" ::: "memory"); }
            bf16x8 pa0, pa1, pa2, pa3;
#define AT_PK4(PP, BASE, OUT) do { unsigned a0 = cvtpk(PP[BASE + 0], PP[BASE + 1]), a1 = cvtpk(PP[BASE + 2], PP[BASE + 3]); \
    unsigned b0_ = cvtpk(PP[BASE + 4], PP[BASE + 5]), b1_ = cvtpk(PP[BASE + 6], PP[BASE + 7]); \
    auto r0_ = __builtin_amdgcn_permlane32_swap(a0, b0_, false, false); auto r1_ = __builtin_amdgcn_permlane32_swap(a1, b1_, false, false); \
    u32x4 w_ = {r0_[0], r1_[0], r0_[1], r1_[1]}; OUT = *reinterpret_cast<bf16x8*>(&w_); } while (0)
            AT_PK4(p0, 0, pa0); AT_PK4(p0, 8, pa1); AT_PK4(p1, 0, pa2); AT_PK4(p1, 8, pa3);
#undef AT_PK4
            const int vb = vb0 + buf * VBYTES;
            pv_one<NB, 0>(o[0], vb, pa0, pa1, pa2, pa3); pv_one<NB, 1>(o[1], vb, pa0, pa1, pa2, pa3);
            if constexpr (NB == 4) { pv_one<NB, 2>(o[2], vb, pa0, pa1, pa2, pa3); pv_one<NB, 3>(o[3], vb, pa0, pa1, pa2, pa3); }
        }
        if (t + 1 < thi) { if constexpr (Pol::KIND == 2) AT_SLOAD(t + 1); AT_SWRITE(buf ^ 1); }
        __syncthreads();
    }
#undef AT_SLOAD
#undef AT_SWRITE
    if (hi == 0) li_l[r32] = l_reg;
    asm volatile("s_waitcnt lgkmcnt(0)" ::: "memory");
    float rli[16];
#pragma unroll
    for (int r = 0; r < 16; ++r) rli[r] = __builtin_amdgcn_rcpf(li_l[crow(r, hi)]);
    if constexpr (Pol::KIND == 0) {
        bf16_t* ob = X.obr + (size_t)P.br * ((size_t)M * 512);
#pragma unroll
        for (int r = 0; r < 16; ++r) { const long tok = P.qtok(wid, crow(r, hi));
#pragma unroll
            for (int d = 0; d < NB; ++d) ob[tok * 512 + P.h * 64 + d * 32 + r32] = (bf16_t)(cvtpk(o[d][r] * rli[r], 0.f) & 0xffffu); }
        if (hi == 0) X.lse[(size_t)P.br * ((size_t)M * 8) + P.qtok(wid, r32) * 8 + P.h] = m_reg + __builtin_amdgcn_logf(l_reg);
    } else if constexpr (Pol::KIND == 1) {
#pragma unroll
        for (int r = 0; r < 16; ++r) { const long tok = P.qtok(wid, crow(r, hi));
#pragma unroll
            for (int d = 0; d < NB; ++d) X.att[tok * D + 512 + P.h * 64 + d * 32 + r32] = (bf16_t)(cvtpk(o[d][r] * rli[r], 0.f) & 0xffffu); }
    } else {
        LAS float* XB = (LAS float*)(lds + L_X);
        if (wid >= 4) {
#pragma unroll
            for (int r = 0; r < 16; ++r) { const int row = 32 * (wid & 3) + crow(r, hi);
#pragma unroll
                for (int d = 0; d < NB; ++d) XB[row * 128 + d * 32 + r32] = X.lam * o[d][r] * rli[r]; }
        }
        __syncthreads();
        if (wid < 4) {
#pragma unroll
            for (int r = 0; r < 16; ++r) { const int row = 32 * wid + crow(r, hi); float s = 0.f;
#pragma unroll
                for (int d = 0; d < NB; ++d) { const float y = o[d][r] * rli[r] - XB[row * 128 + d * 32 + r32]; o[d][r] = y; s += y * y; }
                s += sx(s, 1, lane); s += sx(s, 2, lane); s += sx(s, 4, lane); s += sx(s, 8, lane); s += sx(s, 16, lane);
                const float rs = (1.0f - LAM_INIT) / sqrtf(s * (1.0f / 128.f) + SUBLN_EPS);
                const long tok = P.qtok(wid, crow(r, hi));
#pragma unroll
                for (int d = 0; d < NB; ++d) X.att[tok * D + P.h * 128 + d * 32 + r32] = (bf16_t)(cvtpk(o[d][r] * rs * X.subln[d * 32 + r32], 0.f) & 0xffffu); }
        }
        __syncthreads();
    }
}

template <class Pol> __device__ __forceinline__ void attn_unit(const Pol& P, LAS unsigned char* lds, const Ptrs& X) { bf16x8 z0_ = {}, z1_ = {}, z2_ = {}, z3_ = {}, z4_ = {}, z5_ = {}; attn_unit(P, lds, X, z0_, z1_, z2_, z3_, z4_, z5_, false, P, false); }
typedef __bf16 bf16x2_t __attribute__((ext_vector_type(2)));
typedef float f32x2_t __attribute__((ext_vector_type(2)));
__device__ __forceinline__ unsigned pk2(float lo, float hi) { const f32x2_t v = {lo, hi}; return __builtin_bit_cast(unsigned, __builtin_convertvector(v, bf16x2_t)); }
__device__ __forceinline__ s16x4 trb(const LAS unsigned char* p) { return __builtin_amdgcn_ds_read_tr16_b64_v4i16((LAS s16x4*)p); }
template <int D0> __device__ __forceinline__ void pv_blk(f32x16& od, const LAS unsigned char* vb, bf16x8 pa0, bf16x8 pa1, bf16x8 pa2, bf16x8 pa3) {
    constexpr int NB = 4;
    const s16x4 l0 = trb(vb + v_rd_off<NB>(D0, 0, 0)), h0 = trb(vb + v_rd_off<NB>(D0, 0, 1)), l1 = trb(vb + v_rd_off<NB>(D0, 1, 0)), h1 = trb(vb + v_rd_off<NB>(D0, 1, 1));
    const s16x4 l2 = trb(vb + v_rd_off<NB>(D0, 2, 0)), h2 = trb(vb + v_rd_off<NB>(D0, 2, 1)), l3 = trb(vb + v_rd_off<NB>(D0, 3, 0)), h3 = trb(vb + v_rd_off<NB>(D0, 3, 1));
#define AT_PK(L, H) (bf16x8){L[0], L[1], L[2], L[3], H[0], H[1], H[2], H[3]}
    od = __builtin_amdgcn_mfma_f32_32x32x16_bf16(pa0, AT_PK(l0, h0), od, 0, 0, 0);
    od = __builtin_amdgcn_mfma_f32_32x32x16_bf16(pa1, AT_PK(l1, h1), od, 0, 0, 0);
    od = __builtin_amdgcn_mfma_f32_32x32x16_bf16(pa2, AT_PK(l2, h2), od, 0, 0, 0);
    od = __builtin_amdgcn_mfma_f32_32x32x16_bf16(pa3, AT_PK(l3, h3), od, 0, 0, 0);
#undef AT_PK
}
constexpr int DF_SCR = 98304;
__device__ __forceinline__ void diff_unit(const PolDiff& P, LAS unsigned char* lds, const Ptrs& X) {
    constexpr int W = 128, NB = 4, CH = 2, KBYTES = 64 * W * 2, VBYTES = KBYTES, NT = T / 64;
    int tid_ = threadIdx.x; asm volatile("" : "+v"(tid_));
    const int tid = tid_, wid = __builtin_amdgcn_readfirstlane(tid >> 6), lane = tid & 63, r32 = lane & 31, hi = lane >> 5;
    LAS unsigned char* K_lds = lds; LAS unsigned char* V_lds = lds + 3 * KBYTES;
    LAS float* li_l = (LAS float*)(lds + DF_SCR) + wid * 64;
    LAS unsigned* flag = (LAS unsigned*)(lds + DF_SCR + 8 * 256);
    const bf16_t* qkv = X.qkv;
    bf16x8 qr[4];
    { const bf16_t* qp = qkv + P.qtok(wid, r32) * NQKV + P.qcol(wid) + hi * 8;
#pragma unroll
      for (int d0 = 0; d0 < 4; ++d0) qr[d0] = *(const bf16x8*)(qp + d0 * 16); }
    const int kfb = P.kfrag(wid) * 2;
    int gko, gvo;
    { const int row = 4 * wid + (lane >> 4), c = (lane & 15) ^ (row & 7); gko = row * NQKV + P.kcol0() + 8 * c; }
    { const int sidx = 2 * wid + (lane >> 5), kk = 8 * (sidx >> 2) + ((lane & 31) >> 2), k = (kk & ~0xC) | ((kk & 4) << 1) | ((kk & 8) >> 1), c = 32 * (sidx & 3) + 8 * (lane & 3);
      gvo = k * NQKV + P.vcol0() + c; }
    const bf16_t* gtile = qkv + (long)P.b * T * NQKV;
    const LAS unsigned char* krd = K_lds + r32 * (W * 2);
    const LAS unsigned char* vrd = V_lds + v_rd_base(lane);
    if (tid == 0) flag[0] = 0u;
    int t_lo = 0, n_tiles = T / 64;
    if (P.h < 5)
    { float q2 = 0.f;
#pragma unroll
      for (int d0 = 0; d0 < 4; ++d0)
#pragma unroll
          for (int e = 0; e < 8; ++e) { const float f = bf2f((unsigned short)qr[d0][e]); q2 = fmaf(f, f, q2); }
      q2 += sx(q2, 32, lane);
#pragma unroll
      for (int o_ = 1; o_ < 32; o_ <<= 1) q2 = fmaxf(q2, sx(q2, o_, lane));
      if (lane == 0) li_l[0] = q2;
      __syncthreads();
      float qm1 = 0.f, qm2 = 0.f;
#pragma unroll
      for (int w_ = 0; w_ < 4; ++w_) { qm1 = fmaxf(qm1, ((LAS float*)(lds + DF_SCR))[w_ * 64]); qm2 = fmaxf(qm2, ((LAS float*)(lds + DF_SCR))[(w_ + 4) * 64]); }
      qm1 = sqrtf(qm1) * 1.01f; qm2 = sqrtf(qm2) * 1.01f;
      const float* kn = X.kn + ((P.b * 8 + P.h) * 2) * 128;
      const float k1_ = sqrtf(kn[2 * lane] + kn[2 * lane + 1]) * 1.001f, k2_ = sqrtf(kn[128 + 2 * lane] + kn[128 + 2 * lane + 1]) * 1.001f;
      const float sb = fmaxf(qm1 * k1_, qm2 * k2_);
      const int i0u = 128 * P.qb;
      const int dist = lane < 2 * P.qb ? i0u - (64 * lane + 63) : (lane > 2 * P.qb + 1 ? 64 * lane - (i0u + 127) : 0);
      const bool visit = sb + P.nsl * (float)dist > -152.f;
      const unsigned long long mask = __ballot(visit) | (3ull << (2 * P.qb));
      int lo = __builtin_ctzll(mask), hi_t = 63 - __builtin_clzll(mask);
      if (((hi_t - lo + 1) & 1) != 0) { if (lo > 0) --lo; else ++hi_t; }
      if (hi_t - lo + 1 < 4) { if (lo > 1) lo -= 2; else hi_t += 2; }
      t_lo = __builtin_amdgcn_readfirstlane(lo); n_tiles = __builtin_amdgcn_readfirstlane(hi_t - lo + 1);
      __syncthreads();
    }
#define DF_TL(k) ((k) < 2 ? 2 * P.qb + (k) : (t_lo + (k) - 2 < 2 * P.qb ? t_lo + (k) - 2 : t_lo + (k)))
#define DF_GLDS(k, rb) do { const bf16_t* g_ = gtile + (long)(64 * DF_TL(k)) * NQKV; _Pragma("unroll") for (int i_ = 0; i_ < 2; ++i_) { \
        __builtin_amdgcn_global_load_lds((const unsigned*)(g_ + gko + i_ * (32 * NQKV)), (LAS unsigned*)(K_lds + (rb) * KBYTES + (wid + 8 * i_) * 1024), 16, 0, 0); \
        __builtin_amdgcn_global_load_lds((const unsigned*)(g_ + gvo + i_ * (32 * NQKV)), (LAS unsigned*)(V_lds + (rb) * VBYTES + (wid + 8 * i_) * 1024), 16, 0, 0); } } while (0)
#define DF_QK(p0, p1, rb) do { const LAS unsigned char* Kb_ = krd + (rb) * KBYTES; \
        _Pragma("unroll") for (int d0 = 0; d0 < 4; ++d0) { const int sw_ = (kfb + (d0 * 16 + hi * 8) * 2) ^ ((r32 & 7) << 4); \
            const bf16x8 b0_ = *(const LAS bf16x8*)(Kb_ + sw_); const bf16x8 b1_ = *(const LAS bf16x8*)(Kb_ + 32 * (W * 2) + sw_); \
            p0 = __builtin_amdgcn_mfma_f32_32x32x16_bf16(b0_, qr[d0], p0, 0, 0, 0); p1 = __builtin_amdgcn_mfma_f32_32x32x16_bf16(b1_, qr[d0], p1, 0, 0, 0); } } while (0)
#define DF_KRD(b0v, b1v, rb, d0) do { const LAS unsigned char* Kb_ = krd + (rb) * KBYTES; const int sw_ = (kfb + ((d0) * 16 + hi * 8) * 2) ^ ((r32 & 7) << 4); \
        b0v = *(const LAS bf16x8*)(Kb_ + sw_); b1v = *(const LAS bf16x8*)(Kb_ + 32 * (W * 2) + sw_); } while (0)
#define DF_KMM(p0, p1, b0v, b1v, d0) do { p0 = __builtin_amdgcn_mfma_f32_32x32x16_bf16(b0v, qr[d0], p0, 0, 0, 0); p1 = __builtin_amdgcn_mfma_f32_32x32x16_bf16(b1v, qr[d0], p1, 0, 0, 0); } while (0)
#define DF_QK1(p0, p1, rb, d0) do { const LAS unsigned char* Kb_ = krd + (rb) * KBYTES; const int sw_ = (kfb + ((d0) * 16 + hi * 8) * 2) ^ ((r32 & 7) << 4); \
        const bf16x8 b0_ = *(const LAS bf16x8*)(Kb_ + sw_); const bf16x8 b1_ = *(const LAS bf16x8*)(Kb_ + 32 * (W * 2) + sw_); \
        p0 = __builtin_amdgcn_mfma_f32_32x32x16_bf16(b0_, qr[d0], p0, 0, 0, 0); p1 = __builtin_amdgcn_mfma_f32_32x32x16_bf16(b1_, qr[d0], p1, 0, 0, 0); } while (0)
#define DF_SUM16(p) ((((p[0] + p[1]) + (p[2] + p[3])) + ((p[4] + p[5]) + (p[6] + p[7]))) + (((p[8] + p[9]) + (p[10] + p[11])) + ((p[12] + p[13]) + (p[14] + p[15]))))
#define DF_EXP_H(pp, b8) do { _Pragma("unroll") for (int r = 0; r < 8; ++r) pp[(b8) + r] = __builtin_amdgcn_exp2f(pp[(b8) + r]); } while (0)
#define DF_EXP_A(p0, p1) do { _Pragma("unroll") for (int r = 0; r < 16; ++r) p0[r] = __builtin_amdgcn_exp2f(p0[r]); _Pragma("unroll") for (int r = 0; r < 8; ++r) p1[r] = __builtin_amdgcn_exp2f(p1[r]); } while (0)
#define DF_FINISH(p0, p1) do { _Pragma("unroll") for (int r = 8; r < 16; ++r) p1[r] = __builtin_amdgcn_exp2f(p1[r]); \
        float ps_ = 0.f; _Pragma("unroll") for (int r = 0; r < 16; ++r) ps_ += p0[r] + p1[r]; l_reg += ps_; \
        DF_PK4(p0, 0, pa0); DF_PK4(p0, 8, pa1); DF_PK4(p1, 0, pa2); DF_PK4(p1, 8, pa3); } while (0)
#define DF_PK4(PP, BASE, OUT) do { unsigned a0 = pk2(PP[BASE + 0], PP[BASE + 1]), a1 = pk2(PP[BASE + 2], PP[BASE + 3]); \
    unsigned b0_ = pk2(PP[BASE + 4], PP[BASE + 5]), b1_ = pk2(PP[BASE + 6], PP[BASE + 7]); \
    auto r0_ = __builtin_amdgcn_permlane32_swap(a0, b0_, false, false); auto r1_ = __builtin_amdgcn_permlane32_swap(a1, b1_, false, false); \
    u32x4 w_ = {r0_[0], r1_[0], r0_[1], r1_[1]}; OUT = *reinterpret_cast<bf16x8*>(&w_); } while (0)
#define DF_PV(rb) do { const LAS unsigned char* vb_ = vrd + (rb) * VBYTES; pv_blk<0>(o[0], vb_, pa0, pa1, pa2, pa3); pv_blk<1>(o[1], vb_, pa0, pa1, pa2, pa3); \
        pv_blk<2>(o[2], vb_, pa0, pa1, pa2, pa3); pv_blk<3>(o[3], vb_, pa0, pa1, pa2, pa3); } while (0)
#define DF_HALF(c0, c1, q0, q1, j, LOADS) do { \
        DF_KRD(ka0, ka1, rc, 0); if (LOADS) DF_GLDS((j) + 1, rn); __builtin_amdgcn_sched_barrier(0);     \
        { float ps0_ = 0.f, ps1_ = 0.f; \
          DF_KRD(kb0, kb1, rc, 1); DF_KMM(c0, c1, ka0, ka1, 0); DF_EXP_H(q1, 8); __builtin_amdgcn_sched_barrier(0); \
          DF_KRD(ka0, ka1, rc, 2); DF_KMM(c0, c1, kb0, kb1, 1); ps0_ = DF_SUM16(q0); DF_PK4(q0, 0, pa0); __builtin_amdgcn_sched_barrier(0); \
          DF_KRD(kb0, kb1, rc, 3); DF_KMM(c0, c1, ka0, ka1, 2); ps1_ = DF_SUM16(q1); DF_PK4(q0, 8, pa1); __builtin_amdgcn_sched_barrier(0); \
          DF_KMM(c0, c1, kb0, kb1, 3); l_reg += ps0_ + ps1_; DF_PK4(q1, 0, pa2); DF_PK4(q1, 8, pa3); __builtin_amdgcn_sched_barrier(0); } \
        { const LAS unsigned char* vb_ = vrd + rp * VBYTES; \
          pv_blk<0>(o[0], vb_, pa0, pa1, pa2, pa3); DF_EXP_H(c0, 0); __builtin_amdgcn_sched_barrier(0); \
          pv_blk<1>(o[1], vb_, pa0, pa1, pa2, pa3); DF_EXP_H(c0, 8); __builtin_amdgcn_sched_barrier(0); \
          pv_blk<2>(o[2], vb_, pa0, pa1, pa2, pa3); DF_EXP_H(c1, 0); if (LOADS) P.cinit_off<0>(q0, DF_TL((j) + 1), wid, r32, hi); __builtin_amdgcn_sched_barrier(0); \
          pv_blk<3>(o[3], vb_, pa0, pa1, pa2, pa3); if (LOADS) P.cinit_off<1>(q1, DF_TL((j) + 1), wid, r32, hi); __builtin_amdgcn_sched_barrier(0); } \
        __syncthreads(); { const int t_ = rp; rp = rc; rc = rn; rn = t_; } } while (0)
    float l_reg = 0.f; f32x16 o[NB];
#pragma unroll
    for (int d = 0; d < NB; ++d) o[d] = f32x16{};
    f32x16 pA0, pA1, pB0, pB1; bf16x8 pa0, pa1, pa2, pa3, ka0, ka1, kb0, kb1;
    int rp = 2, rc = 0, rn = 1;
    DF_GLDS(0, 0); DF_GLDS(1, 1); __syncthreads();
    P.cinit_abs<0>(pA0, DF_TL(0), wid, r32, hi); P.cinit_abs<1>(pA1, DF_TL(0), wid, r32, hi); DF_QK(pA0, pA1, 0); DF_EXP_A(pA0, pA1);
    P.cinit_abs<0>(pB0, DF_TL(1), wid, r32, hi); P.cinit_abs<1>(pB1, DF_TL(1), wid, r32, hi);
    rp = 0; rc = 1; rn = 2;
    { int j = 1;
      do { DF_HALF(pB0, pB1, pA0, pA1, j, true);
           DF_HALF(pA0, pA1, pB0, pB1, j + 1, true); j += 2; } while (j + 2 < n_tiles); }
    DF_HALF(pB0, pB1, pA0, pA1, n_tiles - 1, false);
    DF_FINISH(pB0, pB1); DF_PV(rp);
#undef DF_GLDS
#undef DF_TL
#undef DF_QK
#undef DF_EXP_A
#undef DF_QK1
#undef DF_KRD
#undef DF_KMM
#undef DF_SUM16
#undef DF_EXP_H
#undef DF_FINISH
#undef DF_PK4
#undef DF_PV
#undef DF_HALF
    int tid2_ = threadIdx.x; asm volatile("" : "+v"(tid2_));
    const int lane2 = tid2_ & 63, r32b = lane2 & 31, hib = lane2 >> 5;
    { auto rr = __builtin_amdgcn_permlane32_swap(__float_as_uint(l_reg), __float_as_uint(l_reg), false, false);
      l_reg = __uint_as_float(rr[0]) + __uint_as_float(rr[1]); }
    const bool bad = !(l_reg > 7.9e-31f && l_reg < 1.2e30f);
    if (__any(bad) && lane2 == 0) flag[0] = 1u;
    __syncthreads();
    const bool redo = __builtin_amdgcn_readfirstlane((int)flag[0]) != 0;
    __syncthreads();
    if (redo) { attn_unit(P, lds, X); return; }
    if (hib == 0) li_l[r32b] = l_reg;
    asm volatile("s_waitcnt lgkmcnt(0)" ::: "memory");
    float rli[16];
#pragma unroll
    for (int r = 0; r < 16; ++r) rli[r] = __builtin_amdgcn_rcpf(li_l[crow(r, hib)]);
    LAS float* XB = (LAS float*)lds;
    if (wid >= 4) {
#pragma unroll
        for (int r = 0; r < 16; ++r) { const int row = 32 * (wid & 3) + crow(r, hib);
#pragma unroll
            for (int d = 0; d < NB; ++d) XB[row * 128 + d * 32 + r32b] = X.lam * o[d][r] * rli[r]; }
    }
    __syncthreads();
    if (wid < 4) {
#pragma unroll
        for (int r = 0; r < 16; ++r) { const int row = 32 * wid + crow(r, hib); float s = 0.f;
#pragma unroll
            for (int d = 0; d < NB; ++d) { const float y = o[d][r] * rli[r] - XB[row * 128 + d * 32 + r32b]; o[d][r] = y; s += y * y; }
            s += sx(s, 1, lane2); s += sx(s, 2, lane2); s += sx(s, 4, lane2); s += sx(s, 8, lane2); s += sx(s, 16, lane2);
            const float rs = (1.0f - LAM_INIT) / sqrtf(s * (1.0f / 128.f) + SUBLN_EPS);
            const long tok = P.qtok(wid, crow(r, hib));
#pragma unroll
            for (int d = 0; d < NB; ++d) X.att[tok * D + P.h * 128 + d * 32 + r32b] = (bf16_t)(pk2(o[d][r] * rs * X.subln[d * 32 + r32b], 0.f) & 0xffffu); }
    }
    __syncthreads();
}
}

#define XB_TMO      128
#define XB_XCNT(j)  (256  + 64 * (j))
#define XB_XSUB(j)  (1280 + 64 * (j))
#define XB_XGEN(j)  (2304 + 64 * (j))
#define XB_TOP      3328
#define XB_TOPGEN   3392
#define XCD_BAR_WORDS 3456
#define XB_SPIN_CAP (1u << 18)

__device__ __forceinline__ unsigned xb_ld(unsigned* p)              { return __hip_atomic_load(p, __ATOMIC_RELAXED, __HIP_MEMORY_SCOPE_AGENT); }
__device__ __forceinline__ unsigned xb_add(unsigned* p, unsigned v) { return __hip_atomic_fetch_add(p, v, __ATOMIC_RELAXED, __HIP_MEMORY_SCOPE_AGENT); }
__device__ __forceinline__ unsigned xb_xcc_id() { return (unsigned)__builtin_amdgcn_s_getreg((3 << 11) | 20) & 0xFu; }
#define XB_SPIN(cond, bar) do { unsigned _sp = 0; while (cond) { __builtin_amdgcn_s_sleep(1); \
    if ((++_sp & 255u) == 0u) { if (xb_ld(&(bar)[XB_TMO])) break; if (_sp > XB_SPIN_CAP) { atomicAdd(&(bar)[XB_TMO], 1u); break; } } } } while (0)

struct XcdBarrier {
    unsigned* bar; unsigned x;
    volatile LAS unsigned* st;
};

__device__ __forceinline__ XcdBarrier xcd_barrier_post(unsigned* bar, volatile LAS unsigned* st) {
    XcdBarrier b; b.bar = bar; b.x = xb_xcc_id(); b.st = st;
    if (threadIdx.x == 0) (void)xb_add(&bar[XB_XCNT(b.x)], 1u);
    return b;
}
__device__ __forceinline__ void xcd_barrier_complete(unsigned* bar, unsigned x, unsigned& nloc, unsigned& nx) {
    const unsigned G = gridDim.x * gridDim.y * gridDim.z;
    unsigned sum, cnt, mine, sp = 0u;
    for (;;) {
        sum = 0u; cnt = 0u; mine = 0u;
#pragma unroll
        for (unsigned j = 0; j < 16; ++j) { const unsigned c = xb_ld(&bar[XB_XCNT(j)]); sum += c; cnt += (c > 0u) ? 1u : 0u; mine = (j == x) ? c : mine; }
        if (sum == G) break;
        __builtin_amdgcn_s_sleep(1);
        if ((++sp & 255u) == 0u) { if (xb_ld(&bar[XB_TMO])) break; if (sp > XB_SPIN_CAP) { atomicAdd(&bar[XB_TMO], 1u); break; } }
    }
    nloc = mine > 0u ? mine : 1u; nx = cnt > 0u ? cnt : 1u;
}

__device__ __forceinline__ void xcd_barrier(const XcdBarrier& b) {
    asm volatile("s_waitcnt vmcnt(0)" ::: "memory");
    __syncthreads();
    if (threadIdx.x == 0) {
        unsigned* bar = b.bar;
        __builtin_amdgcn_s_waitcnt(0);
        unsigned nloc = b.st[0], nx = b.st[1];
        if (nloc == 0u) { xcd_barrier_complete(bar, b.x, nloc, nx); b.st[0] = nloc; b.st[1] = nx; }
        const unsigned old = xb_add(&bar[XB_XSUB(b.x)], 1u);
        const unsigned gen = old / nloc;
        if (old + 1u == (gen + 1u) * nloc) {
            __builtin_amdgcn_fence(__ATOMIC_RELEASE, "agent");
            asm volatile("s_waitcnt vmcnt(0)" ::: "memory");
            const unsigned og = xb_add(&bar[XB_TOP], 1u);
            const unsigned tg = og / nx;
            if (og + 1u == (tg + 1u) * nx) xb_add(&bar[XB_TOPGEN], 1u);
            else XB_SPIN(xb_ld(&bar[XB_TOPGEN]) == tg, bar);
            __builtin_amdgcn_fence(__ATOMIC_ACQUIRE, "agent");
            xb_add(&bar[XB_XGEN(b.x)], 1u);
            asm volatile("s_waitcnt vmcnt(0)" ::: "memory");
        } else {
            XB_SPIN(xb_ld(&bar[XB_XGEN(b.x)]) == gen, bar);
            __builtin_amdgcn_fence(__ATOMIC_ACQUIRE, "agent");
            asm volatile("s_waitcnt vmcnt(0)" ::: "memory");
        }
    }
    __syncthreads();
}

__device__ __forceinline__ void grp_barrier(unsigned* cnt, unsigned& epoch, unsigned nmem) {
    asm volatile("s_waitcnt vmcnt(0)" ::: "memory");
    __syncthreads();
    epoch += 1u;
    if (threadIdx.x == 0) {
        __builtin_amdgcn_fence(__ATOMIC_RELEASE, "agent"); asm volatile("s_waitcnt vmcnt(0)" ::: "memory");
        (void)xb_add(cnt, 1u);
        const unsigned target = nmem * epoch; unsigned sp = 0u;
        while (xb_ld(cnt) < target) { __builtin_amdgcn_s_sleep(1); if (++sp > (1u << 22)) break; }
        __builtin_amdgcn_fence(__ATOMIC_ACQUIRE, "agent"); asm volatile("s_waitcnt vmcnt(0)" ::: "memory");
    }
    __syncthreads();
}

constexpr size_t MiB = 1u << 20;
constexpr size_t WS_W = 2 * MiB, WS_WL = 26 * MiB;
constexpr size_t WO_IN = 0, WO_O = 6 * MiB, WO_GU = 8 * MiB, WO_D = 19 * MiB;
constexpr size_t WS_BAR = 512 * 1024, WS_BAR_BYTES = 32768;
constexpr size_t WS_KN = 0;
constexpr size_t WS_SS = 56 * MiB, WS_LSE = 60 * MiB, WS_XB = 68 * MiB, WS_ATT = 196 * MiB, WS_OBR = 324 * MiB, WS_QKV = 516 * MiB, WS_H = WS_QKV, WS_END = 900 * MiB;
constexpr int LDS_BYTES = 147456;

struct Args { const float* in[22]; float* out; unsigned char* ws; int ph_lo, ph_hi; };
enum { I_X = 0, I_A0N = 1, I_A0IN = 2, I_A0OUT = 3, I_RPB = 4, I_F0N = 5, I_F0G = 6, I_F0U = 7, I_F0D = 8, I_A1N = 9, I_A1QKV = 10, I_A1OUT = 11,
       I_LQ1 = 12, I_LK1 = 13, I_LQ2 = 14, I_LK2 = 15, I_SUBLN = 16, I_F1N = 17, I_F1G = 18, I_F1U = 19, I_F1D = 20, I_FN = 21 };
constexpr int NPH = 14;

__device__ __forceinline__ float wave_sum(float v, int lane) {
#pragma unroll
    for (int o = 1; o < 64; o <<= 1) v += sx(v, o, lane);
    return v;
}
__device__ __forceinline__ void transpose_item(const float* W, const float* gain, int K, int N, bf16_t* WT, int mode, LAS float* scr, int item, int lane) {
    const int nblk = N / 32, kb = item / nblk, nb = item % nblk, k0 = 64 * kb, n0 = 32 * nb;
#pragma unroll 8
    for (int i = 0; i < 32; ++i) { const int kk = 2 * i + (lane >> 5); const float g = gain ? gain[k0 + kk] : 1.0f; scr[kk * 33 + (lane & 31)] = W[(size_t)(k0 + kk) * N + n0 + (lane & 31)] * g; }
    asm volatile("s_waitcnt lgkmcnt(0)" ::: "memory");
    const int c = lane & 7;
    const int ob = mode == 0 ? n0 : 256 * (n0 >> 7) + 128 * (mode - 1) + (n0 & 127);
#pragma unroll
    for (int j = 0; j < 4; ++j) { const int n = (lane >> 3) + 8 * j; const LAS float* s = scr + (8 * c) * 33 + n;
        u32x4 o; o.x = cvtpk(s[0 * 33], s[1 * 33]); o.y = cvtpk(s[2 * 33], s[3 * 33]); o.z = cvtpk(s[4 * 33], s[5 * 33]); o.w = cvtpk(s[6 * 33], s[7 * 33]);
        *(u32x4*)(WT + (size_t)(ob + n) * K + k0 + 8 * c) = o; }
    asm volatile("s_waitcnt lgkmcnt(0)" ::: "memory");
}

__global__ void __launch_bounds__(512, 2) mk_fwd(Args a) {
    extern __shared__ __attribute__((aligned(16))) unsigned char lds_raw[];
    LAS unsigned char* lds = (LAS unsigned char*)lds_raw;
    cg::grid_group grid = cg::this_grid();
    { volatile LAS unsigned* st_ = (volatile LAS unsigned*)(lds + LDS_BYTES - 64); if (threadIdx.x < 2) st_[threadIdx.x] = 0u; }
    __syncthreads();
    const XcdBarrier bar = xcd_barrier_post((unsigned*)(a.ws + WS_BAR), (volatile LAS unsigned*)(lds + LDS_BYTES - 64));
    if (a.ph_lo < 0) grid.sync();
    const int wave = __builtin_amdgcn_readfirstlane((int)threadIdx.x >> 6);
    const int G = gridDim.x, gw = blockIdx.x * 8 + wave, NGW = G * 8;
    const bool grp = (G == M / 256) && (G % 8 == 0) && MK_DUP_MASK == 0;
    unsigned grp_epoch = 0u; unsigned* const grp_cnt = (unsigned*)(a.ws + WS_BAR) + 3520 + 64 * ((int)blockIdx.x & 7);
    unsigned char* ws = a.ws;
    float* ss = (float*)(ws + WS_SS); float* lse = (float*)(ws + WS_LSE);
    bf16_t* xb = (bf16_t*)(ws + WS_XB); bf16_t* att = (bf16_t*)(ws + WS_ATT); bf16_t* obr = (bf16_t*)(ws + WS_OBR);
    bf16_t* qkv = (bf16_t*)(ws + WS_QKV); bf16_t* hb = (bf16_t*)(ws + WS_H);

#ifdef MK_PROBE_SYNCS
    for (int i_ = 0; i_ < MK_PROBE_SYNCS; ++i_) xcd_barrier(bar);
#endif
    for (int ph = a.ph_lo; ph < a.ph_hi; ++ph)
    for (int rep = 0; rep <= ((MK_DUP_MASK >> ph) & 1); ++rep) {
        if (ph == 0) {
            int tq_ = threadIdx.x; asm volatile("" : "+v"(tq_)); const int lane = tq_ & 63;
            LAS float* scr = (LAS float*)(lds + wave * 16384);
            constexpr int I_IN = 16 * 96, I_O = 16 * 32, I_G = 16 * 88, I_D = 44 * 32, I_L = I_IN + I_O + 2 * I_G + I_D;
            for (int it = gw; it < 2 * I_L; it += NGW) {
                const int l = it / I_L; int r = it % I_L; unsigned char* wl = ws + WS_W + (size_t)l * WS_WL;
                const float* an = a.in[l ? I_A1N : I_A0N]; const float* fn = a.in[l ? I_F1N : I_F0N];
                if (r < I_IN) { transpose_item(a.in[l ? I_A1QKV : I_A0IN], an, D, NQKV, (bf16_t*)(wl + WO_IN), 0, scr, r, lane); continue; } r -= I_IN;
                if (r < I_O) { transpose_item(a.in[l ? I_A1OUT : I_A0OUT], nullptr, D, D, (bf16_t*)(wl + WO_O), 0, scr, r, lane); continue; } r -= I_O;
                if (r < I_G) { transpose_item(a.in[l ? I_F1G : I_F0G], fn, D, FF, (bf16_t*)(wl + WO_GU), 1, scr, r, lane); continue; } r -= I_G;
                if (r < I_G) { transpose_item(a.in[l ? I_F1U : I_F0U], fn, D, FF, (bf16_t*)(wl + WO_GU), 2, scr, r, lane); continue; } r -= I_G;
                transpose_item(a.in[l ? I_F1D : I_F0D], nullptr, FF, D, (bf16_t*)(wl + WO_D), 0, scr, r, lane);
            }
            const float* x = a.in[I_X];
            for (int m = gw; m < M; m += 2 * NGW) {
                const f32x4* xr0 = (const f32x4*)(x + (size_t)m * D) + lane; const f32x4* xr1 = (const f32x4*)(x + (size_t)(m + NGW) * D) + lane; f32x4 v0[4], v1[4];
#pragma unroll
                for (int j = 0; j < 4; ++j) { v0[j] = xr0[64 * j]; v1[j] = xr1[64 * j]; }
                float s0 = 0.f, s1 = 0.f;
#pragma unroll
                for (int j = 0; j < 4; ++j) { s0 += (v0[j][0] * v0[j][0] + v0[j][1] * v0[j][1]) + (v0[j][2] * v0[j][2] + v0[j][3] * v0[j][3]);
                                              s1 += (v1[j][0] * v1[j][0] + v1[j][1] * v1[j][1]) + (v1[j][2] * v1[j][2] + v1[j][3] * v1[j][3]); }
                s0 = wave_sum(s0, lane); s1 = wave_sum(s1, lane);
                u32x2* o0 = (u32x2*)(xb + (size_t)m * D) + lane; u32x2* o1 = (u32x2*)(xb + (size_t)(m + NGW) * D) + lane;
#pragma unroll
                for (int j = 0; j < 4; ++j) { u32x2 w; w.x = cvtpk(v0[j][0], v0[j][1]); w.y = cvtpk(v0[j][2], v0[j][3]); o0[64 * j] = w;
                                              u32x2 z; z.x = cvtpk(v1[j][0], v1[j][1]); z.y = cvtpk(v1[j][2], v1[j][3]); o1[64 * j] = z; }
                if (lane < 16) { ss[(size_t)m * 16 + lane] = lane == 0 ? s0 : 0.f; ss[(size_t)(m + NGW) * 16 + lane] = lane == 0 ? s1 : 0.f; }
            }
        } else if (ph == 13) {
            int tq_ = threadIdx.x; asm volatile("" : "+v"(tq_)); const int lane = tq_ & 63;
            const float* g = a.in[I_FN];
            f32x4 gg[4];
#pragma unroll
            for (int j = 0; j < 4; ++j) gg[j] = ((const f32x4*)g)[lane + 64 * j];
            const int pm_ = ((int)blockIdx.x & 7) * 32 + ((int)blockIdx.x >> 3);
            const int m_lo = grp ? pm_ * 256 + wave : gw, m_hi = grp ? pm_ * 256 + 256 : M, m_st = grp ? 8 : NGW;
            for (int m = m_lo; m < m_hi; m += 2 * m_st) {
                f32x4* xr0 = (f32x4*)(a.out + (size_t)m * D) + lane; f32x4* xr1 = (f32x4*)(a.out + (size_t)(m + m_st) * D) + lane; f32x4 v0[4], v1[4];
#pragma unroll
                for (int j = 0; j < 4; ++j) { v0[j] = xr0[64 * j]; v1[j] = xr1[64 * j]; }
                float s0 = 0.f, s1 = 0.f;
#pragma unroll
                for (int j = 0; j < 4; ++j) { s0 += (v0[j][0] * v0[j][0] + v0[j][1] * v0[j][1]) + (v0[j][2] * v0[j][2] + v0[j][3] * v0[j][3]);
                                              s1 += (v1[j][0] * v1[j][0] + v1[j][1] * v1[j][1]) + (v1[j][2] * v1[j][2] + v1[j][3] * v1[j][3]); }
                s0 = wave_sum(s0, lane); s1 = wave_sum(s1, lane);
                const float rs0 = 1.0f / sqrtf(s0 * (1.0f / D) + RMS_EPS), rs1 = 1.0f / sqrtf(s1 * (1.0f / D) + RMS_EPS);
#pragma unroll
                for (int j = 0; j < 4; ++j) { xr0[64 * j] = v0[j] * rs0 * gg[j]; xr1[64 * j] = v1[j] * rs1 * gg[j]; }
            }
        } else {
            const int l = (ph - 1) / 6, s = (ph - 1) % 6;
            unsigned char* wl = ws + WS_W + (size_t)l * WS_WL;
            if (s == 0) {
                pg8::Gemm g{xb, (const bf16_t*)(wl + WO_IN), M, NQKV, D}; pg8::StaticOrder S; S.init(M, NQKV, G, (int)blockIdx.x);
                pg8::EpiScaleBf16 E{qkv, NQKV, ss, l == 0 ? 0xC3u : 0xFu, l == 1 ? (float*)(ws + WS_KN) : nullptr};
#ifndef SKIP_G1
                pg8::gemm_phase<pg8::EpiScaleBf16, pg8::StaticOrder, true, true>(lds, g, S, E);
#endif
            } else if (s == 1) {
                at::Ptrs X{qkv, att, obr, lse, a.in[I_RPB], a.in[I_SUBLN], 0.f, (const float*)(ws + WS_KN)};
                if (l == 0) {
                    if (grp) {
                        const int x_ = (int)blockIdx.x & 7;
                        unsigned* qctr = (unsigned*)(a.ws + WS_BAR) + 4608 + 64 * x_;
                        LAS unsigned* qs = (LAS unsigned*)(lds + LDS_BYTES - 32);
                        if (threadIdx.x == 0) { const unsigned i0_ = xb_add(qctr, 1u), i1_ = xb_add(qctr, 1u); qs[0] = i0_; qs[1] = i1_; }
                        __syncthreads();
                        int sa = 0, sb = 1, sc = 2; bool have = false;
                        bf16x8 pq0 = {}, pq1 = {}, pq2 = {}, pq3 = {}, pk_ = {}, pv_ = {};
                        for (;;) {
                            const unsigned i = (unsigned)__builtin_amdgcn_readfirstlane((int)qs[sa]), in = (unsigned)__builtin_amdgcn_readfirstlane((int)qs[sb]);
                            if (i >= 1024u) break;
                            unsigned nx2 = 0u; if (threadIdx.x == 0) nx2 = xb_add(qctr, 1u);
                            if (i < 256u) { at::PolNat P, Pn; P.init(x_ * 256 + (int)i); const bool hasn = in < 256u; if (hasn) Pn.init(x_ * 256 + (int)in); else Pn = P;
                                at::attn_unit(P, lds, X, pq0, pq1, pq2, pq3, pk_, pv_, have, Pn, hasn); have = hasn; }
                            else { const int i2 = (int)i - 256, n2 = (int)in - 256;
                                at::PolDil P, Pn; P.init((i2 >> 8) * 2048 + x_ * 256 + (i2 & 255));
                                const bool hasn = in < 1024u && in >= 256u; if (hasn) Pn.init((n2 >> 8) * 2048 + x_ * 256 + (n2 & 255)); else Pn = P;
                                at::attn_unit(P, lds, X, pq0, pq1, pq2, pq3, pk_, pv_, have, Pn, hasn); have = hasn; }
                            if (threadIdx.x == 0) qs[sc] = nx2;
                            __syncthreads(); { const int t_ = sa; sa = sb; sb = sc; sc = t_; }
                        }
                    } else {
                    const int vc0 = ((int)blockIdx.x & 7) * (G >> 3) + ((int)blockIdx.x >> 3);
#ifndef SKIP_NAT
                    for (int u = vc0; u < 2048; u += G) { at::PolNat P; P.init(u); at::attn_unit(P, lds, X); }
#endif
#ifndef SKIP_DIL
                    { bf16x8 pq0 = {}, pq1 = {}, pq2 = {}, pq3 = {}, pk_ = {}, pv_ = {}; bool have = false;
                      for (int u = 2048 + vc0; u < 8192; u += G) { at::PolDil P, Pn; P.init(u - 2048); const bool hasn = u + G < 8192; if (hasn) Pn.init(u + G - 2048); else Pn = P;
                          at::attn_unit(P, lds, X, pq0, pq1, pq2, pq3, pk_, pv_, have, Pn, hasn); have = hasn; } }
#endif
                    }
                }
            } else if (s == 2) {
                if (l == 0) {
                    int tq_ = threadIdx.x; asm volatile("" : "+v"(tq_)); const int lane = tq_ & 63;
                    const int hd = lane >> 3;
                    for (int m0 = gw; m0 < M; m0 += 2 * NGW) {
                        float L[2][3]; bf16x8 ov[2][3];
#pragma unroll
                        for (int r = 0; r < 2; ++r) { const size_t m = (size_t)m0 + (size_t)r * NGW;
#pragma unroll
                            for (int i = 0; i < 3; ++i) { L[r][i] = lse[(size_t)i * M * 8 + m * 8 + hd]; ov[r][i] = *(const bf16x8*)(obr + (size_t)i * M * 512 + m * 512 + lane * 8); } }
#pragma unroll
                        for (int r = 0; r < 2; ++r) { const size_t m = (size_t)m0 + (size_t)r * NGW;
                            const float mx = fmaxf(L[r][0], fmaxf(L[r][1], L[r][2]));
                            float w0 = __builtin_amdgcn_exp2f(L[r][0] - mx), w1 = __builtin_amdgcn_exp2f(L[r][1] - mx), w2 = __builtin_amdgcn_exp2f(L[r][2] - mx);
                            const float inv = 1.0f / (w0 + w1 + w2); w0 *= inv; w1 *= inv; w2 *= inv;
                            float y[8];
#pragma unroll
                            for (int e = 0; e < 8; ++e) y[e] = w0 * bf2f((unsigned short)ov[r][0][e]) + w1 * bf2f((unsigned short)ov[r][1][e]) + w2 * bf2f((unsigned short)ov[r][2][e]);
                            u32x4 w; w.x = cvtpk(y[0], y[1]); w.y = cvtpk(y[2], y[3]); w.z = cvtpk(y[4], y[5]); w.w = cvtpk(y[6], y[7]);
                            *(u32x4*)(att + m * D + lane * 8) = w; }
                    }
                } else {
                    float d1 = 0.f, d2 = 0.f;
                    for (int i = 0; i < 64; ++i) { d1 += a.in[I_LQ1][i] * a.in[I_LK1][i]; d2 += a.in[I_LQ2][i] * a.in[I_LK2][i]; }
                    at::Ptrs X{qkv, att, obr, lse, a.in[I_RPB], a.in[I_SUBLN], 0.f, (const float*)(ws + WS_KN)};
                    X.lam = __int_as_float(__builtin_amdgcn_readfirstlane(__float_as_int(__expf(d1) - __expf(d2) + LAM_INIT)));
#ifndef SKIP_DIFF
                    if (grp) {
                        unsigned* qctr = (unsigned*)(a.ws + WS_BAR) + 4096 + 64 * ((int)blockIdx.x & 7);
                        LAS unsigned* qs = (LAS unsigned*)(lds + LDS_BYTES - 32);
                        if (threadIdx.x == 0) qs[0] = xb_add(qctr, 1u);
                        __syncthreads();
                        int cur = 0;
                        for (;;) {
                            const unsigned i = (unsigned)__builtin_amdgcn_readfirstlane((int)qs[cur]);
                            if (i >= 512u) break;
                            unsigned nxt = 0u; if (threadIdx.x == 0) nxt = xb_add(qctr, 1u);
                            at::PolDiff P; { const int hq = 7 - (int)(i >> 6), bs = (int)(i >> 5) & 1, x_ = (int)blockIdx.x & 7;
                                P.h = hq; P.b = x_ + 8 * bs; P.qb = (int)(i & 31u); P.tlo = 0; P.thi = T / 64; P.nsl = -at::slope_of(hq) * LOG2E; }
                            at::diff_unit(P, lds, X);
                            if (threadIdx.x == 0) qs[cur ^ 1] = nxt;
                            __syncthreads(); cur ^= 1;
                        }
                    } else
                    for (int u = blockIdx.x; u < 4096; u += G) { at::PolDiff P; P.init(u); at::diff_unit(P, lds, X); }
#endif
                }
            } else if (s == 3 || s == 5) {
                const bool dn = s == 5;
                pg8::Gemm g{dn ? hb : att, (const bf16_t*)(wl + (dn ? WO_D : WO_O)), M, D, dn ? FF : D}; pg8::StaticOrder S; S.init(M, D, G, (int)blockIdx.x);
                pg8::EpiResid E{(l == 0 && !dn) ? a.in[I_X] : nullptr, (l == 1 && dn) ? a.out : nullptr, xb, (bf16_t*)(ws + WS_OBR)  , ss};
#ifndef SKIP_G2
                pg8::gemm_phase<pg8::EpiResid, pg8::StaticOrder, true, true>(lds, g, S, E);
#endif
            } else {
                pg8::Gemm g{xb, (const bf16_t*)(wl + WO_GU), M, NGU, D}; pg8::StaticOrder S; S.init(M, NGU, G, (int)blockIdx.x);
                pg8::EpiSwiGLU E{hb, ss};
#ifndef SKIP_G3
                pg8::gemm_phase<pg8::EpiSwiGLU, pg8::StaticOrder, true, true>(lds, g, S, E);
#endif
            }
        }
        if ((ph + 1 < a.ph_hi || rep < ((MK_DUP_MASK >> ph) & 1)) && ph != 8) {
            if (grp && ((ph >= 4 && ph <= 5) || (ph >= 10 && ph <= 12))) grp_barrier(grp_cnt, grp_epoch, (unsigned)(G >> 3));
            else xcd_barrier(bar); }
    }
}

extern "C" void kernel_launch(void* const* d_in, const int* in_sizes, int n_in, void* d_out, int out_size, void* d_ws, size_t ws_size, hipStream_t stream) {
    static int grid = 0;
    if (grid == 0) {
        if (n_in != 22 || in_sizes[0] != M * D || out_size != M * D || ws_size < WS_END) { fprintf(stderr, "kernel_launch: unexpected shapes (n_in %d, in0 %d, out %d, ws %zu)\n", n_in, n_in > 0 ? in_sizes[0] : -1, out_size, ws_size); grid = -1; return; }
        int dev = 0, cus = 0, per_cu = 0;
        hipGetDevice(&dev); hipDeviceGetAttribute(&cus, hipDeviceAttributeMultiprocessorCount, dev);
        if (hipFuncSetAttribute((const void*)mk_fwd, hipFuncAttributeMaxDynamicSharedMemorySize, LDS_BYTES) != hipSuccess) { fprintf(stderr, "kernel_launch: hipFuncSetAttribute failed\n"); grid = -1; return; }
        hipOccupancyMaxActiveBlocksPerMultiprocessor(&per_cu, (const void*)mk_fwd, 512, LDS_BYTES);
        (void)hipGetLastError();
        if (per_cu < 1) { fprintf(stderr, "kernel_launch: occupancy query says %d blocks/CU\n", per_cu); per_cu = 1; }
        grid = cus * 1;
    }
    if (grid < 0) return;
    Args a{};
    for (int i = 0; i < 22; ++i) a.in[i] = (const float*)d_in[i];
    a.out = (float*)d_out; a.ws = (unsigned char*)d_ws;
#if MK_ONE_LAUNCH
    if (hipMemsetAsync((char*)d_ws + WS_BAR, 0, WS_BAR_BYTES, stream) != hipSuccess) { fprintf(stderr, "kernel_launch: memset of the barrier words failed\n"); return; }
    a.ph_lo = 0; a.ph_hi = NPH;
    void* args[] = {&a};
    hipError_t e = hipLaunchCooperativeKernel((const void*)mk_fwd, dim3(grid), dim3(512), args, LDS_BYTES, stream);
    if (e != hipSuccess) fprintf(stderr, "cooperative launch failed: %s (grid %d)\n", hipGetErrorString(e), grid);
#else
    for (int ph = 0; ph < NPH; ++ph) {
        a.ph_lo = ph; a.ph_hi = ph + 1;
        hipLaunchKernelGGL(mk_fwd, dim3(grid), dim3(512), LDS_BYTES, stream, a);
    }
#endif
}
```
